# Optimizing an MI355X kernel written in HIP

```python
import math
import jax, jax.numpy as jnp
from jax import lax
import numpy as np

D_MODEL = 2048
BATCH = 4
SEQ = 2048
DEPTH = 1

DIFF_HEADS = 8
DIFF_QK_DIM = 64
DIFF_V_DIM = 128
DIFF_WIDTH = DIFF_HEADS * DIFF_V_DIM
SSD_HEADS = 8
SSD_HEAD_DIM = 64
SSD_WIDTH = SSD_HEADS * SSD_HEAD_DIM
SSD_GROUPS = 2
SSD_STATE = 128
SSD_CONV = 4
SSD_CHUNK = 128
SSD_CONV_DIM = SSD_WIDTH + 2 * SSD_GROUPS * SSD_STATE
XATTN_HEADS = 4
XATTN_HEAD_DIM = 128
XATTN_WIDTH = XATTN_HEADS * XATTN_HEAD_DIM
MEM_LEN = 256
D_MIX = DIFF_WIDTH + SSD_WIDTH + XATTN_WIDTH
ROPE_THETA = 10000.0
Q_BLOCK = 128
NORM_EPS = 1e-6

IN_SPLITS = (
    2 * DIFF_HEADS * DIFF_QK_DIM,
    2 * DIFF_HEADS * DIFF_QK_DIM,
    DIFF_WIDTH,
    DIFF_WIDTH,
    SSD_WIDTH,
    SSD_CONV_DIM,
    SSD_HEADS,
    XATTN_WIDTH,
    XATTN_WIDTH,
)
D_IN = sum(IN_SPLITS)

kernel_name = 'hymba_diffattn_ssd_memxattn_layer'


def rms_norm(x, w):
    xf = x.astype(jnp.float32)
    y = xf * lax.rsqrt(jnp.mean(xf * xf, axis=-1, keepdims=True) + NORM_EPS)
    return (y * w.astype(jnp.float32)).astype(x.dtype)


def rope_cos_sin(positions, dim):
    inv_freq = 1.0 / (ROPE_THETA ** (jnp.arange(0, dim, 2, dtype=jnp.float32) / dim))
    ang = positions.astype(jnp.float32)[..., None] * inv_freq
    ang = jnp.concatenate([ang, ang], axis=-1)
    return jnp.cos(ang), jnp.sin(ang)


def apply_rope(x, cos, sin):
    xf = x.astype(jnp.float32)
    x1, x2 = jnp.split(xf, 2, axis=-1)
    rot = jnp.concatenate([-x2, x1], axis=-1)
    c = cos[:, :, None, None, :]
    s = sin[:, :, None, None, :]
    return (xf * c + rot * s).astype(x.dtype)


def diff_attention(q, k, v, lam):
    B, H, _, S, Dk = q.shape
    Dv = v.shape[-1]
    nq = S // Q_BLOCK
    q_blocks = q.reshape(B, H, 2, nq, Q_BLOCK, Dk).transpose(3, 0, 1, 2, 4, 5)
    starts = jnp.arange(nq, dtype=jnp.int32) * Q_BLOCK
    key_pos = jnp.arange(S, dtype=jnp.int32)
    scale = Dk ** -0.5

    def one_block(args):
        q_blk, start = args
        s = jnp.einsum('bhcqd,bhckd->bhcqk', q_blk, k).astype(jnp.float32) * scale
        q_pos = start + jnp.arange(Q_BLOCK, dtype=jnp.int32)
        causal = key_pos[None, :] <= q_pos[:, None]
        s = jnp.where(causal, s, -jnp.inf)
        p = jax.nn.softmax(s, axis=-1)
        a = p[:, :, 0] - lam * p[:, :, 1]
        return jnp.einsum('bhqk,bhkv->bhqv', a.astype(v.dtype), v)

    out = lax.map(one_block, (q_blocks, starts))
    return out.transpose(1, 0, 3, 2, 4).reshape(B, S, H, Dv)


def causal_depthwise_conv(x, w, b):
    y = lax.conv_general_dilated(
        x, w[:, None, :].astype(x.dtype), window_strides=(1,),
        padding=[(SSD_CONV - 1, 0)], dimension_numbers=('NWC', 'WIO', 'NWC'),
        feature_group_count=x.shape[-1])
    return y + b.astype(x.dtype)


def ssd_chunked(xh, dt, A, Bg, Cg):
    Bsz, S, H, P = xh.shape
    N = Bg.shape[-1]
    rep = H // Bg.shape[2]
    L = SSD_CHUNK
    nc = S // L
    Bh = jnp.repeat(Bg.astype(jnp.float32), rep, axis=2).reshape(Bsz, nc, L, H, N)
    Ch = jnp.repeat(Cg.astype(jnp.float32), rep, axis=2).reshape(Bsz, nc, L, H, N)
    X = (xh.astype(jnp.float32) * dt[..., None]).reshape(Bsz, nc, L, H, P)
    a_dt = (dt * A).reshape(Bsz, nc, L, H).transpose(0, 3, 1, 2)
    a_cs = jnp.cumsum(a_dt, axis=-1)
    tri = jnp.tril(jnp.ones((L, L), dtype=bool))
    seg = a_cs[..., :, None] - a_cs[..., None, :]
    decay = jnp.exp(jnp.where(tri, seg, -jnp.inf))
    scores = jnp.einsum('bclhn,bcshn->bhcls', Ch, Bh) * decay
    y_diag = jnp.einsum('bhcls,bcshp->bclhp', scores, X)
    decay_to_end = jnp.exp(a_cs[..., -1:] - a_cs).transpose(0, 2, 3, 1)
    chunk_states = jnp.einsum('bclhn,bclhp->bchpn', Bh * decay_to_end[..., None], X)
    chunk_decay = jnp.exp(a_cs[..., -1])

    def step(state, inp):
        cs, dec = inp
        return state * dec[:, :, None, None] + cs, state

    init = jnp.zeros((Bsz, H, P, N), jnp.float32)
    _, prev_states = lax.scan(step, init, (chunk_states.transpose(1, 0, 2, 3, 4),
                                           chunk_decay.transpose(2, 0, 1)))
    prev_states = prev_states.transpose(1, 0, 2, 3, 4)
    decay_in = jnp.exp(a_cs).transpose(0, 2, 3, 1)
    y_off = jnp.einsum('bclhn,bchpn->bclhp', Ch, prev_states) * decay_in[..., None]
    return (y_diag + y_off).reshape(Bsz, S, H, P)


def hybrid_layer(x, mem, cos, sin, lambda_init, pre_norm_w, w_in, lambda_q1, lambda_k1,
                 lambda_q2, lambda_k2, diff_subln_w, conv_w, conv_b, dt_bias, a_log,
                 d_skip, ssd_norm_w, mem_norm_w, w_mem_kv, w_out, post_norm_w):
    B, S, _ = x.shape
    h = rms_norm(x, pre_norm_w)
    proj = h @ w_in
    offsets = [int(o) for o in np.cumsum(IN_SPLITS)[:-1]]
    dq, dk, dv, dg, z, xbc, dt_raw, xq, xg = jnp.split(proj, offsets, axis=-1)

    dq = apply_rope(dq.reshape(B, S, DIFF_HEADS, 2, DIFF_QK_DIM), cos, sin).transpose(0, 2, 3, 1, 4)
    dk = apply_rope(dk.reshape(B, S, DIFF_HEADS, 2, DIFF_QK_DIM), cos, sin).transpose(0, 2, 3, 1, 4)
    dv = dv.reshape(B, S, DIFF_HEADS, DIFF_V_DIM).transpose(0, 2, 1, 3)
    lam = (jnp.exp(jnp.sum(lambda_q1.astype(jnp.float32) * lambda_k1.astype(jnp.float32)))
           - jnp.exp(jnp.sum(lambda_q2.astype(jnp.float32) * lambda_k2.astype(jnp.float32)))
           + lambda_init)
    o = diff_attention(dq, dk, dv, lam)
    o = rms_norm(o, diff_subln_w) * (1.0 - lambda_init)
    diff_out = o.reshape(B, S, DIFF_WIDTH) * jax.nn.silu(dg)

    xbc = jax.nn.silu(causal_depthwise_conv(xbc, conv_w, conv_b))
    xs, bm, cm = jnp.split(xbc, [SSD_WIDTH, SSD_WIDTH + SSD_GROUPS * SSD_STATE], axis=-1)
    dt = jax.nn.softplus(dt_raw.astype(jnp.float32) + dt_bias.astype(jnp.float32))
    A = -jnp.exp(a_log.astype(jnp.float32))
    xh = xs.reshape(B, S, SSD_HEADS, SSD_HEAD_DIM)
    y = ssd_chunked(xh, dt, A, bm.reshape(B, S, SSD_GROUPS, SSD_STATE),
                    cm.reshape(B, S, SSD_GROUPS, SSD_STATE))
    y = y + xh.astype(jnp.float32) * d_skip.astype(jnp.float32)[:, None]
    y = y.reshape(B, S, SSD_WIDTH).astype(x.dtype) * jax.nn.silu(z)
    grp = SSD_WIDTH // SSD_GROUPS
    ssd_out = rms_norm(y.reshape(B, S, SSD_GROUPS, grp),
                       ssd_norm_w.reshape(SSD_GROUPS, grp)).reshape(B, S, SSD_WIDTH)

    mem_n = rms_norm(mem, mem_norm_w)
    mk, mv = jnp.split(mem_n @ w_mem_kv, 2, axis=-1)
    mk = mk.reshape(B, -1, XATTN_HEADS, XATTN_HEAD_DIM)
    mv = mv.reshape(B, -1, XATTN_HEADS, XATTN_HEAD_DIM)
    q = xq.reshape(B, S, XATTN_HEADS, XATTN_HEAD_DIM)
    s = jnp.einsum('bshd,bmhd->bhsm', q, mk).astype(jnp.float32) * (XATTN_HEAD_DIM ** -0.5)
    p = jax.nn.softmax(s, axis=-1)
    xo = jnp.einsum('bhsm,bmhd->bshd', p.astype(mv.dtype), mv).reshape(B, S, XATTN_WIDTH)
    xattn_out = xo * jax.nn.silu(xg)

    mixed = jnp.concatenate([diff_out, ssd_out, xattn_out], axis=-1)
    return x + rms_norm(mixed @ w_out, post_norm_w)


def setup_inputs(seed: int = 0) -> dict:
    key = jax.random.key(seed)
    ks = jax.random.split(key, 20)
    f32 = jnp.float32
    x = jax.random.normal(ks[0], (BATCH, SEQ, D_MODEL), f32)
    mem = jax.random.normal(ks[1], (BATCH, MEM_LEN, D_MODEL), f32)
    positions = jnp.broadcast_to(jnp.arange(SEQ, dtype=jnp.int32), (BATCH, SEQ))
    pre_norm_w = 1.0 + 0.02 * jax.random.normal(ks[2], (DEPTH, D_MODEL), f32)
    w_in = jax.random.normal(ks[3], (DEPTH, D_MODEL, D_IN), f32) * D_MODEL ** -0.5
    lambda_q1 = 0.1 * jax.random.normal(ks[4], (DEPTH, DIFF_QK_DIM), f32)
    lambda_k1 = 0.1 * jax.random.normal(ks[5], (DEPTH, DIFF_QK_DIM), f32)
    lambda_q2 = 0.1 * jax.random.normal(ks[6], (DEPTH, DIFF_QK_DIM), f32)
    lambda_k2 = 0.1 * jax.random.normal(ks[7], (DEPTH, DIFF_QK_DIM), f32)
    diff_subln_w = 1.0 + 0.02 * jax.random.normal(ks[8], (DEPTH, DIFF_V_DIM), f32)
    conv_w = jax.random.normal(ks[9], (DEPTH, SSD_CONV, SSD_CONV_DIM), f32) * SSD_CONV ** -0.5
    conv_b = 0.01 * jax.random.normal(ks[10], (DEPTH, SSD_CONV_DIM), f32)
    u = jax.random.uniform(ks[11], (DEPTH, SSD_HEADS), f32)
    dt0 = jnp.exp(u * (math.log(0.1) - math.log(0.001)) + math.log(0.001))
    dt_bias = dt0 + jnp.log(-jnp.expm1(-dt0))
    a_log = jnp.log(jax.random.uniform(ks[12], (DEPTH, SSD_HEADS), f32, 1.0, 16.0))
    d_skip = 1.0 + 0.1 * jax.random.normal(ks[13], (DEPTH, SSD_HEADS), f32)
    ssd_norm_w = 1.0 + 0.02 * jax.random.normal(ks[14], (DEPTH, SSD_WIDTH), f32)
    mem_norm_w = 1.0 + 0.02 * jax.random.normal(ks[15], (DEPTH, D_MODEL), f32)
    w_mem_kv = jax.random.normal(ks[16], (DEPTH, D_MODEL, 2 * XATTN_WIDTH), f32) * D_MODEL ** -0.5
    w_out = jax.random.normal(ks[17], (DEPTH, D_MIX, D_MODEL), f32) * D_MIX ** -0.5
    post_norm_w = 1.0 + 0.02 * jax.random.normal(ks[18], (DEPTH, D_MODEL), f32)
    return {'x': x, 'mem': mem, 'positions': positions, 'pre_norm_w': pre_norm_w,
            'w_in': w_in, 'lambda_q1': lambda_q1, 'lambda_k1': lambda_k1,
            'lambda_q2': lambda_q2, 'lambda_k2': lambda_k2, 'diff_subln_w': diff_subln_w,
            'conv_w': conv_w, 'conv_b': conv_b, 'dt_bias': dt_bias, 'a_log': a_log,
            'd_skip': d_skip, 'ssd_norm_w': ssd_norm_w, 'mem_norm_w': mem_norm_w,
            'w_mem_kv': w_mem_kv, 'w_out': w_out, 'post_norm_w': post_norm_w}


def reference(x, mem, positions, pre_norm_w, w_in, lambda_q1, lambda_k1, lambda_q2,
              lambda_k2, diff_subln_w, conv_w, conv_b, dt_bias, a_log, d_skip,
              ssd_norm_w, mem_norm_w, w_mem_kv, w_out, post_norm_w):
    cos, sin = rope_cos_sin(positions, DIFF_QK_DIM)
    h = x
    for i in range(DEPTH):
        lambda_init = 0.8 - 0.6 * math.exp(-0.3 * i)
        h = hybrid_layer(h, mem, cos, sin, lambda_init, pre_norm_w[i], w_in[i],
                         lambda_q1[i], lambda_k1[i], lambda_q2[i], lambda_k2[i],
                         diff_subln_w[i], conv_w[i], conv_b[i], dt_bias[i], a_log[i],
                         d_skip[i], ssd_norm_w[i], mem_norm_w[i], w_mem_kv[i],
                         w_out[i], post_norm_w[i])
    return h
```

```cpp
#include <hip/hip_runtime.h>
#include <cstdio>
#include <cstdint>
#include <cmath>
namespace nv {
constexpr int NB = 4, NS = 2048, ND = 2048, NM = NB * NS, NDIN = 6664, NMEM = 256;
constexpr int OQ = 0, OK_ = 1024, OV = 2048, OG = 3072, OZ = 4096, OXBC = 4608, ODT = 5632, OXQ = 5640, OXG = 6152;

__device__ __forceinline__ float block_sum(float v, float* red) {
    for (int o = 32; o > 0; o >>= 1) v += __shfl_xor(v, o);
    const int w = threadIdx.x >> 6, nw = blockDim.x >> 6;
    __syncthreads();
    if ((threadIdx.x & 63) == 0) red[w] = v;
    __syncthreads();
    float s = 0.f; for (int i = 0; i < nw; ++i) s += red[i];
    return s;
}
__device__ __forceinline__ float block_max(float v, float* red) {
    for (int o = 32; o > 0; o >>= 1) v = fmaxf(v, __shfl_xor(v, o));
    const int w = threadIdx.x >> 6, nw = blockDim.x >> 6;
    __syncthreads();
    if ((threadIdx.x & 63) == 0) red[w] = v;
    __syncthreads();
    float s = -INFINITY; for (int i = 0; i < nw; ++i) s = fmaxf(s, red[i]);
    return s;
}
__device__ __forceinline__ float silu(float v) { return v / (1.f + expf(-v)); }

__global__ void __launch_bounds__(256) k_rstd(const float* x, float* rstd, int D) {
    __shared__ float red[8];
    const float* r = x + (size_t)blockIdx.x * D; float s = 0.f;
    for (int i = threadIdx.x; i < D; i += blockDim.x) s += r[i] * r[i];
    s = block_sum(s, red);
    if (threadIdx.x == 0) rstd[blockIdx.x] = rsqrtf(s / D + 1e-6f);
}
__global__ void __launch_bounds__(256) k_gemm(const float* A, const float* rs, const float* cw, const float* Bm, float* C, int M, int N, int K) {
    __shared__ float As[16][68], Bs[16][68];
    const int tx = threadIdx.x & 15, ty = threadIdx.x >> 4, m0 = blockIdx.y * 64, n0 = blockIdx.x * 64;
    float acc[4][4] = {};
    for (int k0 = 0; k0 < K; k0 += 16) {
        for (int i = threadIdx.x; i < 1024; i += 256) { const int r = i >> 4, c = i & 15; float v = A[(size_t)(m0 + r) * K + k0 + c]; if (rs) v *= rs[m0 + r]; if (cw) v *= cw[k0 + c]; As[c][r] = v; }
        for (int i = threadIdx.x; i < 1024; i += 256) { const int r = i >> 6, c = i & 63; Bs[r][c] = (n0 + c < N) ? Bm[(size_t)(k0 + r) * N + n0 + c] : 0.f; }
        __syncthreads();
#pragma unroll
        for (int k = 0; k < 16; ++k) { float a[4], b[4];
#pragma unroll
            for (int i = 0; i < 4; ++i) { a[i] = As[k][ty * 4 + i]; b[i] = Bs[k][tx * 4 + i]; }
#pragma unroll
            for (int i = 0; i < 4; ++i)
#pragma unroll
                for (int j = 0; j < 4; ++j) acc[i][j] += a[i] * b[j]; }
        __syncthreads();
    }
    for (int i = 0; i < 4; ++i) for (int j = 0; j < 4; ++j) { const int n = n0 + tx * 4 + j; if (n < N) C[(size_t)(m0 + ty * 4 + i) * N + n] = acc[i][j]; }
}
__global__ void __launch_bounds__(256) k_rope(float* proj, const int* pos) {
    const int idx = blockIdx.x * blockDim.x + threadIdx.x; if (idx >= NM * 32 * 32) return;
    const int d = idx & 31, ch = (idx >> 5) & 31, t = idx >> 10;
    const float inv = 1.0f / powf(10000.f, (float)(2 * d) / 64.f);
    const float ang = (float)pos[t] * inv, c = cosf(ang), s = sinf(ang);
    float* p = proj + (size_t)t * NDIN + ch * 64;
    const float a = p[d], b = p[d + 32];
    p[d] = a * c - b * s; p[d + 32] = b * c + a * s;
}
__global__ void __launch_bounds__(256) k_diffattn(const float* proj, const float* lq1, const float* lk1, const float* lq2, const float* lk2, const float* subw, float* mixed) {
    __shared__ float sc[2][NS]; __shared__ float qs[128]; __shared__ float red[8];
    const int i = blockIdx.x, h = blockIdx.y, b = blockIdx.z, tid = threadIdx.x;
    const size_t trow = (size_t)(b * NS + i);
    if (tid < 128) qs[tid] = proj[trow * NDIN + OQ + h * 128 + tid];
    float d1 = 0.f, d2 = 0.f;
    if (tid < 64) { d1 = lq1[tid] * lk1[tid]; d2 = lq2[tid] * lk2[tid]; }
    d1 = block_sum(d1, red); d2 = block_sum(d2, red);
    const float lam = expf(d1) - expf(d2) + 0.2f;
    __syncthreads();
    float mx0 = -INFINITY, mx1 = -INFINITY;
    for (int j = tid; j <= i; j += 256) {
        const float* kr = proj + (size_t)(b * NS + j) * NDIN + OK_ + h * 128; float s0 = 0.f, s1 = 0.f;
        for (int d = 0; d < 64; ++d) { s0 += qs[d] * kr[d]; s1 += qs[64 + d] * kr[64 + d]; }
        s0 *= 0.125f; s1 *= 0.125f; sc[0][j] = s0; sc[1][j] = s1; mx0 = fmaxf(mx0, s0); mx1 = fmaxf(mx1, s1);
    }
    mx0 = block_max(mx0, red); mx1 = block_max(mx1, red);
    float l0 = 0.f, l1 = 0.f;
    for (int j = tid; j <= i; j += 256) { const float p0 = expf(sc[0][j] - mx0), p1 = expf(sc[1][j] - mx1); sc[0][j] = p0; sc[1][j] = p1; l0 += p0; l1 += p1; }
    l0 = block_sum(l0, red); l1 = block_sum(l1, red);
    __syncthreads();
    for (int j = tid; j <= i; j += 256) sc[0][j] = sc[0][j] / l0 - lam * (sc[1][j] / l1);
    __syncthreads();
    float o = 0.f;
    if (tid < 128) { const float* vp = proj + (size_t)(b * NS) * NDIN + OV + h * 128 + tid; for (int j = 0; j <= i; ++j) o += sc[0][j] * vp[(size_t)j * NDIN]; }
    float ss = (tid < 128) ? o * o : 0.f; ss = block_sum(ss, red);
    if (tid < 128) { const float r = rsqrtf(ss / 128.f + 1e-6f); const float g = proj[trow * NDIN + OG + h * 128 + tid];
        mixed[trow * 2048 + h * 128 + tid] = o * r * subw[tid] * 0.8f * silu(g); }
}
__global__ void __launch_bounds__(256) k_conv(const float* proj, const float* cw, const float* cb, float* xc) {
    const int idx = blockIdx.x * blockDim.x + threadIdx.x; if (idx >= NM * 1024) return;
    const int c = idx & 1023, t = idx >> 10, s = t & (NS - 1);
    float y = cb[c];
    for (int k = 0; k < 4; ++k) { const int ss = s - 3 + k; if (ss >= 0) y += cw[k * 1024 + c] * proj[(size_t)(t - 3 + k) * NDIN + OXBC + c]; }
    xc[idx] = silu(y);
}
__global__ void __launch_bounds__(256) k_ssd(const float* proj, const float* xc, const float* dtb, const float* alog, const float* dsk, float* ypre) {
    const int gw = (blockIdx.x * blockDim.x + threadIdx.x) >> 6, lane = threadIdx.x & 63; if (gw >= NB * 8 * 64) return;
    const int p = gw & 63, h = (gw >> 6) & 7, b = gw >> 9, g = h >> 2;
    const float A = -expf(alog[h]), bias = dtb[h], D = dsk[h];
    float s0 = 0.f, s1 = 0.f;
    for (int s = 0; s < NS; ++s) { const size_t t = (size_t)b * NS + s;
        const float draw = proj[t * NDIN + ODT + h] + bias; const float dt = (draw > 20.f) ? draw : log1pf(expf(draw));
        const float x = xc[t * 1024 + h * 64 + p], dec = expf(dt * A);
        const float* Bp = xc + t * 1024 + 512 + g * 128; const float* Cp = xc + t * 1024 + 768 + g * 128;
        s0 = s0 * dec + dt * x * Bp[lane]; s1 = s1 * dec + dt * x * Bp[lane + 64];
        float y = Cp[lane] * s0 + Cp[lane + 64] * s1;
        for (int o = 32; o > 0; o >>= 1) y += __shfl_xor(y, o);
        if (lane == 0) { const float z = proj[t * NDIN + OZ + h * 64 + p]; ypre[t * 2048 + 1024 + h * 64 + p] = (y + x * D) * silu(z); }
    }
}
__global__ void __launch_bounds__(256) k_ssdnorm(const float* w, float* mixed) {
    __shared__ float red[8];
    const int t = blockIdx.x, g = blockIdx.y, j = threadIdx.x;
    const float v = mixed[(size_t)t * 2048 + 1024 + g * 256 + j]; const float ss = block_sum(v * v, red);
    mixed[(size_t)t * 2048 + 1024 + g * 256 + j] = v * rsqrtf(ss / 256.f + 1e-6f) * w[g * 256 + j];
}
__global__ void __launch_bounds__(256) k_xattn(const float* proj, const float* memkv, float* mixed) {
    __shared__ float qs[128], ps[256]; __shared__ float red[8];
    const int i = blockIdx.x, h = blockIdx.y, b = blockIdx.z, tid = threadIdx.x; const size_t trow = (size_t)(b * NS + i);
    if (tid < 128) qs[tid] = proj[trow * NDIN + OXQ + h * 128 + tid];
    __syncthreads();
    const float* kr = memkv + (size_t)(b * NMEM + tid) * 1024 + h * 128; float s = 0.f;
    for (int d = 0; d < 128; ++d) s += qs[d] * kr[d];
    s *= 0.08838834764831845f;
    const float mx = block_max(s, red); const float p = expf(s - mx); const float l = block_sum(p, red);
    ps[tid] = p / l; __syncthreads();
    if (tid < 128) { float o = 0.f; const float* vp = memkv + (size_t)(b * NMEM) * 1024 + 512 + h * 128 + tid;
        for (int j = 0; j < NMEM; ++j) o += ps[j] * vp[(size_t)j * 1024];
        const float g = proj[trow * NDIN + OXG + h * 128 + tid]; mixed[trow * 2048 + 1536 + h * 128 + tid] = o * silu(g); }
}
__global__ void __launch_bounds__(256) k_final(const float* x, const float* o2, const float* w, float* out) {
    __shared__ float red[8];
    const size_t r = (size_t)blockIdx.x * ND; float s = 0.f;
    for (int i = threadIdx.x; i < ND; i += 256) s += o2[r + i] * o2[r + i];
    s = block_sum(s, red); const float rs = rsqrtf(s / ND + 1e-6f);
    for (int i = threadIdx.x; i < ND; i += 256) out[r + i] = x[r + i] + o2[r + i] * rs * w[i];
}

static void launch(void* const* d_in, float* out, unsigned char* ws, hipStream_t st) {
    const float* x = (const float*)d_in[0]; const float* mem = (const float*)d_in[1]; const int* pos = (const int*)d_in[2];
    const float* prew = (const float*)d_in[3]; const float* w_in = (const float*)d_in[4];
    const float *lq1 = (const float*)d_in[5], *lk1 = (const float*)d_in[6], *lq2 = (const float*)d_in[7], *lk2 = (const float*)d_in[8];
    const float* subw = (const float*)d_in[9]; const float* cw = (const float*)d_in[10]; const float* cb = (const float*)d_in[11];
    const float* dtb = (const float*)d_in[12]; const float* alog = (const float*)d_in[13]; const float* dsk = (const float*)d_in[14];
    const float* ssdw = (const float*)d_in[15]; const float* memw = (const float*)d_in[16]; const float* wkv = (const float*)d_in[17];
    const float* wout = (const float*)d_in[18]; const float* postw = (const float*)d_in[19];
    float* proj = (float*)ws;
    float* xc = (float*)(ws + 218365952);
    float* memkv = (float*)(ws + 251920384);
    float* rstd = (float*)(ws + 256114688);
    float* rstdm = rstd + 8192;
    float* mixed = out;
    k_rstd<<<NM, 256, 0, st>>>(x, rstd, ND);
    k_rstd<<<NB * NMEM, 256, 0, st>>>(mem, rstdm, ND);
    k_gemm<<<dim3((NDIN + 63) / 64, NM / 64), 256, 0, st>>>(x, rstd, prew, w_in, proj, NM, NDIN, ND);
    k_gemm<<<dim3(1024 / 64, NB * NMEM / 64), 256, 0, st>>>(mem, rstdm, memw, wkv, memkv, NB * NMEM, 1024, ND);
    k_rope<<<NM * 32 * 32 / 256, 256, 0, st>>>(proj, pos);
    k_conv<<<NM * 1024 / 256, 256, 0, st>>>(proj, cw, cb, xc);
    k_diffattn<<<dim3(NS, 8, NB), 256, 0, st>>>(proj, lq1, lk1, lq2, lk2, subw, mixed);
    k_xattn<<<dim3(NS, 4, NB), 256, 0, st>>>(proj, memkv, mixed);
    k_ssd<<<NB * 8 * 64 * 64 / 256, 256, 0, st>>>(proj, xc, dtb, alog, dsk, mixed);
    k_ssdnorm<<<dim3(NM, 2), 256, 0, st>>>(ssdw, mixed);
    float* o2 = proj;
    k_gemm<<<dim3(ND / 64, NM / 64), 256, 0, st>>>(mixed, nullptr, nullptr, wout, o2, NM, ND, ND);
    k_final<<<NM, 256, 0, st>>>(x, o2, postw, out);
}
}

extern "C" void kernel_launch(void* const* d_in, const int* in_sizes, int n_in, void* d_out, int out_size, void* d_ws, size_t ws_size, hipStream_t stream) {
    (void)in_sizes; (void)n_in; (void)out_size; (void)ws_size;
    nv::launch(d_in, (float*)d_out, (unsigned char*)d_ws, stream);
}
```

```cpp
#include <hip/hip_runtime.h>
#include <cstdio>
#include <cstdint>
#include <cmath>
namespace pg8 {
#define PG8_LAS __attribute__((address_space(3)))
typedef unsigned short bf16_t;
typedef short bf16x8 __attribute__((ext_vector_type(8)));
typedef float f32x4 __attribute__((ext_vector_type(4)));
typedef unsigned u32x4 __attribute__((ext_vector_type(4)));
constexpr int BM = 256, BK = 64, HALF = 128, HTB = HALF * BK * 2  , STAGE_BYTES = 8 * HTB, NXCD = 8, WGM = 8;

__host__ __device__ __forceinline__ int lds_byte(int r, int c) { const int st = (r >> 4) * 2 + (c >> 5), rr = r & 15, cc = c & 31, ob = rr * 64 + cc * 2; return st * 1024 + (ob ^ (((ob >> 9) & 1) << 5)); }
__host__ __device__ __forceinline__ void stage_rc(int b, int& R, int& C) { const int st = b / 1024, sb = b % 1024, swz = sb ^ (((sb >> 9) & 1) << 5); R = (st >> 1) * 16 + swz / 64; C = (st & 1) * 32 + (swz % 64) / 2; }
__host__ __device__ __forceinline__ int perm32(int rho) { const int n = rho >> 4, i = rho & 15; return 8 * (i >> 2) + 4 * n + (i & 3); }

struct Unit { const char* a; const char* b; int pm, pn, kind; };
struct Gemm { int K; };

__device__ __forceinline__ unsigned cvt_pk_bf16(float lo, float hi) { unsigned r; asm volatile("v_cvt_pk_bf16_f32 %0, %1, %2" : "=v"(r) : "v"(lo), "v"(hi)); return r; }
template <class Epi, class Sched, bool ALIGN_EPI = false, bool SP2 = false>
__device__ __forceinline__ void gemm_phase(PG8_LAS unsigned char* lds, const Gemm g, const Sched& S, const Epi& E) {
    const int tid = threadIdx.x, wid = __builtin_amdgcn_readfirstlane(tid >> 6), lane = tid & 63, wr = wid >> 2, wc = wid & 3, fr = lane & 15, fq = lane >> 4;
    const int K = g.K, nt = K / BK;
    unsigned voffA[2], voffB[2];
#pragma unroll
    for (int i = 0; i < 2; ++i) { int R, C; stage_rc(tid * 16 + i * 8192, R, C); const int Rb = Epi::PERM ? ((R & ~31) + perm32(R & 31)) : R;
        voffA[i] = (unsigned)(R * K + C) * 2u; voffB[i] = (unsigned)(Rb * K + C) * 2u; }
    const size_t kstep = (size_t)(BK * 2);
    const size_t hstep = (size_t)HALF * K * 2;
        const unsigned ldsw = (unsigned)wid * 1024u;
    const int aoff = lds_byte(wr * 64 + fr, fq * 8), boff = lds_byte(wc * 32 + fr, fq * 8);
#define PG8_SA(b, h) (((b) * 2 + (h)) * HTB)
#define PG8_SB(b, h) ((4 + (b) * 2 + (h)) * HTB)
#define PG8_STAGE(bufoff, gbase, voff) do { _Pragma("unroll") for (int _i = 0; _i < 2; ++_i) \
        __builtin_amdgcn_global_load_lds((const unsigned*)((const char*)(gbase) + (voff)[_i]), (PG8_LAS unsigned*)(lds + (bufoff) + ldsw + _i * 8192), 16, 0, 0); } while (0)
#define PG8_LDA(dst, b, h) do { _Pragma("unroll") for (int m = 0; m < 4; ++m) _Pragma("unroll") for (int k = 0; k < 2; ++k) dst[m][k] = *(const PG8_LAS bf16x8*)(lds + PG8_SA(b, h) + aoff + m * 2048 + k * 1024); } while (0)
#define PG8_LDB(dst, b, h) do { _Pragma("unroll") for (int n = 0; n < 2; ++n) _Pragma("unroll") for (int k = 0; k < 2; ++k) dst[n][k] = *(const PG8_LAS bf16x8*)(lds + PG8_SB(b, h) + boff + n * 2048 + k * 1024); } while (0)
#define PG8_MMA(ai, bj, At, Bt) do { __builtin_amdgcn_s_setprio(1); _Pragma("unroll") for (int m = 0; m < 4; ++m) _Pragma("unroll") for (int n = 0; n < 2; ++n) _Pragma("unroll") for (int k = 0; k < 2; ++k) \
        acc[ai][bj][m][n] = __builtin_amdgcn_mfma_f32_16x16x32_bf16(Bt[n][k], At[m][k], acc[ai][bj][m][n], 0, 0, 0); __builtin_amdgcn_s_setprio(0); } while (0)
#define PG8_WAIT_V(n) asm volatile("s_waitcnt vmcnt(" #n ")" ::: "memory")
#define PG8_WAIT_L(n) asm volatile("s_waitcnt lgkmcnt(" #n ")" ::: "memory")
#define PG8_BAR __builtin_amdgcn_s_barrier()
#define PG8_SCHED __builtin_amdgcn_sched_barrier(0)
    Unit cur, nxt; int ui = 0;
    if (!S.next(0, cur)) return;
    f32x4 acc[2][2][4][2];
#pragma unroll
    for (int a = 0; a < 2; ++a)
#pragma unroll
        for (int b = 0; b < 2; ++b)
#pragma unroll
            for (int m = 0; m < 4; ++m)
#pragma unroll
                for (int n = 0; n < 2; ++n) acc[a][b][m][n] = (f32x4){0.f, 0.f, 0.f, 0.f};
    bf16x8 At[4][2], B0[2][2], B1[2][2];
    const char* cA = cur.a; const char* cB = cur.b;
    S.a_ready(cur);
    if constexpr (SP2) {
        PG8_STAGE(PG8_SB(0, 0), cB, voffB); PG8_STAGE(PG8_SB(0, 1), cB + hstep, voffB); PG8_STAGE(PG8_SA(0, 0), cA, voffA); PG8_STAGE(PG8_SA(0, 1), cA + hstep, voffA);
        if (wr == 1) PG8_BAR;
        PG8_WAIT_V(2); PG8_BAR;
        PG8_STAGE(PG8_SB(1, 0), cB + kstep, voffB); PG8_STAGE(PG8_SA(1, 0), cA + kstep, voffA); PG8_STAGE(PG8_SB(1, 1), cB + hstep + kstep, voffB);
        PG8_WAIT_V(6); PG8_BAR;
    } else {
        PG8_STAGE(PG8_SB(0, 0), cB, voffB); PG8_STAGE(PG8_SA(0, 0), cA, voffA); PG8_STAGE(PG8_SB(0, 1), cB + hstep, voffB); PG8_STAGE(PG8_SA(0, 1), cA + hstep, voffA);
        if (wr == 1) PG8_BAR;
        PG8_WAIT_V(4); PG8_BAR;
        PG8_STAGE(PG8_SB(1, 0), cB + kstep, voffB); PG8_STAGE(PG8_SA(1, 0), cA + kstep, voffA); PG8_STAGE(PG8_SB(1, 1), cB + hstep + kstep, voffB);
        PG8_WAIT_V(6); PG8_BAR;
    }
    for (;;) {
        const bool has_next = S.next(ui + 1, nxt);
        const char* nA = has_next ? nxt.a : cA; const char* nB = has_next ? nxt.b : cB;
        for (int t = 0; t < nt; t += 2) {
            const bool last = (t == nt - 2);
            const char* a1 = cA + (size_t)(t + 1) * kstep;
            const char* a2 = last ? nA : cA + (size_t)(t + 2) * kstep; const char* b2 = last ? nB : cB + (size_t)(t + 2) * kstep;
            const char* a3 = a2 + kstep; const char* b3 = b2 + kstep;
            if (last && has_next) S.a_ready(nxt);
            if constexpr (SP2) {
            PG8_LDB(B0, 0, 0); PG8_LDB(B1, 0, 1); PG8_SCHED; PG8_LDA(At, 0, 0); PG8_STAGE(PG8_SA(1, 1), a1 + hstep, voffA);
            PG8_WAIT_V(8); PG8_WAIT_L(0); PG8_BAR; PG8_MMA(0, 0, At, B0); PG8_MMA(0, 1, At, B1); PG8_BAR; PG8_SCHED;
            PG8_LDA(At, 0, 1); PG8_STAGE(PG8_SB(0, 0), b2, voffB); PG8_STAGE(PG8_SB(0, 1), b2 + hstep, voffB); PG8_STAGE(PG8_SA(0, 0), a2, voffA);
            PG8_WAIT_V(8); PG8_WAIT_L(0); PG8_BAR; PG8_MMA(1, 0, At, B0); PG8_MMA(1, 1, At, B1); PG8_BAR; PG8_SCHED;
            PG8_LDB(B0, 1, 0); PG8_LDB(B1, 1, 1); PG8_SCHED; PG8_LDA(At, 1, 0); PG8_STAGE(PG8_SA(0, 1), a2 + hstep, voffA);
            PG8_WAIT_V(8); PG8_WAIT_L(0); PG8_BAR; PG8_MMA(0, 0, At, B0); PG8_MMA(0, 1, At, B1); PG8_BAR; PG8_SCHED;
            PG8_LDA(At, 1, 1); PG8_STAGE(PG8_SB(1, 0), b3, voffB); PG8_STAGE(PG8_SB(1, 1), b3 + hstep, voffB); PG8_STAGE(PG8_SA(1, 0), a3, voffA);
            PG8_WAIT_V(8); PG8_WAIT_L(0); PG8_BAR; PG8_MMA(1, 0, At, B0); PG8_MMA(1, 1, At, B1); PG8_BAR; PG8_SCHED;
            } else {
            PG8_LDB(B0, 0, 0); PG8_SCHED; PG8_LDA(At, 0, 0); PG8_STAGE(PG8_SA(1, 1), a1 + hstep, voffA);
            PG8_WAIT_L(8); PG8_BAR; PG8_WAIT_L(0); PG8_MMA(0, 0, At, B0); PG8_BAR; PG8_SCHED;
            PG8_LDB(B1, 0, 1); PG8_STAGE(PG8_SB(0, 0), b2, voffB);
            PG8_BAR; PG8_WAIT_L(0); PG8_MMA(0, 1, At, B1); PG8_BAR;
            PG8_LDA(At, 0, 1); PG8_STAGE(PG8_SA(0, 0), a2, voffA);
            PG8_BAR; PG8_WAIT_L(0); PG8_MMA(1, 0, At, B0); PG8_BAR; PG8_SCHED;
            PG8_STAGE(PG8_SB(0, 1), b2 + hstep, voffB);
            PG8_WAIT_V(6); PG8_BAR; PG8_MMA(1, 1, At, B1); PG8_BAR;
            PG8_LDB(B0, 1, 0); PG8_SCHED; PG8_LDA(At, 1, 0); PG8_STAGE(PG8_SA(0, 1), a2 + hstep, voffA);
            PG8_WAIT_L(8); PG8_BAR; PG8_WAIT_L(0); PG8_MMA(0, 0, At, B0); PG8_BAR; PG8_SCHED;
            PG8_LDB(B1, 1, 1); PG8_STAGE(PG8_SB(1, 0), b3, voffB);
            PG8_BAR; PG8_WAIT_L(0); PG8_MMA(0, 1, At, B1); PG8_BAR;
            PG8_LDA(At, 1, 1); PG8_STAGE(PG8_SA(1, 0), a3, voffA);
            PG8_BAR; PG8_WAIT_L(0); PG8_MMA(1, 0, At, B0); PG8_BAR; PG8_SCHED;
            PG8_STAGE(PG8_SB(1, 1), b3 + hstep, voffB);
            PG8_WAIT_V(6); PG8_BAR; PG8_MMA(1, 1, At, B1); PG8_BAR;
            }
        }
        if constexpr (ALIGN_EPI) { if (wr == 0) PG8_BAR; }
        if constexpr (!Epi::AFTER_DRAIN) { E(acc, cur, wr, wc, fr, fq); S.done(cur); }
        if (!has_next) break;
#pragma unroll
        for (int a = 0; a < 2; ++a)
#pragma unroll
            for (int b = 0; b < 2; ++b)
#pragma unroll
                for (int m = 0; m < 4; ++m)
#pragma unroll
                    for (int n = 0; n < 2; ++n) acc[a][b][m][n] = (f32x4){0.f, 0.f, 0.f, 0.f};
        cur = nxt; cA = nA; cB = nB; ++ui;
        if constexpr (ALIGN_EPI) { if (wr == 1) PG8_BAR; }
    }
    PG8_WAIT_V(0);
    if constexpr (!ALIGN_EPI) { if (wr == 0) PG8_BAR; }
    PG8_BAR;
    if constexpr (Epi::AFTER_DRAIN) { E.fused(acc, cur, wr, wc, fr, fq, lds, wid, lane); S.done(cur); }
#undef PG8_SA
#undef PG8_SB
#undef PG8_STAGE
#undef PG8_LDA
#undef PG8_LDB
#undef PG8_MMA
#undef PG8_WAIT_V
#undef PG8_WAIT_L
#undef PG8_BAR
#undef PG8_SCHED
}
}
constexpr int NWAVES = 8, NTHR = NWAVES * 64;
constexpr int BATCH = 4, SEQ = 2048, DM = 2048, M = BATCH * SEQ, DIN = 6664, MEMLEN = 256, MM = BATCH * MEMLEN;
constexpr int NW1 = 6656;
constexpr float EPS = 1e-6f, LOG2E = 1.4426950408889634f;
constexpr float C2Q = 0.125f * LOG2E;
constexpr float C2X = 0.08838834764831845f * LOG2E;
constexpr float LAMBDA_INIT = 0.2f;
constexpr size_t MiB = 1u << 20;
constexpr size_t WS_CTL = 0, CTL_ZERO_BYTES = 1 * MiB;
constexpr size_t WS_W1T = 1 * MiB, WS_WOT = 27 * MiB, WS_WKVT = 35 * MiB, WS_HN = 39 * MiB, WS_MEMN = 71 * MiB;
constexpr size_t WS_DT = 75 * MiB, WS_ACS = 75 * MiB + 256 * 1024, WS_ROPE = 76 * MiB;
constexpr size_t WS_Q = 78 * MiB, WS_K = 94 * MiB, WS_VT = 110 * MiB, WS_G = 126 * MiB, WS_Z = 142 * MiB, WS_XBC = 150 * MiB, WS_XQ = 166 * MiB, WS_XG = 174 * MiB;
constexpr size_t WS_MK = 182 * MiB, WS_MVT = 183 * MiB, WS_XT = 184 * MiB, WS_BC = 192 * MiB, WS_CS = 200 * MiB, WS_MIXED = 216 * MiB, WS_END = 248 * MiB;
constexpr size_t WS_O2 = 39 * MiB;
constexpr size_t TSTEP = (size_t)256 * DM * 2;

#define GAS __attribute__((address_space(1)))
#define LAS __attribute__((address_space(3)))
typedef unsigned short bf16;
typedef unsigned v4u __attribute__((ext_vector_type(4)));
typedef unsigned v2u __attribute__((ext_vector_type(2)));
typedef float f32x4 __attribute__((ext_vector_type(4)));
typedef float f32x16 __attribute__((ext_vector_type(16)));
typedef short bf16x8 __attribute__((ext_vector_type(8)));
#define LDS_WAIT() asm volatile("s_waitcnt lgkmcnt(0)" ::: "memory")
#define VM_WAIT() asm volatile("s_waitcnt vmcnt(0)" ::: "memory")
__device__ __forceinline__ unsigned f2bf(float f) { unsigned u = __builtin_bit_cast(unsigned, f); return (u + 0x7fffu + ((u >> 16) & 1u)) >> 16; }
__device__ __forceinline__ unsigned pk2(float lo, float hi) { return f2bf(lo) | (f2bf(hi) << 16); }
__device__ __forceinline__ float bf2f(bf16 v) { return __builtin_bit_cast(float, (unsigned)v << 16); }
__device__ __forceinline__ float bflo(unsigned w) { return __builtin_bit_cast(float, w << 16); }
__device__ __forceinline__ float bfhi(unsigned w) { return __builtin_bit_cast(float, w & 0xffff0000u); }
__device__ __forceinline__ float silu_f(float v) { return v / (1.f + __expf(-v)); }
__device__ __forceinline__ float wave_sum(float v) {
#pragma unroll
    for (int o = 1; o < 64; o <<= 1) v += __shfl_xor(v, o);
    return v;
}

struct Frame {
    LAS unsigned char* lds;
    int tid, lane, wave, vcu, G;
    const float* in[20]; float* out; unsigned char* ws;
};

__device__ __forceinline__ int w1_src_col(int r) {
    if (r < 2048) { const int p = r & 63, i = p >> 2, j = p & 3; return (r & ~63) + 2 * i + (j & 1) + 32 * (j >> 1); }
    if (r < 3072) return 3072 + (r - 2048);
    if (r < 3584) return 4096 + (r - 3072);
    if (r < 4608) return 4608 + (r - 3584);
    if (r < 5120) return 5640 + (r - 4608);
    if (r < 5632) return 6152 + (r - 5120);
    return 2048 + (r - 5632);
}
template <bool MAP>
__device__ __forceinline__ void p0_transpose_item(const float* W, int K, int N, bf16* WT, LAS float* scr, int item, int lane) {
    const int nkb = K / 64, nb = item / nkb, kb = item % nkb, k0 = 64 * kb, n0 = 32 * nb;
    const int sc = MAP ? w1_src_col(n0 + (lane & 31)) : n0 + (lane & 31);
#pragma unroll 8
    for (int i = 0; i < 32; ++i) { const int kk = 2 * i + (lane >> 5); scr[kk * 33 + (lane & 31)] = W[(size_t)(k0 + kk) * N + sc]; }
    LDS_WAIT(); asm volatile("" ::: "memory");
    const int c = lane & 7;
#pragma unroll
    for (int j = 0; j < 4; ++j) { const int n = (lane >> 3) + 8 * j; const LAS float* s = scr + (8 * c) * 33 + n;
        v4u o; o.x = pk2(s[0 * 33], s[1 * 33]); o.y = pk2(s[2 * 33], s[3 * 33]); o.z = pk2(s[4 * 33], s[5 * 33]); o.w = pk2(s[6 * 33], s[7 * 33]);
        *(GAS v4u*)(WT + (size_t)(n0 + n) * K + k0 + 8 * c) = o; }
    LDS_WAIT(); asm volatile("" ::: "memory");
}
template <bool WITH_DT>
__device__ __forceinline__ void p0_norm_row(const float* xrow, const float* w, bf16* orow, const LAS float* wdt, const float* dtb, float* dtrow, int lane) {
    const GAS f32x4* xr = (const GAS f32x4*)xrow + lane; const GAS f32x4* wr = (const GAS f32x4*)w + lane;
    f32x4 v[8]; float s = 0.f;
#pragma unroll
    for (int j = 0; j < 8; ++j) { v[j] = xr[64 * j]; s += (v[j].x * v[j].x + v[j].y * v[j].y) + (v[j].z * v[j].z + v[j].w * v[j].w); }
    const float rstd = rsqrtf(wave_sum(s) * (1.f / DM) + EPS);
    GAS v2u* o8 = (GAS v2u*)orow + lane;
#pragma unroll
    for (int j = 0; j < 8; ++j) { v[j] = v[j] * rstd * wr[64 * j]; v2u o; o.x = pk2(v[j].x, v[j].y); o.y = pk2(v[j].z, v[j].w); o8[64 * j] = o; }
    if (WITH_DT) {
        float d[8];
#pragma unroll
        for (int h = 0; h < 8; ++h) { float a = 0.f;
#pragma unroll
            for (int j = 0; j < 8; ++j) { const f32x4 ww = *(const LAS f32x4*)(wdt + h * DM + 4 * (lane + 64 * j)); a += (v[j].x * ww.x + v[j].y * ww.y) + (v[j].z * ww.z + v[j].w * ww.w); }
            d[h] = wave_sum(a); }
        float mine = 0.f;
#pragma unroll
        for (int h = 0; h < 8; ++h) mine = (lane == h) ? d[h] : mine;
        if (lane < 8) { const float r = mine + dtb[lane]; dtrow[lane] = (r > 20.f) ? r : log1pf(__expf(r)); }
    }
}
__device__ __forceinline__ void p0_prologue(Frame& F) {
    LAS float* scr = (LAS float*)(F.lds + F.wave * 16384);
    const int gw = F.vcu * NWAVES + F.wave, NGW = F.G * NWAVES;
    unsigned char* ws = F.ws;
    constexpr int I_1 = (NW1 / 32) * (DM / 64), I_O = (DM / 32) * (DM / 64), I_KV = (1024 / 32) * (DM / 64);
    for (int it = gw; it < I_1 + I_O + I_KV; it += NGW) {
        int r = it;
        if (r < I_1) { p0_transpose_item<true>(F.in[4], DM, DIN, (bf16*)(ws + WS_W1T), scr, r, F.lane); continue; } r -= I_1;
        if (r < I_O) { p0_transpose_item<false>(F.in[18], DM, DM, (bf16*)(ws + WS_WOT), scr, r, F.lane); continue; } r -= I_O;
        p0_transpose_item<false>(F.in[17], DM, 1024, (bf16*)(ws + WS_WKVT), scr, r, F.lane);
    }
    { const int* pos = (const int*)F.in[2]; float* rope = (float*)(ws + WS_ROPE);
      for (int idx = (F.vcu * NTHR + F.tid); idx < M * 32; idx += F.G * NTHR) { const int t = idx >> 5, f = idx & 31;
          const float inv = 1.0f / powf(10000.f, (float)(2 * f) / 64.f); const float ang = (float)pos[t] * inv;
          rope[2 * idx] = cosf(ang); rope[2 * idx + 1] = sinf(ang); } }
    __syncthreads();
    LAS float* wdt = (LAS float*)F.lds;
    for (int idx = F.tid; idx < DM * 8; idx += NTHR) { const int k = idx >> 3, h = idx & 7; wdt[h * DM + k] = F.in[4][(size_t)k * DIN + 5632 + h]; }
    __syncthreads();
    for (int m = gw; m < M + MM; m += NGW) {
        if (m < M) p0_norm_row<true>(F.in[0] + (size_t)m * DM, F.in[3], (bf16*)(ws + WS_HN) + (size_t)m * DM, wdt, F.in[12], (float*)(ws + WS_DT) + (size_t)m * 8, F.lane);
        else p0_norm_row<false>(F.in[1] + (size_t)(m - M) * DM, F.in[16], (bf16*)(ws + WS_MEMN) + (size_t)(m - M) * DM, wdt, nullptr, nullptr, F.lane);
    }
    __syncthreads();
}

struct Sched1 {
    int G, c; const char *HN, *W1T, *MEMN, *WKVT;
    __device__ __forceinline__ bool next(int i, pg8::Unit& u) const {
        const long L = (long)i * G + c; if (L >= 848) return false;
        if (L < 704) {
            int wgid = (int)L; { const int xcd = wgid % 8, off = wgid / 8; wgid = xcd * 88 + off; }
            const int pm = (wgid / 176) * 8 + ((wgid % 176) % 8), pn = (wgid % 176) / 8;
            u.kind = 0; u.pm = pm; u.pn = pn; u.a = HN + (size_t)pm * TSTEP; u.b = W1T + (size_t)pn * TSTEP;
        } else if (L < 832) { const int r = (int)L - 704;
            u.kind = 1; u.pm = r & 3; u.pn = r >> 2; u.a = W1T + (size_t)(22 + u.pm) * TSTEP; u.b = HN + (size_t)u.pn * TSTEP;
        } else if (L < 840) { const int r = (int)L - 832;
            u.kind = 2; u.pm = r & 3; u.pn = r >> 2; u.a = MEMN + (size_t)u.pm * TSTEP; u.b = WKVT + (size_t)u.pn * TSTEP;
        } else { const int r = (int)L - 840;
            u.kind = 3; u.pm = r & 1; u.pn = r >> 1; u.a = WKVT + (size_t)(2 + u.pm) * TSTEP; u.b = MEMN + (size_t)u.pn * TSTEP; }
        return true;
    }
    __device__ __forceinline__ void a_ready(const pg8::Unit&) const {}
    __device__ __forceinline__ void done(const pg8::Unit&) const {}
};
struct EpiP1 {
    static constexpr bool PERM = true, AFTER_DRAIN = false;
    unsigned char* ws;
    __device__ __forceinline__ void operator()(const pg8::f32x4 (&acc)[2][2][4][2], const pg8::Unit& u, int wr, int wc, int fr, int fq) const {
        bf16* base; int ldc, op = 0, colt; float sc = 1.f;
        if (u.kind == 0) { const int pn = u.pn;
            if (pn < 4) { base = (bf16*)(ws + WS_Q); ldc = 1024; colt = pn * 256; op = 2; sc = C2Q; }
            else if (pn < 8) { base = (bf16*)(ws + WS_K); ldc = 1024; colt = (pn - 4) * 256; op = 2; }
            else if (pn < 12) { base = (bf16*)(ws + WS_G); ldc = 1024; colt = (pn - 8) * 256; op = 1; }
            else if (pn < 14) { base = (bf16*)(ws + WS_Z); ldc = 512; colt = (pn - 12) * 256; op = 1; }
            else if (pn < 18) { base = (bf16*)(ws + WS_XBC); ldc = 1024; colt = (pn - 14) * 256; }
            else if (pn < 20) { base = (bf16*)(ws + WS_XQ); ldc = 512; colt = (pn - 18) * 256; sc = C2X; }
            else { base = (bf16*)(ws + WS_XG); ldc = 512; colt = (pn - 20) * 256; op = 1; }
        } else if (u.kind == 1) { base = (bf16*)(ws + WS_VT); ldc = M; colt = u.pn * 256; }
        else if (u.kind == 2) { base = (bf16*)(ws + WS_MK); ldc = 512; colt = u.pn * 256; }
        else { base = (bf16*)(ws + WS_MVT); ldc = MM; colt = u.pn * 256; }
        const int row0 = u.pm * 256 + wr * 64 + fr, col0 = colt + wc * 32 + 8 * fq;
        const float* rope = (const float*)(ws + WS_ROPE); const int i0 = 8 * (wc & 1) + 2 * fq;
#pragma unroll
        for (int ai = 0; ai < 2; ++ai)
#pragma unroll
            for (int m = 0; m < 4; ++m) { const int row = row0 + ai * 128 + m * 16; bf16* rowp = base + (size_t)row * ldc + col0;
                f32x4 cs0 = {1.f, 0.f, 1.f, 0.f}, cs1 = {1.f, 0.f, 1.f, 0.f};
                if (op == 2) { cs0 = *(const f32x4*)(rope + ((size_t)row * 32 + 2 * i0) * 2); cs1 = *(const f32x4*)(rope + ((size_t)row * 32 + 2 * i0 + 2) * 2); }
#pragma unroll
                for (int bj = 0; bj < 2; ++bj) { f32x4 v0 = acc[ai][bj][m][0], v1 = acc[ai][bj][m][1];
                    if (op == 1) { v0 = (f32x4){silu_f(v0[0]), silu_f(v0[1]), silu_f(v0[2]), silu_f(v0[3])}; v1 = (f32x4){silu_f(v1[0]), silu_f(v1[1]), silu_f(v1[2]), silu_f(v1[3])}; }
                    if (op == 2) {
                        v0 = (f32x4){v0[0] * cs0[0] - v0[2] * cs0[1], v0[1] * cs0[2] - v0[3] * cs0[3], v0[2] * cs0[0] + v0[0] * cs0[1], v0[3] * cs0[2] + v0[1] * cs0[3]};
                        v1 = (f32x4){v1[0] * cs1[0] - v1[2] * cs1[1], v1[1] * cs1[2] - v1[3] * cs1[3], v1[2] * cs1[0] + v1[0] * cs1[1], v1[3] * cs1[2] + v1[1] * cs1[3]}; }
                    v0 = v0 * sc; v1 = v1 * sc;
                    v4u w; w.x = pg8::cvt_pk_bf16(v0[0], v0[1]); w.y = pg8::cvt_pk_bf16(v0[2], v0[3]); w.z = pg8::cvt_pk_bf16(v1[0], v1[1]); w.w = pg8::cvt_pk_bf16(v1[2], v1[3]);
                    *(v4u*)(rowp + bj * 128) = w; } }
    }
};
namespace att {
constexpr int STAGE = 32768;
__device__ __forceinline__ int k_off(int row, int ch) { return row * 256 + ((ch ^ (row & 15)) << 4); }
__device__ __forceinline__ int v_off(int row, int ch) { return 16384 + (row >> 1) * 256 + ((((row & 1) << 3) | (ch ^ ((row >> 1) & 7))) << 4); }
__device__ __forceinline__ int pi32(int i) { return (i & 0x13) | ((i & 4) << 1) | ((i & 8) >> 1); }
__device__ __forceinline__ float other_half(float v) {
    return __shfl_xor(v, 32);
}
__device__ __forceinline__ unsigned cvtpk(float lo, float hi) { typedef float f2 __attribute__((ext_vector_type(2))); typedef __bf16 b2 __attribute__((ext_vector_type(2))); f2 v = {lo, hi}; b2 b = __builtin_convertvector(v, b2); return __builtin_bit_cast(unsigned, b); }
struct StageRegs { v4u k[2], v[2]; };
__device__ __forceinline__ void stage_load(StageRegs& s, const bf16* Kp, int ldk, const bf16* VTp, int ldv, int kv0, int tid) {
#pragma unroll
    for (int i = 0; i < 2; ++i) { const int ci = tid + i * NTHR;
        s.k[i] = *(const GAS v4u*)(Kp + (size_t)(kv0 + (ci >> 4)) * ldk + (ci & 15) * 8);
        s.v[i] = *(const GAS v4u*)(VTp + (size_t)(ci >> 3) * ldv + kv0 + (ci & 7) * 8); }
}
__device__ __forceinline__ void stage_store(const StageRegs& s, LAS unsigned char* buf, int tid) {
#pragma unroll
    for (int i = 0; i < 2; ++i) { const int ci = tid + i * NTHR;
        *(LAS v4u*)(buf + k_off(ci >> 4, ci & 15)) = s.k[i];
        *(LAS v4u*)(buf + v_off(ci >> 3, ci & 7)) = s.v[i]; }
}
template <int KSTEPS, bool CAUSAL>
__device__ __forceinline__ void attn_core(LAS unsigned char* lds, const bf16* Qw, int ldq, const bf16* Kp, int ldk, const bf16* VTp, int ldv, int ntiles, int q0rel, int coff,
                                          f32x16 (&o)[4], float& m_out, float& l_out, int tid, int lane) {
    const int r32 = lane & 31, hi = lane >> 5;
    bf16x8 qf[KSTEPS];
#pragma unroll
    for (int ks = 0; ks < KSTEPS; ++ks) qf[ks] = *(const GAS bf16x8*)(Qw + (size_t)r32 * ldq + ks * 16 + hi * 8);
#pragma unroll
    for (int d = 0; d < 4; ++d)
#pragma unroll
        for (int r = 0; r < 16; ++r) o[d][r] = 0.f;
    float m = -1e30f, l = 0.f;
    const int krow = pi32(r32), kch0 = (coff >> 3) + hi;
    StageRegs sr;
    stage_load(sr, Kp, ldk, VTp, ldv, 0, tid);
    stage_store(sr, lds, tid);
    __syncthreads();
    for (int t = 0; t < ntiles; ++t) {
        LAS unsigned char* buf = lds + (t & 1) * STAGE;
        const bool more = (t + 1 < ntiles);
        if (more) stage_load(sr, Kp, ldk, VTp, ldv, (t + 1) * 64, tid);
        const int kv0 = t * 64;
        const bool active = !CAUSAL || (kv0 <= q0rel + 31);
        if (active) {
            f32x16 p0, p1;
#pragma unroll
            for (int r = 0; r < 16; ++r) { p0[r] = 0.f; p1[r] = 0.f; }
#pragma unroll
            for (int ks = 0; ks < KSTEPS; ++ks) {
                const bf16x8 a0 = *(const LAS bf16x8*)(buf + k_off(krow, kch0 + 2 * ks));
                const bf16x8 a1 = *(const LAS bf16x8*)(buf + k_off(32 + krow, kch0 + 2 * ks));
                p0 = __builtin_amdgcn_mfma_f32_32x32x16_bf16(a0, qf[ks], p0, 0, 0, 0);
                p1 = __builtin_amdgcn_mfma_f32_32x32x16_bf16(a1, qf[ks], p1, 0, 0, 0);
            }
            if (CAUSAL && (kv0 + 63 > q0rel)) {
                const int qg = q0rel + r32;
#pragma unroll
                for (int r = 0; r < 16; ++r) { const int kv = kv0 + 16 * (r >> 3) + 8 * hi + (r & 7); if (kv > qg) p0[r] = -INFINITY; if (kv + 32 > qg) p1[r] = -INFINITY; }
            }
            float rm = fmaxf(p0[0], p1[0]);
#pragma unroll
            for (int r = 1; r < 16; ++r) rm = fmaxf(rm, fmaxf(p0[r], p1[r]));
            rm = fmaxf(rm, other_half(rm));
            if (__any(rm > m + 8.f)) {
                const float mn = fmaxf(m, rm), al = __builtin_amdgcn_exp2f(m - mn);
                l *= al; m = mn;
#pragma unroll
                for (int d = 0; d < 4; ++d)
#pragma unroll
                    for (int r = 0; r < 16; ++r) o[d][r] *= al;
            }
            float ls = 0.f;
#pragma unroll
            for (int r = 0; r < 16; ++r) { p0[r] = __builtin_amdgcn_exp2f(p0[r] - m); p1[r] = __builtin_amdgcn_exp2f(p1[r] - m); ls += p0[r] + p1[r]; }
            l += ls;
            v4u pw[4];
#pragma unroll
            for (int s = 0; s < 2; ++s) {
                pw[s] = (v4u){cvtpk(p0[8 * s], p0[8 * s + 1]), cvtpk(p0[8 * s + 2], p0[8 * s + 3]), cvtpk(p0[8 * s + 4], p0[8 * s + 5]), cvtpk(p0[8 * s + 6], p0[8 * s + 7])};
                pw[2 + s] = (v4u){cvtpk(p1[8 * s], p1[8 * s + 1]), cvtpk(p1[8 * s + 2], p1[8 * s + 3]), cvtpk(p1[8 * s + 4], p1[8 * s + 5]), cvtpk(p1[8 * s + 6], p1[8 * s + 7])};
            }
#pragma unroll
            for (int d = 0; d < 4; ++d)
#pragma unroll
                for (int ks = 0; ks < 4; ++ks) {
                    const bf16x8 vf = *(const LAS bf16x8*)(buf + v_off(32 * d + r32, 2 * ks + hi));
                    o[d] = __builtin_amdgcn_mfma_f32_32x32x16_bf16(vf, __builtin_bit_cast(bf16x8, pw[ks]), o[d], 0, 0, 0);
                }
        }
        if (more) stage_store(sr, lds + ((t + 1) & 1) * STAGE, tid);
        __syncthreads();
    }
    m_out = m; l_out = l + other_half(l);
}
__device__ __forceinline__ int crow(int r, int hi) { return (r & 3) + 8 * (r >> 2) + 4 * hi; }

__device__ __forceinline__ void diff_unit(Frame& F, int b, int h, int qb, float lam) {
    unsigned char* ws = F.ws; int tid_ = F.tid; asm volatile("" : "+v"(tid_)); const int w = F.wave, c = w >> 2, sb = w & 3, lane = tid_ & 63, r32 = lane & 31, hi = lane >> 5;
    const int q0 = qb * 128, q0w = q0 + 32 * sb; const size_t trow0 = (size_t)b * SEQ;
    const bf16* Qw = (const bf16*)(ws + WS_Q) + (trow0 + q0w) * 1024 + h * 128 + c * 64;
    const bf16* Kp = (const bf16*)(ws + WS_K) + trow0 * 1024 + h * 128;
    const bf16* VTp = (const bf16*)(ws + WS_VT) + (size_t)(h * 128) * M + trow0;
    f32x16 o[4]; float m, l;
    attn_core<4, true>(F.lds, Qw, 1024, Kp, 1024, VTp, M, (q0 + 128) / 64, q0w, c * 64, o, m, l, tid_, lane);
    const float inv = 1.f / l;
    LAS float* xch = (LAS float*)F.lds + sb * 4096 + lane;
    if (c == 1) {
        const float f = lam * inv;
#pragma unroll
        for (int d = 0; d < 4; ++d)
#pragma unroll
            for (int r = 0; r < 16; ++r) xch[(d * 16 + r) * 64] = o[d][r] * f;
    }
    __syncthreads();
    if (c == 0) {
        float ss = 0.f;
#pragma unroll
        for (int d = 0; d < 4; ++d)
#pragma unroll
            for (int r = 0; r < 16; ++r) { const float v = o[d][r] * inv - xch[(d * 16 + r) * 64]; o[d][r] = v; ss += v * v; }
        ss += other_half(ss);
        const float rs = rsqrtf(ss * (1.f / 128.f) + EPS) * (1.f - LAMBDA_INIT);
        const size_t t = trow0 + q0w + r32;
        const bf16* Gp = (const bf16*)(ws + WS_G) + t * 1024 + h * 128; bf16* Op = (bf16*)(ws + WS_MIXED) + t * 2048 + h * 128;
        const float* sw = F.in[9];
#pragma unroll
        for (int d = 0; d < 4; ++d)
#pragma unroll
            for (int rg = 0; rg < 4; ++rg) { const int dv = 32 * d + 8 * rg + 4 * hi;
                const v2u g = *(const GAS v2u*)(Gp + dv); const f32x4 wv = *(const GAS f32x4*)(sw + dv);
                v2u ov; ov.x = pk2(o[d][4 * rg] * rs * wv[0] * bflo(g.x), o[d][4 * rg + 1] * rs * wv[1] * bfhi(g.x));
                ov.y = pk2(o[d][4 * rg + 2] * rs * wv[2] * bflo(g.y), o[d][4 * rg + 3] * rs * wv[3] * bfhi(g.y));
                *(GAS v2u*)(Op + dv) = ov; }
    }
    __syncthreads();
}
__device__ __forceinline__ void xattn_unit(Frame& F, int b, int h, int qb) {
    unsigned char* ws = F.ws; int tid_ = F.tid; asm volatile("" : "+v"(tid_)); const int w = F.wave, lane = tid_ & 63, r32 = lane & 31, hi = lane >> 5;
    const int q0w = qb * 256 + 32 * w; const size_t trow0 = (size_t)b * SEQ;
    const bf16* Qw = (const bf16*)(ws + WS_XQ) + (trow0 + q0w) * 512 + h * 128;
    const bf16* Kp = (const bf16*)(ws + WS_MK) + (size_t)(b * MEMLEN) * 512 + h * 128;
    const bf16* VTp = (const bf16*)(ws + WS_MVT) + (size_t)(h * 128) * MM + b * MEMLEN;
    f32x16 o[4]; float m, l;
    attn_core<8, false>(F.lds, Qw, 512, Kp, 512, VTp, MM, MEMLEN / 64, 0, 0, o, m, l, tid_, lane);
    const float inv = 1.f / l; const size_t t = trow0 + q0w + r32;
    const bf16* Gp = (const bf16*)(ws + WS_XG) + t * 512 + h * 128; bf16* Op = (bf16*)(ws + WS_MIXED) + t * 2048 + 1536 + h * 128;
#pragma unroll
    for (int d = 0; d < 4; ++d)
#pragma unroll
        for (int rg = 0; rg < 4; ++rg) { const int dv = 32 * d + 8 * rg + 4 * hi;
            const v2u g = *(const GAS v2u*)(Gp + dv);
            v2u ov; ov.x = pk2(o[d][4 * rg] * inv * bflo(g.x), o[d][4 * rg + 1] * inv * bfhi(g.x));
            ov.y = pk2(o[d][4 * rg + 2] * inv * bflo(g.y), o[d][4 * rg + 3] * inv * bfhi(g.y));
            *(GAS v2u*)(Op + dv) = ov; }
}
}
namespace ssd {
using att::k_off; using att::pi32; using att::crow; using att::other_half;
__device__ __forceinline__ v4u pack8(const float (&s)[8]) { return (v4u){att::cvtpk(s[0], s[1]), att::cvtpk(s[2], s[3]), att::cvtpk(s[4], s[5]), att::cvtpk(s[6], s[7])}; }
__device__ __forceinline__ void unitA(Frame& F, int b, int c, int g) {
    unsigned char* ws = F.ws; int tid_ = F.tid; asm volatile("" : "+v"(tid_)); const int tid = tid_, lane = tid & 63, w = F.wave, r32 = lane & 31, hi = lane >> 5;
    const size_t t0 = (size_t)b * SEQ + c * 128;
    LAS unsigned char* tile = F.lds;
    LAS float* tab = (LAS float*)(F.lds + 98304);
    const float* DTg = (const float*)(ws + WS_DT); float* ACSg = (float*)(ws + WS_ACS);
    { const int hh = tid >> 7, l = tid & 127, h = g * 4 + hh;
      const float dt = DTg[(t0 + l) * 8 + h]; float v = dt * (-__expf(F.in[13][h]));
#pragma unroll
      for (int o = 1; o < 64; o <<= 1) { const float t = __shfl_up(v, o); if (lane >= o) v += t; }
      if ((w & 1) == 0 && lane == 63) tab[1536 + hh] = v;
      __syncthreads();
      if (w & 1) v += tab[1536 + hh];
      tab[hh * 128 + l] = dt; tab[512 + hh * 128 + l] = v; ACSg[(t0 + l) * 8 + h] = v;
      __syncthreads();
      tab[1024 + hh * 128 + l] = dt * __expf(tab[512 + hh * 128 + 127] - v);
      __syncthreads(); }
    { const int ch = tid; const int col = (ch < 256) ? g * 256 + ch : (ch < 384) ? 512 + g * 128 + (ch - 256) : 768 + g * 128 + (ch - 384);
      const float* cw = F.in[10]; const float w0 = cw[col], w1 = cw[1024 + col], w2 = cw[2048 + col], w3 = cw[3072 + col], bias = F.in[11][col];
      const bf16* src = (const bf16*)(ws + WS_XBC) + t0 * 1024 + col;
      float xx[11]; xx[0] = xx[1] = xx[2] = 0.f;
      if (c > 0) { xx[0] = bf2f(src[-3 * 1024]); xx[1] = bf2f(src[-2 * 1024]); xx[2] = bf2f(src[-1 * 1024]); }
      bf16* XTg = (bf16*)(ws + WS_XT) + ((size_t)(b * 16 + c) * 512 + g * 256 + ch) * 128;
      bf16* BCg = (bf16*)(ws + WS_BC) + t0 * 512 + ((ch < 384) ? g * 128 + (ch - 256) : 256 + g * 128 + (ch - 384));
      const int hh = (ch >> 6) & 3;
#pragma unroll 1
      for (int lg = 0; lg < 16; ++lg) {
#pragma unroll
          for (int j = 0; j < 8; ++j) xx[3 + j] = bf2f(src[(size_t)(lg * 8 + j) * 1024]);
          float s[8];
#pragma unroll
          for (int j = 0; j < 8; ++j) { const float y = bias + w0 * xx[j] + w1 * xx[j + 1] + w2 * xx[j + 2] + w3 * xx[j + 3]; s[j] = y / (1.f + __expf(-y)); }
          xx[0] = xx[8]; xx[1] = xx[9]; xx[2] = xx[10];
          if (ch < 256) {
              *(GAS v4u*)(XTg + lg * 8) = pack8(s);
              const f32x4 wa = *(const LAS f32x4*)(tab + 1024 + hh * 128 + lg * 8), wb = *(const LAS f32x4*)(tab + 1024 + hh * 128 + lg * 8 + 4);
              float sw[8] = {s[0] * wa[0], s[1] * wa[1], s[2] * wa[2], s[3] * wa[3], s[4] * wb[0], s[5] * wb[1], s[6] * wb[2], s[7] * wb[3]};
              *(LAS v4u*)(tile + k_off(ch, lg)) = pack8(sw);
          } else {
#pragma unroll
              for (int j = 0; j < 8; ++j) BCg[(size_t)(lg * 8 + j) * 512] = (bf16)f2bf(s[j]);
              if (ch < 384) *(LAS v4u*)(tile + k_off(ch, lg)) = pack8(s);
          }
      } }
    __syncthreads();
    { const int hh = w >> 1, nh = w & 1;
      f32x16 acc[2][2];
#pragma unroll
      for (int i = 0; i < 2; ++i)
#pragma unroll
          for (int j = 0; j < 2; ++j)
#pragma unroll
              for (int r = 0; r < 16; ++r) acc[i][j][r] = 0.f;
#pragma unroll
      for (int ks = 0; ks < 8; ++ks) {
          const bf16x8 a0 = *(const LAS bf16x8*)(tile + k_off(hh * 64 + r32, 2 * ks + hi)), a1 = *(const LAS bf16x8*)(tile + k_off(hh * 64 + 32 + r32, 2 * ks + hi));
          const bf16x8 b0 = *(const LAS bf16x8*)(tile + k_off(256 + nh * 64 + r32, 2 * ks + hi)), b1 = *(const LAS bf16x8*)(tile + k_off(256 + nh * 64 + 32 + r32, 2 * ks + hi));
          acc[0][0] = __builtin_amdgcn_mfma_f32_32x32x16_bf16(a0, b0, acc[0][0], 0, 0, 0); acc[0][1] = __builtin_amdgcn_mfma_f32_32x32x16_bf16(a0, b1, acc[0][1], 0, 0, 0);
          acc[1][0] = __builtin_amdgcn_mfma_f32_32x32x16_bf16(a1, b0, acc[1][0], 0, 0, 0); acc[1][1] = __builtin_amdgcn_mfma_f32_32x32x16_bf16(a1, b1, acc[1][1], 0, 0, 0);
      }
      float* cs = (float*)(ws + WS_CS) + (size_t)((b * 16 + c) * 8 + g * 4 + hh) * 8192;
#pragma unroll
      for (int pb = 0; pb < 2; ++pb)
#pragma unroll
          for (int nb = 0; nb < 2; ++nb)
#pragma unroll
              for (int r = 0; r < 16; ++r) cs[(32 * pb + crow(r, hi)) * 128 + nh * 64 + 32 * nb + r32] = acc[pb][nb][r]; }
    __syncthreads();
}

__device__ __forceinline__ void unitB(Frame& F, int b, int c, int g) {
    unsigned char* ws = F.ws; int tid_ = F.tid; asm volatile("" : "+v"(tid_)); const int tid = tid_, lane = tid & 63, w = F.wave, r32 = lane & 31, hi = lane >> 5;
    const size_t t0 = (size_t)b * SEQ + c * 128;
    LAS unsigned char* ptile = F.lds;
    LAS float* tab = (LAS float*)(F.lds + 65536);
    const float* DTg = (const float*)(ws + WS_DT); const float* ACSg = (const float*)(ws + WS_ACS);
    { const int hh = tid >> 7, l = tid & 127; tab[hh * 128 + l] = DTg[(t0 + l) * 8 + g * 4 + hh]; tab[512 + hh * 128 + l] = ACSg[(t0 + l) * 8 + g * 4 + hh]; }
    { f32x4 acc[4][4]; float wgt[4];
#pragma unroll
      for (int hh = 0; hh < 4; ++hh) { wgt[hh] = 1.f;
#pragma unroll
          for (int j = 0; j < 4; ++j) acc[hh][j] = (f32x4){0.f, 0.f, 0.f, 0.f}; }
      for (int cp = c - 1; cp >= 0; --cp) {
#pragma unroll
          for (int hh = 0; hh < 4; ++hh) {
              if (wgt[hh] > 1e-30f) { const float* src = (const float*)(ws + WS_CS) + (size_t)((b * 16 + cp) * 8 + g * 4 + hh) * 8192;
#pragma unroll
                  for (int j = 0; j < 4; ++j) acc[hh][j] += *(const GAS f32x4*)(src + 4 * (tid + 512 * j)) * wgt[hh]; }
              wgt[hh] *= __expf(ACSg[((size_t)b * SEQ + cp * 128 + 127) * 8 + g * 4 + hh]); }
      }
#pragma unroll
      for (int hh = 0; hh < 4; ++hh)
#pragma unroll
          for (int j = 0; j < 4; ++j) { const int e = 4 * (tid + 512 * j), p = e >> 7, n = e & 127;
              v2u o; o.x = att::cvtpk(acc[hh][j][0], acc[hh][j][1]); o.y = att::cvtpk(acc[hh][j][2], acc[hh][j][3]);
              *(LAS v2u*)(ptile + k_off(hh * 64 + p, n >> 3) + (n & 7) * 2) = o; } }
    __syncthreads();
    const int lb = w & 3, hp = w >> 2, l_loc = 32 * lb + r32;
    const bf16* BCg = (const bf16*)(ws + WS_BC) + t0 * 512;
    bf16x8 cf[8];
#pragma unroll
    for (int ks = 0; ks < 8; ++ks) cf[ks] = *(const GAS bf16x8*)(BCg + (size_t)l_loc * 512 + 256 + g * 128 + 16 * ks + 8 * hi);
    f32x16 acc[2][2];
#pragma unroll
    for (int hh2 = 0; hh2 < 2; ++hh2)
#pragma unroll
        for (int pb = 0; pb < 2; ++pb) {
#pragma unroll
            for (int r = 0; r < 16; ++r) acc[hh2][pb][r] = 0.f;
            if (c > 0) {
#pragma unroll
                for (int ks = 0; ks < 8; ++ks) { const bf16x8 a = *(const LAS bf16x8*)(ptile + k_off((2 * hp + hh2) * 64 + 32 * pb + r32, 2 * ks + hi));
                    acc[hh2][pb] = __builtin_amdgcn_mfma_f32_32x32x16_bf16(a, cf[ks], acc[hh2][pb], 0, 0, 0); }
                const float e = __expf(tab[512 + (2 * hp + hh2) * 128 + l_loc]);
#pragma unroll
                for (int r = 0; r < 16; ++r) acc[hh2][pb][r] *= e;
            }
        }
    const bf16* XTg = (const bf16*)(ws + WS_XT) + ((size_t)(b * 16 + c) * 512 + g * 256) * 128;
    for (int sb = 0; sb <= lb; ++sb) {
        f32x16 gt;
#pragma unroll
        for (int r = 0; r < 16; ++r) gt[r] = 0.f;
        const bf16* brow = BCg + (size_t)(32 * sb + pi32(r32)) * 512 + g * 128 + 8 * hi;
#pragma unroll
        for (int ks = 0; ks < 8; ++ks) { const bf16x8 bfr = *(const GAS bf16x8*)(brow + 16 * ks); gt = __builtin_amdgcn_mfma_f32_32x32x16_bf16(bfr, cf[ks], gt, 0, 0, 0); }
#pragma unroll
        for (int hh2 = 0; hh2 < 2; ++hh2) { const int hh = 2 * hp + hh2; const float acs_l = tab[512 + hh * 128 + l_loc], Dh = F.in[14][g * 4 + hh];
            float sc[16];
#pragma unroll
            for (int q4 = 0; q4 < 4; ++q4) { const int sbase = 32 * sb + 16 * (q4 >> 1) + 8 * hi + 4 * (q4 & 1);
                const f32x4 as = *(const LAS f32x4*)(tab + 512 + hh * 128 + sbase), ds = *(const LAS f32x4*)(tab + hh * 128 + sbase);
#pragma unroll
                for (int e = 0; e < 4; ++e) { const int r = 4 * q4 + e; float v = gt[r] * __builtin_amdgcn_exp2f(fminf(acs_l - as[e], 0.f) * LOG2E) * ds[e];
                    if (sb == lb) { const int sl = 16 * (r >> 3) + 8 * hi + (r & 7); if (sl > r32) v = 0.f; if (sl == r32) v += Dh; }
                    sc[r] = v; } }
            v4u scb[2];
            scb[0] = (v4u){att::cvtpk(sc[0], sc[1]), att::cvtpk(sc[2], sc[3]), att::cvtpk(sc[4], sc[5]), att::cvtpk(sc[6], sc[7])};
            scb[1] = (v4u){att::cvtpk(sc[8], sc[9]), att::cvtpk(sc[10], sc[11]), att::cvtpk(sc[12], sc[13]), att::cvtpk(sc[14], sc[15])};
#pragma unroll
            for (int pb = 0; pb < 2; ++pb)
#pragma unroll
                for (int k2 = 0; k2 < 2; ++k2) { const bf16x8 xf = *(const GAS bf16x8*)(XTg + (size_t)(hh * 64 + 32 * pb + r32) * 128 + 32 * sb + 16 * k2 + 8 * hi);
                    acc[hh2][pb] = __builtin_amdgcn_mfma_f32_32x32x16_bf16(xf, __builtin_bit_cast(bf16x8, scb[k2]), acc[hh2][pb], 0, 0, 0); }
        }
    }
    const size_t t = t0 + l_loc; const bf16* Zg = (const bf16*)(ws + WS_Z) + t * 512 + g * 256;
    float ss = 0.f;
#pragma unroll
    for (int hh2 = 0; hh2 < 2; ++hh2)
#pragma unroll
        for (int pb = 0; pb < 2; ++pb)
#pragma unroll
            for (int rg = 0; rg < 4; ++rg) { const int ch = (2 * hp + hh2) * 64 + 32 * pb + 8 * rg + 4 * hi; const v2u z = *(const GAS v2u*)(Zg + ch);
                const float y0 = acc[hh2][pb][4 * rg] * bflo(z.x), y1 = acc[hh2][pb][4 * rg + 1] * bfhi(z.x), y2 = acc[hh2][pb][4 * rg + 2] * bflo(z.y), y3 = acc[hh2][pb][4 * rg + 3] * bfhi(z.y);
                acc[hh2][pb][4 * rg] = y0; acc[hh2][pb][4 * rg + 1] = y1; acc[hh2][pb][4 * rg + 2] = y2; acc[hh2][pb][4 * rg + 3] = y3;
                ss += (y0 * y0 + y1 * y1) + (y2 * y2 + y3 * y3); }
    ss += other_half(ss);
    if (hi == 0) tab[1024 + hp * 128 + l_loc] = ss;
    __syncthreads();
    const float rs = rsqrtf((tab[1024 + l_loc] + tab[1024 + 128 + l_loc]) * (1.f / 256.f) + EPS);
    bf16* Og = (bf16*)(ws + WS_MIXED) + t * 2048 + 1024 + g * 256; const float* nw = F.in[15] + g * 256;
#pragma unroll
    for (int hh2 = 0; hh2 < 2; ++hh2)
#pragma unroll
        for (int pb = 0; pb < 2; ++pb)
#pragma unroll
            for (int rg = 0; rg < 4; ++rg) { const int ch = (2 * hp + hh2) * 64 + 32 * pb + 8 * rg + 4 * hi; const f32x4 wv = *(const GAS f32x4*)(nw + ch);
                v2u o; o.x = pk2(acc[hh2][pb][4 * rg] * rs * wv[0], acc[hh2][pb][4 * rg + 1] * rs * wv[1]); o.y = pk2(acc[hh2][pb][4 * rg + 2] * rs * wv[2], acc[hh2][pb][4 * rg + 3] * rs * wv[3]);
                *(GAS v2u*)(Og + ch) = o; }
    __syncthreads();
}
}
struct Sched2 {
    int G, c; const char *A, *B;
    __device__ __forceinline__ bool next(int i, pg8::Unit& u) const {
        const long L = (long)i * G + c; if (L >= 256) return false;
        int wgid = (int)L; { const int xcd = wgid % 8, off = wgid / 8; wgid = xcd * 32 + off; }
        u.pm = (wgid / 64) * 8 + ((wgid % 64) % 8); u.pn = (wgid % 64) / 8; u.kind = 0;
        u.a = A + (size_t)u.pm * TSTEP; u.b = B + (size_t)u.pn * TSTEP; return true;
    }
    __device__ __forceinline__ void a_ready(const pg8::Unit&) const {}
    __device__ __forceinline__ void done(const pg8::Unit&) const {}
};
struct EpiF32 {
    static constexpr bool PERM = false, AFTER_DRAIN = false;
    float* O; int ldc;
    __device__ __forceinline__ void operator()(const pg8::f32x4 (&acc)[2][2][4][2], const pg8::Unit& u, int wr, int wc, int fr, int fq) const {
        const int row0 = u.pm * 256 + wr * 64 + fr, col0 = u.pn * 256 + wc * 32 + 4 * fq;
#pragma unroll
        for (int ai = 0; ai < 2; ++ai)
#pragma unroll
            for (int m = 0; m < 4; ++m) { float* rowp = O + (size_t)(row0 + ai * 128 + m * 16) * ldc + col0;
#pragma unroll
                for (int bj = 0; bj < 2; ++bj)
#pragma unroll
                    for (int n = 0; n < 2; ++n) *(pg8::f32x4*)(rowp + bj * 128 + n * 16) = acc[ai][bj][m][n]; }
    }
};
__device__ __forceinline__ void p5_final(Frame& F) {
    const int gw = F.vcu * NWAVES + F.wave, NGW = F.G * NWAVES;
    const float* o2 = (const float*)(F.ws + WS_O2); const GAS f32x4* wr = (const GAS f32x4*)F.in[19] + F.lane;
    for (int mrow = gw; mrow < M; mrow += NGW) {
        const GAS f32x4* orow = (const GAS f32x4*)(o2 + (size_t)mrow * DM) + F.lane; const GAS f32x4* xr = (const GAS f32x4*)(F.in[0] + (size_t)mrow * DM) + F.lane;
        GAS f32x4* outr = (GAS f32x4*)(F.out + (size_t)mrow * DM) + F.lane;
        f32x4 v[8]; float s = 0.f;
#pragma unroll
        for (int j = 0; j < 8; ++j) { v[j] = orow[64 * j]; s += (v[j].x * v[j].x + v[j].y * v[j].y) + (v[j].z * v[j].z + v[j].w * v[j].w); }
        const float rstd = rsqrtf(wave_sum(s) * (1.f / DM) + EPS);
#pragma unroll
        for (int j = 0; j < 8; ++j) outr[64 * j] = xr[64 * j] + v[j] * rstd * wr[64 * j];
    }
}
struct Args { const float* in[20]; float* out; unsigned char* ws; int ph_lo, ph_hi; };
__global__ void __launch_bounds__(NTHR, 2) mega(Args args) {
    extern __shared__ __attribute__((aligned(16))) unsigned char lds[];
    Frame F;
    F.lds = (LAS unsigned char*)lds;
    F.tid = threadIdx.x; F.lane = F.tid & 63; F.wave = __builtin_amdgcn_readfirstlane(F.tid >> 6);
    F.G = gridDim.x; { const int bx = blockIdx.x; F.vcu = (F.G % 8 == 0) ? (bx % 8) * (F.G / 8) + bx / 8 : bx; }
#pragma unroll
    for (int i = 0; i < 20; ++i) F.in[i] = args.in[i];
    F.out = args.out; F.ws = args.ws;
    const int lo = args.ph_lo, hi = args.ph_hi;
#define IN(k) (lo <= (k) && (k) < hi)
    if (IN(0)) { p0_prologue(F); }
    if (IN(1)) {
        pg8::Gemm g{DM}; Sched1 S{F.G, (int)blockIdx.x, (const char*)(F.ws + WS_HN), (const char*)(F.ws + WS_W1T), (const char*)(F.ws + WS_MEMN), (const char*)(F.ws + WS_WKVT)};
        EpiP1 E{F.ws};
        pg8::gemm_phase<EpiP1, Sched1, true, true>(F.lds, g, S, E);
    }
    if (IN(2)) {
        for (int u = F.vcu; u < 256; u += F.G) { if (u < 128) att::xattn_unit(F, u >> 5, (u >> 3) & 3, u & 7); else { const int v = u - 128; ssd::unitA(F, v >> 5, (v >> 1) & 15, v & 1); } }
    }
    if (IN(3)) {
        const float d1 = wave_sum(F.lane < 64 ? F.in[5][F.lane] * F.in[6][F.lane] : 0.f), d2 = wave_sum(F.in[7][F.lane] * F.in[8][F.lane]);
        const float lam = __expf(d1) - __expf(d2) + LAMBDA_INIT;
        for (int v = F.vcu; v < 256; v += F.G) { const int bh = v >> 3, s = v & 7;
            att::diff_unit(F, bh >> 3, bh & 7, s, lam); att::diff_unit(F, bh >> 3, bh & 7, 15 - s, lam); }
        for (int v = F.vcu; v < 128; v += F.G) ssd::unitB(F, v >> 5, (v >> 1) & 15, v & 1);
    }
    if (IN(4)) {
        pg8::Gemm g{DM}; Sched2 S{F.G, (int)blockIdx.x, (const char*)(F.ws + WS_MIXED), (const char*)(F.ws + WS_WOT)};
        EpiF32 E{(float*)(F.ws + WS_O2), DM};
        pg8::gemm_phase<EpiF32, Sched2, false, true>(F.lds, g, S, E);
    }
    if (IN(5)) p5_final(F);
#undef IN
}
constexpr int LDS_BYTES = 147456;
extern "C" void kernel_launch(void* const* d_in, const int* in_sizes, int n_in, void* d_out, int out_size, void* d_ws, size_t ws_size, hipStream_t stream) {
    static int grid = 0;
    if (grid == 0) {
        if (n_in != 20 || in_sizes[0] != M * DM || out_size != M * DM || ws_size < WS_END) { fprintf(stderr, "kernel_launch: unexpected shapes (n_in %d, ws %zu)\n", n_in, ws_size); grid = -1; return; }
        int dev = 0, cus = 0, per_cu = 0;
        (void)hipGetDevice(&dev); (void)hipDeviceGetAttribute(&cus, hipDeviceAttributeMultiprocessorCount, dev);
        (void)hipFuncSetAttribute((const void*)mega, hipFuncAttributeMaxDynamicSharedMemorySize, LDS_BYTES);
        (void)hipOccupancyMaxActiveBlocksPerMultiprocessor(&per_cu, (const void*)mega, NTHR, LDS_BYTES);
        if (per_cu < 1) { fprintf(stderr, "kernel_launch: occupancy query says %d\n", per_cu); per_cu = 1; }
        (void)hipGetLastError();
        grid = cus;
    }
    if (grid < 0) return;
    unsigned char* ws = (unsigned char*)d_ws;
    Args a{};
    for (int i = 0; i < 20; ++i) a.in[i] = (const float*)d_in[i];
    a.out = (float*)d_out; a.ws = ws;
    a.ph_lo = 0; a.ph_hi = 1; hipLaunchKernelGGL(mega, dim3(grid), dim3(NTHR), LDS_BYTES, stream, a);
    a.ph_lo = 1; a.ph_hi = 2; hipLaunchKernelGGL(mega, dim3(grid), dim3(NTHR), LDS_BYTES, stream, a);
    a.ph_lo = 2; a.ph_hi = 3; hipLaunchKernelGGL(mega, dim3(grid), dim3(NTHR), LDS_BYTES, stream, a);
    a.ph_lo = 3; a.ph_hi = 4; hipLaunchKernelGGL(mega, dim3(grid), dim3(NTHR), LDS_BYTES, stream, a);
    const float* x = (const float*)d_in[0];
    float* xc = (float*)(ws + WS_XT); float* ypre = (float*)d_out; float* o2 = (float*)(ws + WS_O2); bf16* mixed = (bf16*)(ws + WS_MIXED);
    a.ph_lo = 4; a.ph_hi = 5; hipLaunchKernelGGL(mega, dim3(grid), dim3(NTHR), LDS_BYTES, stream, a);
    a.ph_lo = 5; a.ph_hi = 6; hipLaunchKernelGGL(mega, dim3(grid), dim3(NTHR), LDS_BYTES, stream, a);
}
```

```cpp
#include <hip/hip_runtime.h>
#include <hip/hip_cooperative_groups.h>
#include <cstdio>
#include <cstdint>
#include <cmath>
namespace pg8 {
#define PG8_LAS __attribute__((address_space(3)))
typedef unsigned short bf16_t;
typedef short bf16x8 __attribute__((ext_vector_type(8)));
typedef float f32x4 __attribute__((ext_vector_type(4)));
typedef unsigned u32x4 __attribute__((ext_vector_type(4)));
constexpr int BM = 256, BK = 64, HALF = 128, HTB = HALF * BK * 2  , STAGE_BYTES = 8 * HTB, NXCD = 8, WGM = 8;

__host__ __device__ __forceinline__ int lds_byte(int r, int c) { const int st = (r >> 4) * 2 + (c >> 5), rr = r & 15, cc = c & 31, ob = rr * 64 + cc * 2; return st * 1024 + (ob ^ (((ob >> 9) & 1) << 5)); }
__host__ __device__ __forceinline__ void stage_rc(int b, int& R, int& C) { const int st = b / 1024, sb = b % 1024, swz = sb ^ (((sb >> 9) & 1) << 5); R = (st >> 1) * 16 + swz / 64; C = (st & 1) * 32 + (swz % 64) / 2; }
__host__ __device__ __forceinline__ int perm32(int rho) { const int n = rho >> 4, i = rho & 15; return 8 * (i >> 2) + 4 * n + (i & 3); }

struct Unit { const char* a; const char* b; int pm, pn, kind; };
struct Gemm { int K; };

__device__ __forceinline__ unsigned cvt_pk_bf16(float lo, float hi) { unsigned r; asm volatile("v_cvt_pk_bf16_f32 %0, %1, %2" : "=v"(r) : "v"(lo), "v"(hi)); return r; }
template <class Epi, class Sched, bool ALIGN_EPI = false, bool SP2 = false>
__device__ __forceinline__ void gemm_phase(PG8_LAS unsigned char* lds, const Gemm g, const Sched& S, const Epi& E) {
    const int tid = threadIdx.x, wid = __builtin_amdgcn_readfirstlane(tid >> 6), lane = tid & 63, wr = wid >> 2, wc = wid & 3, fr = lane & 15, fq = lane >> 4;
    const int K = g.K, nt = K / BK;
    unsigned voffA[2], voffB[2];
#pragma unroll
    for (int i = 0; i < 2; ++i) { int R, C; stage_rc(tid * 16 + i * 8192, R, C); const int Rb = Epi::PERM ? ((R & ~31) + perm32(R & 31)) : R;
        voffA[i] = (unsigned)(R * K + C) * 2u; voffB[i] = (unsigned)(Rb * K + C) * 2u; }
    const size_t kstep = (size_t)(BK * 2);
    const size_t hstep = (size_t)HALF * K * 2;
        const unsigned ldsw = (unsigned)wid * 1024u;
    const int aoff = lds_byte(wr * 64 + fr, fq * 8), boff = lds_byte(wc * 32 + fr, fq * 8);
#define PG8_SA(b, h) (((b) * 2 + (h)) * HTB)
#define PG8_SB(b, h) ((4 + (b) * 2 + (h)) * HTB)
#define PG8_STAGE(bufoff, gbase, voff) do { _Pragma("unroll") for (int _i = 0; _i < 2; ++_i) \
        __builtin_amdgcn_global_load_lds((const unsigned*)((const char*)(gbase) + (voff)[_i]), (PG8_LAS unsigned*)(lds + (bufoff) + ldsw + _i * 8192), 16, 0, 0); } while (0)
#define PG8_LDA(dst, b, h) do { _Pragma("unroll") for (int m = 0; m < 4; ++m) _Pragma("unroll") for (int k = 0; k < 2; ++k) dst[m][k] = *(const PG8_LAS bf16x8*)(lds + PG8_SA(b, h) + aoff + m * 2048 + k * 1024); } while (0)
#define PG8_LDB(dst, b, h) do { _Pragma("unroll") for (int n = 0; n < 2; ++n) _Pragma("unroll") for (int k = 0; k < 2; ++k) dst[n][k] = *(const PG8_LAS bf16x8*)(lds + PG8_SB(b, h) + boff + n * 2048 + k * 1024); } while (0)
#define PG8_MMA(ai, bj, At, Bt) do { __builtin_amdgcn_s_setprio(1); _Pragma("unroll") for (int m = 0; m < 4; ++m) _Pragma("unroll") for (int n = 0; n < 2; ++n) _Pragma("unroll") for (int k = 0; k < 2; ++k) \
        acc[ai][bj][m][n] = __builtin_amdgcn_mfma_f32_16x16x32_bf16(Bt[n][k], At[m][k], acc[ai][bj][m][n], 0, 0, 0); __builtin_amdgcn_s_setprio(0); } while (0)
#define PG8_WAIT_V(n) asm volatile("s_waitcnt vmcnt(" #n ")" ::: "memory")
#define PG8_WAIT_L(n) asm volatile("s_waitcnt lgkmcnt(" #n ")" ::: "memory")
#define PG8_BAR __builtin_amdgcn_s_barrier()
#define PG8_SCHED __builtin_amdgcn_sched_barrier(0)
    Unit cur, nxt; int ui = 0;
    if (!S.next(0, cur)) return;
    f32x4 acc[2][2][4][2];
#pragma unroll
    for (int a = 0; a < 2; ++a)
#pragma unroll
        for (int b = 0; b < 2; ++b)
#pragma unroll
            for (int m = 0; m < 4; ++m)
#pragma unroll
                for (int n = 0; n < 2; ++n) acc[a][b][m][n] = (f32x4){0.f, 0.f, 0.f, 0.f};
    bf16x8 At[4][2], B0[2][2], B1[2][2];
    const char* cA = cur.a; const char* cB = cur.b;
    S.a_ready(cur);
    if constexpr (SP2) {
        PG8_STAGE(PG8_SB(0, 0), cB, voffB); PG8_STAGE(PG8_SB(0, 1), cB + hstep, voffB); PG8_STAGE(PG8_SA(0, 0), cA, voffA); PG8_STAGE(PG8_SA(0, 1), cA + hstep, voffA);
        if (wr == 1) PG8_BAR;
        PG8_WAIT_V(2); PG8_BAR;
        PG8_STAGE(PG8_SB(1, 0), cB + kstep, voffB); PG8_STAGE(PG8_SA(1, 0), cA + kstep, voffA); PG8_STAGE(PG8_SB(1, 1), cB + hstep + kstep, voffB);
        PG8_WAIT_V(6); PG8_BAR;
    } else {
        PG8_STAGE(PG8_SB(0, 0), cB, voffB); PG8_STAGE(PG8_SA(0, 0), cA, voffA); PG8_STAGE(PG8_SB(0, 1), cB + hstep, voffB); PG8_STAGE(PG8_SA(0, 1), cA + hstep, voffA);
        if (wr == 1) PG8_BAR;
        PG8_WAIT_V(4); PG8_BAR;
        PG8_STAGE(PG8_SB(1, 0), cB + kstep, voffB); PG8_STAGE(PG8_SA(1, 0), cA + kstep, voffA); PG8_STAGE(PG8_SB(1, 1), cB + hstep + kstep, voffB);
        PG8_WAIT_V(6); PG8_BAR;
    }
    for (;;) {
        const bool has_next = S.next(ui + 1, nxt);
        const char* nA = has_next ? nxt.a : cA; const char* nB = has_next ? nxt.b : cB;
        for (int t = 0; t < nt; t += 2) {
            const bool last = (t == nt - 2);
            const char* a1 = cA + (size_t)(t + 1) * kstep;
            const char* a2 = last ? nA : cA + (size_t)(t + 2) * kstep; const char* b2 = last ? nB : cB + (size_t)(t + 2) * kstep;
            const char* a3 = a2 + kstep; const char* b3 = b2 + kstep;
            if (last && has_next) S.a_ready(nxt);
            if constexpr (SP2) {
            PG8_LDB(B0, 0, 0); PG8_LDB(B1, 0, 1); PG8_SCHED; PG8_LDA(At, 0, 0); PG8_STAGE(PG8_SA(1, 1), a1 + hstep, voffA);
            PG8_WAIT_V(8); PG8_WAIT_L(0); PG8_BAR; PG8_MMA(0, 0, At, B0); PG8_MMA(0, 1, At, B1); PG8_BAR; PG8_SCHED;
            PG8_LDA(At, 0, 1); PG8_STAGE(PG8_SB(0, 0), b2, voffB); PG8_STAGE(PG8_SB(0, 1), b2 + hstep, voffB); PG8_STAGE(PG8_SA(0, 0), a2, voffA);
            PG8_WAIT_V(8); PG8_WAIT_L(0); PG8_BAR; PG8_MMA(1, 0, At, B0); PG8_MMA(1, 1, At, B1); PG8_BAR; PG8_SCHED;
            PG8_LDB(B0, 1, 0); PG8_LDB(B1, 1, 1); PG8_SCHED; PG8_LDA(At, 1, 0); PG8_STAGE(PG8_SA(0, 1), a2 + hstep, voffA);
            PG8_WAIT_V(8); PG8_WAIT_L(0); PG8_BAR; PG8_MMA(0, 0, At, B0); PG8_MMA(0, 1, At, B1); PG8_BAR; PG8_SCHED;
            PG8_LDA(At, 1, 1); PG8_STAGE(PG8_SB(1, 0), b3, voffB); PG8_STAGE(PG8_SB(1, 1), b3 + hstep, voffB); PG8_STAGE(PG8_SA(1, 0), a3, voffA);
            PG8_WAIT_V(8); PG8_WAIT_L(0); PG8_BAR; PG8_MMA(1, 0, At, B0); PG8_MMA(1, 1, At, B1); PG8_BAR; PG8_SCHED;
            } else {
            PG8_LDB(B0, 0, 0); PG8_SCHED; PG8_LDA(At, 0, 0); PG8_STAGE(PG8_SA(1, 1), a1 + hstep, voffA);
            PG8_WAIT_L(8); PG8_BAR; PG8_WAIT_L(0); PG8_MMA(0, 0, At, B0); PG8_BAR; PG8_SCHED;
            PG8_LDB(B1, 0, 1); PG8_STAGE(PG8_SB(0, 0), b2, voffB);
            PG8_BAR; PG8_WAIT_L(0); PG8_MMA(0, 1, At, B1); PG8_BAR;
            PG8_LDA(At, 0, 1); PG8_STAGE(PG8_SA(0, 0), a2, voffA);
            PG8_BAR; PG8_WAIT_L(0); PG8_MMA(1, 0, At, B0); PG8_BAR; PG8_SCHED;
            PG8_STAGE(PG8_SB(0, 1), b2 + hstep, voffB);
            PG8_WAIT_V(6); PG8_BAR; PG8_MMA(1, 1, At, B1); PG8_BAR;
            PG8_LDB(B0, 1, 0); PG8_SCHED; PG8_LDA(At, 1, 0); PG8_STAGE(PG8_SA(0, 1), a2 + hstep, voffA);
            PG8_WAIT_L(8); PG8_BAR; PG8_WAIT_L(0); PG8_MMA(0, 0, At, B0); PG8_BAR; PG8_SCHED;
            PG8_LDB(B1, 1, 1); PG8_STAGE(PG8_SB(1, 0), b3, voffB);
            PG8_BAR; PG8_WAIT_L(0); PG8_MMA(0, 1, At, B1); PG8_BAR;
            PG8_LDA(At, 1, 1); PG8_STAGE(PG8_SA(1, 0), a3, voffA);
            PG8_BAR; PG8_WAIT_L(0); PG8_MMA(1, 0, At, B0); PG8_BAR; PG8_SCHED;
            PG8_STAGE(PG8_SB(1, 1), b3 + hstep, voffB);
            PG8_WAIT_V(6); PG8_BAR; PG8_MMA(1, 1, At, B1); PG8_BAR;
            }
        }
        if constexpr (ALIGN_EPI) { if (wr == 0) PG8_BAR; }
        if constexpr (!Epi::AFTER_DRAIN) { E(acc, cur, wr, wc, fr, fq); S.done(cur); }
        if (!has_next) break;
#pragma unroll
        for (int a = 0; a < 2; ++a)
#pragma unroll
            for (int b = 0; b < 2; ++b)
#pragma unroll
                for (int m = 0; m < 4; ++m)
#pragma unroll
                    for (int n = 0; n < 2; ++n) acc[a][b][m][n] = (f32x4){0.f, 0.f, 0.f, 0.f};
        cur = nxt; cA = nA; cB = nB; ++ui;
        if constexpr (ALIGN_EPI) { if (wr == 1) PG8_BAR; }
    }
    PG8_WAIT_V(0);
    if constexpr (!ALIGN_EPI) { if (wr == 0) PG8_BAR; }
    PG8_BAR;
    if constexpr (Epi::AFTER_DRAIN) { E.fused(acc, cur, wr, wc, fr, fq, lds, wid, lane); S.done(cur); }
#undef PG8_SA
#undef PG8_SB
#undef PG8_STAGE
#undef PG8_LDA
#undef PG8_LDB
#undef PG8_MMA
#undef PG8_WAIT_V
#undef PG8_WAIT_L
#undef PG8_BAR
#undef PG8_SCHED
}
}
constexpr int NWAVES = 8, NTHR = NWAVES * 64;
constexpr int BATCH = 4, SEQ = 2048, DM = 2048, M = BATCH * SEQ, DIN = 6664, MEMLEN = 256, MM = BATCH * MEMLEN;
constexpr int NW1 = 6656;
constexpr float EPS = 1e-6f, LOG2E = 1.4426950408889634f;
constexpr float C2Q = 0.125f * LOG2E;
constexpr float C2X = 0.08838834764831845f * LOG2E;
constexpr float LAMBDA_INIT = 0.2f;
constexpr size_t MiB = 1u << 20;
constexpr size_t WS_CTL = 0, CTL_ZERO_BYTES = 1 * MiB;
constexpr size_t WS_W1T = 1 * MiB, WS_WOT = 27 * MiB, WS_WKVT = 35 * MiB, WS_HN = 39 * MiB, WS_MEMN = 71 * MiB;
constexpr size_t WS_DT = 75 * MiB, WS_ACS = 75 * MiB + 256 * 1024, WS_ROPE = 76 * MiB;
constexpr size_t WS_Q = 78 * MiB, WS_K = 94 * MiB, WS_VT = 110 * MiB, WS_G = 126 * MiB, WS_Z = 142 * MiB, WS_XBC = 150 * MiB, WS_XQ = 166 * MiB, WS_XG = 174 * MiB;
constexpr size_t WS_MK = 182 * MiB, WS_MVT = 183 * MiB, WS_XT = 184 * MiB, WS_BC = 192 * MiB, WS_CS = 200 * MiB, WS_MIXED = 216 * MiB, WS_END = 248 * MiB;
constexpr size_t WS_O2 = 39 * MiB;
constexpr size_t TSTEP = (size_t)256 * DM * 2;

#define GAS __attribute__((address_space(1)))
#define LAS __attribute__((address_space(3)))
typedef unsigned short bf16;
typedef unsigned v4u __attribute__((ext_vector_type(4)));
typedef unsigned v2u __attribute__((ext_vector_type(2)));
typedef float f32x4 __attribute__((ext_vector_type(4)));
typedef float f32x16 __attribute__((ext_vector_type(16)));
typedef short bf16x8 __attribute__((ext_vector_type(8)));
#define LDS_WAIT() asm volatile("s_waitcnt lgkmcnt(0)" ::: "memory")
#define VM_WAIT() asm volatile("s_waitcnt vmcnt(0)" ::: "memory")
__device__ __forceinline__ unsigned f2bf(float f) { unsigned u = __builtin_bit_cast(unsigned, f); return (u + 0x7fffu + ((u >> 16) & 1u)) >> 16; }
__device__ __forceinline__ unsigned pk2(float lo, float hi) { return f2bf(lo) | (f2bf(hi) << 16); }
__device__ __forceinline__ float bf2f(bf16 v) { return __builtin_bit_cast(float, (unsigned)v << 16); }
__device__ __forceinline__ float bflo(unsigned w) { return __builtin_bit_cast(float, w << 16); }
__device__ __forceinline__ float bfhi(unsigned w) { return __builtin_bit_cast(float, w & 0xffff0000u); }
__device__ __forceinline__ float silu_f(float v) { return v / (1.f + __expf(-v)); }
__device__ __forceinline__ float wave_sum(float v) {
#pragma unroll
    for (int o = 1; o < 64; o <<= 1) v += __shfl_xor(v, o);
    return v;
}

struct Frame {
    LAS unsigned char* lds;
    int tid, lane, wave, vcu, G;
    const float* in[20]; float* out; unsigned char* ws;
};

__device__ __forceinline__ int w1_src_col(int r) {
    if (r < 2048) { const int p = r & 63, i = p >> 2, j = p & 3; return (r & ~63) + 2 * i + (j & 1) + 32 * (j >> 1); }
    if (r < 3072) return 3072 + (r - 2048);
    if (r < 3584) return 4096 + (r - 3072);
    if (r < 4608) return 4608 + (r - 3584);
    if (r < 5120) return 5640 + (r - 4608);
    if (r < 5632) return 6152 + (r - 5120);
    return 2048 + (r - 5632);
}
template <bool MAP>
__device__ __forceinline__ void p0_transpose_item(const float* W, int K, int N, bf16* WT, LAS float* scr, int item, int lane) {
    const int nkb = K / 64, nb = item / nkb, kb = item % nkb, k0 = 64 * kb, n0 = 32 * nb;
    const int sc = MAP ? w1_src_col(n0 + (lane & 31)) : n0 + (lane & 31);
#pragma unroll 8
    for (int i = 0; i < 32; ++i) { const int kk = 2 * i + (lane >> 5); scr[kk * 33 + (lane & 31)] = W[(size_t)(k0 + kk) * N + sc]; }
    LDS_WAIT(); asm volatile("" ::: "memory");
    const int c = lane & 7;
#pragma unroll
    for (int j = 0; j < 4; ++j) { const int n = (lane >> 3) + 8 * j; const LAS float* s = scr + (8 * c) * 33 + n;
        v4u o; o.x = pk2(s[0 * 33], s[1 * 33]); o.y = pk2(s[2 * 33], s[3 * 33]); o.z = pk2(s[4 * 33], s[5 * 33]); o.w = pk2(s[6 * 33], s[7 * 33]);
        *(GAS v4u*)(WT + (size_t)(n0 + n) * K + k0 + 8 * c) = o; }
    LDS_WAIT(); asm volatile("" ::: "memory");
}
template <bool WITH_DT>
__device__ __forceinline__ void p0_norm_row(const float* xrow, const float* w, bf16* orow, const LAS float* wdt, const float* dtb, float* dtrow, int lane) {
    const GAS f32x4* xr = (const GAS f32x4*)xrow + lane; const GAS f32x4* wr = (const GAS f32x4*)w + lane;
    f32x4 v[8]; float s = 0.f;
#pragma unroll
    for (int j = 0; j < 8; ++j) { v[j] = xr[64 * j]; s += (v[j].x * v[j].x + v[j].y * v[j].y) + (v[j].z * v[j].z + v[j].w * v[j].w); }
    const float rstd = rsqrtf(wave_sum(s) * (1.f / DM) + EPS);
    GAS v2u* o8 = (GAS v2u*)orow + lane;
#pragma unroll
    for (int j = 0; j < 8; ++j) { v[j] = v[j] * rstd * wr[64 * j]; v2u o; o.x = pk2(v[j].x, v[j].y); o.y = pk2(v[j].z, v[j].w); o8[64 * j] = o; }
    if (WITH_DT) {
        float d[8];
#pragma unroll
        for (int h = 0; h < 8; ++h) { float a = 0.f;
#pragma unroll
            for (int j = 0; j < 8; ++j) { const f32x4 ww = *(const LAS f32x4*)(wdt + h * DM + 4 * (lane + 64 * j)); a += (v[j].x * ww.x + v[j].y * ww.y) + (v[j].z * ww.z + v[j].w * ww.w); }
            d[h] = wave_sum(a); }
        float mine = 0.f;
#pragma unroll
        for (int h = 0; h < 8; ++h) mine = (lane == h) ? d[h] : mine;
        if (lane < 8) { const float r = mine + dtb[lane]; dtrow[lane] = (r > 20.f) ? r : log1pf(__expf(r)); }
    }
}
__device__ __forceinline__ void p0_prologue(Frame& F) {
    LAS float* scr = (LAS float*)(F.lds + F.wave * 16384);
    const int gw = F.vcu * NWAVES + F.wave, NGW = F.G * NWAVES;
    unsigned char* ws = F.ws;
    constexpr int I_1 = (NW1 / 32) * (DM / 64), I_O = (DM / 32) * (DM / 64), I_KV = (1024 / 32) * (DM / 64);
    for (int it = gw; it < I_1 + I_O + I_KV; it += NGW) {
        int r = it;
        if (r < I_1) { p0_transpose_item<true>(F.in[4], DM, DIN, (bf16*)(ws + WS_W1T), scr, r, F.lane); continue; } r -= I_1;
        if (r < I_O) { p0_transpose_item<false>(F.in[18], DM, DM, (bf16*)(ws + WS_WOT), scr, r, F.lane); continue; } r -= I_O;
        p0_transpose_item<false>(F.in[17], DM, 1024, (bf16*)(ws + WS_WKVT), scr, r, F.lane);
    }
    { const int* pos = (const int*)F.in[2]; float* rope = (float*)(ws + WS_ROPE);
      for (int idx = (F.vcu * NTHR + F.tid); idx < M * 32; idx += F.G * NTHR) { const int t = idx >> 5, f = idx & 31;
          const float inv = 1.0f / powf(10000.f, (float)(2 * f) / 64.f); const float ang = (float)pos[t] * inv;
          rope[2 * idx] = cosf(ang); rope[2 * idx + 1] = sinf(ang); } }
    __syncthreads();
    LAS float* wdt = (LAS float*)F.lds;
    for (int idx = F.tid; idx < DM * 8; idx += NTHR) { const int k = idx >> 3, h = idx & 7; wdt[h * DM + k] = F.in[4][(size_t)k * DIN + 5632 + h]; }
    __syncthreads();
    for (int m = gw; m < M + MM; m += NGW) {
        if (m < M) p0_norm_row<true>(F.in[0] + (size_t)m * DM, F.in[3], (bf16*)(ws + WS_HN) + (size_t)m * DM, wdt, F.in[12], (float*)(ws + WS_DT) + (size_t)m * 8, F.lane);
        else p0_norm_row<false>(F.in[1] + (size_t)(m - M) * DM, F.in[16], (bf16*)(ws + WS_MEMN) + (size_t)(m - M) * DM, wdt, nullptr, nullptr, F.lane);
    }
    __syncthreads();
}

struct Sched1 {
    int G, c; const char *HN, *W1T, *MEMN, *WKVT;
    __device__ __forceinline__ bool next(int i, pg8::Unit& u) const {
        const long L = (long)i * G + c; if (L >= 848) return false;
        if (L < 704) {
            int wgid = (int)L; { const int xcd = wgid % 8, off = wgid / 8; wgid = xcd * 88 + off; }
            const int pm = (wgid / 176) * 8 + ((wgid % 176) % 8), pn = (wgid % 176) / 8;
            u.kind = 0; u.pm = pm; u.pn = pn; u.a = HN + (size_t)pm * TSTEP; u.b = W1T + (size_t)pn * TSTEP;
        } else if (L < 832) { const int r = (int)L - 704;
            u.kind = 1; u.pm = r & 3; u.pn = r >> 2; u.a = W1T + (size_t)(22 + u.pm) * TSTEP; u.b = HN + (size_t)u.pn * TSTEP;
        } else if (L < 840) { const int r = (int)L - 832;
            u.kind = 2; u.pm = r & 3; u.pn = r >> 2; u.a = MEMN + (size_t)u.pm * TSTEP; u.b = WKVT + (size_t)u.pn * TSTEP;
        } else { const int r = (int)L - 840;
            u.kind = 3; u.pm = r & 1; u.pn = r >> 1; u.a = WKVT + (size_t)(2 + u.pm) * TSTEP; u.b = MEMN + (size_t)u.pn * TSTEP; }
        return true;
    }
    __device__ __forceinline__ void a_ready(const pg8::Unit&) const {}
    __device__ __forceinline__ void done(const pg8::Unit&) const {}
};
struct EpiP1 {
    static constexpr bool PERM = true, AFTER_DRAIN = false;
    unsigned char* ws;
    __device__ __forceinline__ void operator()(const pg8::f32x4 (&acc)[2][2][4][2], const pg8::Unit& u, int wr, int wc, int fr, int fq) const {
        bf16* base; int ldc, op = 0, colt; float sc = 1.f;
        if (u.kind == 0) { const int pn = u.pn;
            if (pn < 4) { base = (bf16*)(ws + WS_Q); ldc = 1024; colt = pn * 256; op = 2; sc = C2Q; }
            else if (pn < 8) { base = (bf16*)(ws + WS_K); ldc = 1024; colt = (pn - 4) * 256; op = 2; }
            else if (pn < 12) { base = (bf16*)(ws + WS_G); ldc = 1024; colt = (pn - 8) * 256; op = 1; }
            else if (pn < 14) { base = (bf16*)(ws + WS_Z); ldc = 512; colt = (pn - 12) * 256; op = 1; }
            else if (pn < 18) { base = (bf16*)(ws + WS_XBC); ldc = 1024; colt = (pn - 14) * 256; }
            else if (pn < 20) { base = (bf16*)(ws + WS_XQ); ldc = 512; colt = (pn - 18) * 256; sc = C2X; }
            else { base = (bf16*)(ws + WS_XG); ldc = 512; colt = (pn - 20) * 256; op = 1; }
        } else if (u.kind == 1) { base = (bf16*)(ws + WS_VT); ldc = M; colt = u.pn * 256; }
        else if (u.kind == 2) { base = (bf16*)(ws + WS_MK); ldc = 512; colt = u.pn * 256; }
        else { base = (bf16*)(ws + WS_MVT); ldc = MM; colt = u.pn * 256; }
        const int row0 = u.pm * 256 + wr * 64 + fr, col0 = colt + wc * 32 + 8 * fq;
        const float* rope = (const float*)(ws + WS_ROPE); const int i0 = 8 * (wc & 1) + 2 * fq;
#pragma unroll
        for (int ai = 0; ai < 2; ++ai)
#pragma unroll
            for (int m = 0; m < 4; ++m) { const int row = row0 + ai * 128 + m * 16; bf16* rowp = base + (size_t)row * ldc + col0;
                f32x4 cs0 = {1.f, 0.f, 1.f, 0.f}, cs1 = {1.f, 0.f, 1.f, 0.f};
                if (op == 2) { cs0 = *(const f32x4*)(rope + ((size_t)row * 32 + 2 * i0) * 2); cs1 = *(const f32x4*)(rope + ((size_t)row * 32 + 2 * i0 + 2) * 2); }
#pragma unroll
                for (int bj = 0; bj < 2; ++bj) { f32x4 v0 = acc[ai][bj][m][0], v1 = acc[ai][bj][m][1];
                    if (op == 1) { v0 = (f32x4){silu_f(v0[0]), silu_f(v0[1]), silu_f(v0[2]), silu_f(v0[3])}; v1 = (f32x4){silu_f(v1[0]), silu_f(v1[1]), silu_f(v1[2]), silu_f(v1[3])}; }
                    if (op == 2) {
                        v0 = (f32x4){v0[0] * cs0[0] - v0[2] * cs0[1], v0[1] * cs0[2] - v0[3] * cs0[3], v0[2] * cs0[0] + v0[0] * cs0[1], v0[3] * cs0[2] + v0[1] * cs0[3]};
                        v1 = (f32x4){v1[0] * cs1[0] - v1[2] * cs1[1], v1[1] * cs1[2] - v1[3] * cs1[3], v1[2] * cs1[0] + v1[0] * cs1[1], v1[3] * cs1[2] + v1[1] * cs1[3]}; }
                    v0 = v0 * sc; v1 = v1 * sc;
                    v4u w; w.x = pg8::cvt_pk_bf16(v0[0], v0[1]); w.y = pg8::cvt_pk_bf16(v0[2], v0[3]); w.z = pg8::cvt_pk_bf16(v1[0], v1[1]); w.w = pg8::cvt_pk_bf16(v1[2], v1[3]);
                    *(v4u*)(rowp + bj * 128) = w; } }
    }
};
namespace att {
constexpr int STAGE = 32768;
__device__ __forceinline__ int k_off(int row, int ch) { return row * 256 + ((ch ^ (row & 15)) << 4); }
__device__ __forceinline__ int v_off(int row, int ch) { return 16384 + (row >> 1) * 256 + ((((row & 1) << 3) | (ch ^ ((row >> 1) & 7))) << 4); }
__device__ __forceinline__ int pi32(int i) { return (i & 0x13) | ((i & 4) << 1) | ((i & 8) >> 1); }
__device__ __forceinline__ float other_half(float v) {
    return __shfl_xor(v, 32);
}
__device__ __forceinline__ unsigned cvtpk(float lo, float hi) { typedef float f2 __attribute__((ext_vector_type(2))); typedef __bf16 b2 __attribute__((ext_vector_type(2))); f2 v = {lo, hi}; b2 b = __builtin_convertvector(v, b2); return __builtin_bit_cast(unsigned, b); }
struct StageRegs { v4u k[2], v[2]; };
__device__ __forceinline__ void stage_load(StageRegs& s, const bf16* Kp, int ldk, const bf16* VTp, int ldv, int kv0, int tid) {
#pragma unroll
    for (int i = 0; i < 2; ++i) { const int ci = tid + i * NTHR;
        s.k[i] = *(const GAS v4u*)(Kp + (size_t)(kv0 + (ci >> 4)) * ldk + (ci & 15) * 8);
        s.v[i] = *(const GAS v4u*)(VTp + (size_t)(ci >> 3) * ldv + kv0 + (ci & 7) * 8); }
}
__device__ __forceinline__ void stage_store(const StageRegs& s, LAS unsigned char* buf, int tid) {
#pragma unroll
    for (int i = 0; i < 2; ++i) { const int ci = tid + i * NTHR;
        *(LAS v4u*)(buf + k_off(ci >> 4, ci & 15)) = s.k[i];
        *(LAS v4u*)(buf + v_off(ci >> 3, ci & 7)) = s.v[i]; }
}
template <int KSTEPS, bool CAUSAL>
__device__ __forceinline__ void attn_core(LAS unsigned char* lds, const bf16* Qw, int ldq, const bf16* Kp, int ldk, const bf16* VTp, int ldv, int ntiles, int q0rel, int coff,
                                          f32x16 (&o)[4], float& m_out, float& l_out, int tid, int lane) {
    const int r32 = lane & 31, hi = lane >> 5;
    bf16x8 qf[KSTEPS];
#pragma unroll
    for (int ks = 0; ks < KSTEPS; ++ks) qf[ks] = *(const GAS bf16x8*)(Qw + (size_t)r32 * ldq + ks * 16 + hi * 8);
#pragma unroll
    for (int d = 0; d < 4; ++d)
#pragma unroll
        for (int r = 0; r < 16; ++r) o[d][r] = 0.f;
    float m = -1e30f, l = 0.f;
    const int krow = pi32(r32), kch0 = (coff >> 3) + hi;
    StageRegs sr;
    stage_load(sr, Kp, ldk, VTp, ldv, 0, tid);
    stage_store(sr, lds, tid);
    __syncthreads();
    for (int t = 0; t < ntiles; ++t) {
        LAS unsigned char* buf = lds + (t & 1) * STAGE;
        const bool more = (t + 1 < ntiles);
        if (more) stage_load(sr, Kp, ldk, VTp, ldv, (t + 1) * 64, tid);
        const int kv0 = t * 64;
        const bool active = !CAUSAL || (kv0 <= q0rel + 31);
        if (active) {
            f32x16 p0, p1;
#pragma unroll
            for (int r = 0; r < 16; ++r) { p0[r] = 0.f; p1[r] = 0.f; }
#pragma unroll
            for (int ks = 0; ks < KSTEPS; ++ks) {
                const bf16x8 a0 = *(const LAS bf16x8*)(buf + k_off(krow, kch0 + 2 * ks));
                const bf16x8 a1 = *(const LAS bf16x8*)(buf + k_off(32 + krow, kch0 + 2 * ks));
                p0 = __builtin_amdgcn_mfma_f32_32x32x16_bf16(a0, qf[ks], p0, 0, 0, 0);
                p1 = __builtin_amdgcn_mfma_f32_32x32x16_bf16(a1, qf[ks], p1, 0, 0, 0);
            }
            if (CAUSAL && (kv0 + 63 > q0rel)) {
                const int qg = q0rel + r32;
#pragma unroll
                for (int r = 0; r < 16; ++r) { const int kv = kv0 + 16 * (r >> 3) + 8 * hi + (r & 7); if (kv > qg) p0[r] = -INFINITY; if (kv + 32 > qg) p1[r] = -INFINITY; }
            }
            float rm = fmaxf(p0[0], p1[0]);
#pragma unroll
            for (int r = 1; r < 16; ++r) rm = fmaxf(rm, fmaxf(p0[r], p1[r]));
            rm = fmaxf(rm, other_half(rm));
            if (__any(rm > m + 8.f)) {
                const float mn = fmaxf(m, rm), al = __builtin_amdgcn_exp2f(m - mn);
                l *= al; m = mn;
#pragma unroll
                for (int d = 0; d < 4; ++d)
#pragma unroll
                    for (int r = 0; r < 16; ++r) o[d][r] *= al;
            }
            float ls = 0.f;
#pragma unroll
            for (int r = 0; r < 16; ++r) { p0[r] = __builtin_amdgcn_exp2f(p0[r] - m); p1[r] = __builtin_amdgcn_exp2f(p1[r] - m); ls += p0[r] + p1[r]; }
            l += ls;
            v4u pw[4];
#pragma unroll
            for (int s = 0; s < 2; ++s) {
                pw[s] = (v4u){cvtpk(p0[8 * s], p0[8 * s + 1]), cvtpk(p0[8 * s + 2], p0[8 * s + 3]), cvtpk(p0[8 * s + 4], p0[8 * s + 5]), cvtpk(p0[8 * s + 6], p0[8 * s + 7])};
                pw[2 + s] = (v4u){cvtpk(p1[8 * s], p1[8 * s + 1]), cvtpk(p1[8 * s + 2], p1[8 * s + 3]), cvtpk(p1[8 * s + 4], p1[8 * s + 5]), cvtpk(p1[8 * s + 6], p1[8 * s + 7])};
            }
#pragma unroll
            for (int d = 0; d < 4; ++d)
#pragma unroll
                for (int ks = 0; ks < 4; ++ks) {
                    const bf16x8 vf = *(const LAS bf16x8*)(buf + v_off(32 * d + r32, 2 * ks + hi));
                    o[d] = __builtin_amdgcn_mfma_f32_32x32x16_bf16(vf, __builtin_bit_cast(bf16x8, pw[ks]), o[d], 0, 0, 0);
                }
        }
        if (more) stage_store(sr, lds + ((t + 1) & 1) * STAGE, tid);
        __syncthreads();
    }
    m_out = m; l_out = l + other_half(l);
}
__device__ __forceinline__ int crow(int r, int hi) { return (r & 3) + 8 * (r >> 2) + 4 * hi; }

__device__ __forceinline__ void diff_unit(Frame& F, int b, int h, int qb, float lam) {
    unsigned char* ws = F.ws; int tid_ = F.tid; asm volatile("" : "+v"(tid_)); const int w = F.wave, c = w >> 2, sb = w & 3, lane = tid_ & 63, r32 = lane & 31, hi = lane >> 5;
    const int q0 = qb * 128, q0w = q0 + 32 * sb; const size_t trow0 = (size_t)b * SEQ;
    const bf16* Qw = (const bf16*)(ws + WS_Q) + (trow0 + q0w) * 1024 + h * 128 + c * 64;
    const bf16* Kp = (const bf16*)(ws + WS_K) + trow0 * 1024 + h * 128;
    const bf16* VTp = (const bf16*)(ws + WS_VT) + (size_t)(h * 128) * M + trow0;
    f32x16 o[4]; float m, l;
    attn_core<4, true>(F.lds, Qw, 1024, Kp, 1024, VTp, M, (q0 + 128) / 64, q0w, c * 64, o, m, l, tid_, lane);
    const float inv = 1.f / l;
    LAS float* xch = (LAS float*)F.lds + sb * 4096 + lane;
    if (c == 1) {
        const float f = lam * inv;
#pragma unroll
        for (int d = 0; d < 4; ++d)
#pragma unroll
            for (int r = 0; r < 16; ++r) xch[(d * 16 + r) * 64] = o[d][r] * f;
    }
    __syncthreads();
    if (c == 0) {
        float ss = 0.f;
#pragma unroll
        for (int d = 0; d < 4; ++d)
#pragma unroll
            for (int r = 0; r < 16; ++r) { const float v = o[d][r] * inv - xch[(d * 16 + r) * 64]; o[d][r] = v; ss += v * v; }
        ss += other_half(ss);
        const float rs = rsqrtf(ss * (1.f / 128.f) + EPS) * (1.f - LAMBDA_INIT);
        const size_t t = trow0 + q0w + r32;
        const bf16* Gp = (const bf16*)(ws + WS_G) + t * 1024 + h * 128; bf16* Op = (bf16*)(ws + WS_MIXED) + t * 2048 + h * 128;
        const float* sw = F.in[9];
#pragma unroll
        for (int d = 0; d < 4; ++d)
#pragma unroll
            for (int rg = 0; rg < 4; ++rg) { const int dv = 32 * d + 8 * rg + 4 * hi;
                const v2u g = *(const GAS v2u*)(Gp + dv); const f32x4 wv = *(const GAS f32x4*)(sw + dv);
                v2u ov; ov.x = pk2(o[d][4 * rg] * rs * wv[0] * bflo(g.x), o[d][4 * rg + 1] * rs * wv[1] * bfhi(g.x));
                ov.y = pk2(o[d][4 * rg + 2] * rs * wv[2] * bflo(g.y), o[d][4 * rg + 3] * rs * wv[3] * bfhi(g.y));
                *(GAS v2u*)(Op + dv) = ov; }
    }
    __syncthreads();
}
__device__ __forceinline__ void xattn_unit(Frame& F, int b, int h, int qb) {
    unsigned char* ws = F.ws; int tid_ = F.tid; asm volatile("" : "+v"(tid_)); const int w = F.wave, lane = tid_ & 63, r32 = lane & 31, hi = lane >> 5;
    const int q0w = qb * 256 + 32 * w; const size_t trow0 = (size_t)b * SEQ;
    const bf16* Qw = (const bf16*)(ws + WS_XQ) + (trow0 + q0w) * 512 + h * 128;
    const bf16* Kp = (const bf16*)(ws + WS_MK) + (size_t)(b * MEMLEN) * 512 + h * 128;
    const bf16* VTp = (const bf16*)(ws + WS_MVT) + (size_t)(h * 128) * MM + b * MEMLEN;
    f32x16 o[4]; float m, l;
    attn_core<8, false>(F.lds, Qw, 512, Kp, 512, VTp, MM, MEMLEN / 64, 0, 0, o, m, l, tid_, lane);
    const float inv = 1.f / l; const size_t t = trow0 + q0w + r32;
    const bf16* Gp = (const bf16*)(ws + WS_XG) + t * 512 + h * 128; bf16* Op = (bf16*)(ws + WS_MIXED) + t * 2048 + 1536 + h * 128;
#pragma unroll
    for (int d = 0; d < 4; ++d)
#pragma unroll
        for (int rg = 0; rg < 4; ++rg) { const int dv = 32 * d + 8 * rg + 4 * hi;
            const v2u g = *(const GAS v2u*)(Gp + dv);
            v2u ov; ov.x = pk2(o[d][4 * rg] * inv * bflo(g.x), o[d][4 * rg + 1] * inv * bfhi(g.x));
            ov.y = pk2(o[d][4 * rg + 2] * inv * bflo(g.y), o[d][4 * rg + 3] * inv * bfhi(g.y));
            *(GAS v2u*)(Op + dv) = ov; }
}
}
namespace ssd {
using att::k_off; using att::pi32; using att::crow; using att::other_half;
__device__ __forceinline__ v4u pack8(const float (&s)[8]) { return (v4u){att::cvtpk(s[0], s[1]), att::cvtpk(s[2], s[3]), att::cvtpk(s[4], s[5]), att::cvtpk(s[6], s[7])}; }
__device__ __forceinline__ void unitA(Frame& F, int b, int c, int g) {
    unsigned char* ws = F.ws; int tid_ = F.tid; asm volatile("" : "+v"(tid_)); const int tid = tid_, lane = tid & 63, w = F.wave, r32 = lane & 31, hi = lane >> 5;
    const size_t t0 = (size_t)b * SEQ + c * 128;
    LAS unsigned char* tile = F.lds;
    LAS float* tab = (LAS float*)(F.lds + 98304);
    const float* DTg = (const float*)(ws + WS_DT); float* ACSg = (float*)(ws + WS_ACS);
    { const int hh = tid >> 7, l = tid & 127, h = g * 4 + hh;
      const float dt = DTg[(t0 + l) * 8 + h]; float v = dt * (-__expf(F.in[13][h]));
#pragma unroll
      for (int o = 1; o < 64; o <<= 1) { const float t = __shfl_up(v, o); if (lane >= o) v += t; }
      if ((w & 1) == 0 && lane == 63) tab[1536 + hh] = v;
      __syncthreads();
      if (w & 1) v += tab[1536 + hh];
      tab[hh * 128 + l] = dt; tab[512 + hh * 128 + l] = v; ACSg[(t0 + l) * 8 + h] = v;
      __syncthreads();
      tab[1024 + hh * 128 + l] = dt * __expf(tab[512 + hh * 128 + 127] - v);
      __syncthreads(); }
    { const int ch = tid; const int col = (ch < 256) ? g * 256 + ch : (ch < 384) ? 512 + g * 128 + (ch - 256) : 768 + g * 128 + (ch - 384);
      const float* cw = F.in[10]; const float w0 = cw[col], w1 = cw[1024 + col], w2 = cw[2048 + col], w3 = cw[3072 + col], bias = F.in[11][col];
      const bf16* src = (const bf16*)(ws + WS_XBC) + t0 * 1024 + col;
      float xx[11]; xx[0] = xx[1] = xx[2] = 0.f;
      if (c > 0) { xx[0] = bf2f(src[-3 * 1024]); xx[1] = bf2f(src[-2 * 1024]); xx[2] = bf2f(src[-1 * 1024]); }
      bf16* XTg = (bf16*)(ws + WS_XT) + ((size_t)(b * 16 + c) * 512 + g * 256 + ch) * 128;
      bf16* BCg = (bf16*)(ws + WS_BC) + t0 * 512 + ((ch < 384) ? g * 128 + (ch - 256) : 256 + g * 128 + (ch - 384));
      const int hh = (ch >> 6) & 3;
#pragma unroll 1
      for (int lg = 0; lg < 16; ++lg) {
#pragma unroll
          for (int j = 0; j < 8; ++j) xx[3 + j] = bf2f(src[(size_t)(lg * 8 + j) * 1024]);
          float s[8];
#pragma unroll
          for (int j = 0; j < 8; ++j) { const float y = bias + w0 * xx[j] + w1 * xx[j + 1] + w2 * xx[j + 2] + w3 * xx[j + 3]; s[j] = y / (1.f + __expf(-y)); }
          xx[0] = xx[8]; xx[1] = xx[9]; xx[2] = xx[10];
          if (ch < 256) {
              *(GAS v4u*)(XTg + lg * 8) = pack8(s);
              const f32x4 wa = *(const LAS f32x4*)(tab + 1024 + hh * 128 + lg * 8), wb = *(const LAS f32x4*)(tab + 1024 + hh * 128 + lg * 8 + 4);
              float sw[8] = {s[0] * wa[0], s[1] * wa[1], s[2] * wa[2], s[3] * wa[3], s[4] * wb[0], s[5] * wb[1], s[6] * wb[2], s[7] * wb[3]};
              *(LAS v4u*)(tile + k_off(ch, lg)) = pack8(sw);
          } else {
#pragma unroll
              for (int j = 0; j < 8; ++j) BCg[(size_t)(lg * 8 + j) * 512] = (bf16)f2bf(s[j]);
              if (ch < 384) *(LAS v4u*)(tile + k_off(ch, lg)) = pack8(s);
          }
      } }
    __syncthreads();
    { const int hh = w >> 1, nh = w & 1;
      f32x16 acc[2][2];
#pragma unroll
      for (int i = 0; i < 2; ++i)
#pragma unroll
          for (int j = 0; j < 2; ++j)
#pragma unroll
              for (int r = 0; r < 16; ++r) acc[i][j][r] = 0.f;
#pragma unroll
      for (int ks = 0; ks < 8; ++ks) {
          const bf16x8 a0 = *(const LAS bf16x8*)(tile + k_off(hh * 64 + r32, 2 * ks + hi)), a1 = *(const LAS bf16x8*)(tile + k_off(hh * 64 + 32 + r32, 2 * ks + hi));
          const bf16x8 b0 = *(const LAS bf16x8*)(tile + k_off(256 + nh * 64 + r32, 2 * ks + hi)), b1 = *(const LAS bf16x8*)(tile + k_off(256 + nh * 64 + 32 + r32, 2 * ks + hi));
          acc[0][0] = __builtin_amdgcn_mfma_f32_32x32x16_bf16(a0, b0, acc[0][0], 0, 0, 0); acc[0][1] = __builtin_amdgcn_mfma_f32_32x32x16_bf16(a0, b1, acc[0][1], 0, 0, 0);
          acc[1][0] = __builtin_amdgcn_mfma_f32_32x32x16_bf16(a1, b0, acc[1][0], 0, 0, 0); acc[1][1] = __builtin_amdgcn_mfma_f32_32x32x16_bf16(a1, b1, acc[1][1], 0, 0, 0);
      }
      float* cs = (float*)(ws + WS_CS) + (size_t)((b * 16 + c) * 8 + g * 4 + hh) * 8192;
#pragma unroll
      for (int pb = 0; pb < 2; ++pb)
#pragma unroll
          for (int nb = 0; nb < 2; ++nb)
#pragma unroll
              for (int r = 0; r < 16; ++r) cs[(32 * pb + crow(r, hi)) * 128 + nh * 64 + 32 * nb + r32] = acc[pb][nb][r]; }
    __syncthreads();
}

__device__ __forceinline__ void unitB(Frame& F, int b, int c, int g) {
    unsigned char* ws = F.ws; int tid_ = F.tid; asm volatile("" : "+v"(tid_)); const int tid = tid_, lane = tid & 63, w = F.wave, r32 = lane & 31, hi = lane >> 5;
    const size_t t0 = (size_t)b * SEQ + c * 128;
    LAS unsigned char* ptile = F.lds;
    LAS float* tab = (LAS float*)(F.lds + 65536);
    const float* DTg = (const float*)(ws + WS_DT); const float* ACSg = (const float*)(ws + WS_ACS);
    { const int hh = tid >> 7, l = tid & 127; tab[hh * 128 + l] = DTg[(t0 + l) * 8 + g * 4 + hh]; tab[512 + hh * 128 + l] = ACSg[(t0 + l) * 8 + g * 4 + hh]; }
    { f32x4 acc[4][4]; float wgt[4];
#pragma unroll
      for (int hh = 0; hh < 4; ++hh) { wgt[hh] = 1.f;
#pragma unroll
          for (int j = 0; j < 4; ++j) acc[hh][j] = (f32x4){0.f, 0.f, 0.f, 0.f}; }
      for (int cp = c - 1; cp >= 0; --cp) {
#pragma unroll
          for (int hh = 0; hh < 4; ++hh) {
              if (wgt[hh] > 1e-30f) { const float* src = (const float*)(ws + WS_CS) + (size_t)((b * 16 + cp) * 8 + g * 4 + hh) * 8192;
#pragma unroll
                  for (int j = 0; j < 4; ++j) acc[hh][j] += *(const GAS f32x4*)(src + 4 * (tid + 512 * j)) * wgt[hh]; }
              wgt[hh] *= __expf(ACSg[((size_t)b * SEQ + cp * 128 + 127) * 8 + g * 4 + hh]); }
      }
#pragma unroll
      for (int hh = 0; hh < 4; ++hh)
#pragma unroll
          for (int j = 0; j < 4; ++j) { const int e = 4 * (tid + 512 * j), p = e >> 7, n = e & 127;
              v2u o; o.x = att::cvtpk(acc[hh][j][0], acc[hh][j][1]); o.y = att::cvtpk(acc[hh][j][2], acc[hh][j][3]);
              *(LAS v2u*)(ptile + k_off(hh * 64 + p, n >> 3) + (n & 7) * 2) = o; } }
    __syncthreads();
    const int lb = w & 3, hp = w >> 2, l_loc = 32 * lb + r32;
    const bf16* BCg = (const bf16*)(ws + WS_BC) + t0 * 512;
    bf16x8 cf[8];
#pragma unroll
    for (int ks = 0; ks < 8; ++ks) cf[ks] = *(const GAS bf16x8*)(BCg + (size_t)l_loc * 512 + 256 + g * 128 + 16 * ks + 8 * hi);
    f32x16 acc[2][2];
#pragma unroll
    for (int hh2 = 0; hh2 < 2; ++hh2)
#pragma unroll
        for (int pb = 0; pb < 2; ++pb) {
#pragma unroll
            for (int r = 0; r < 16; ++r) acc[hh2][pb][r] = 0.f;
            if (c > 0) {
#pragma unroll
                for (int ks = 0; ks < 8; ++ks) { const bf16x8 a = *(const LAS bf16x8*)(ptile + k_off((2 * hp + hh2) * 64 + 32 * pb + r32, 2 * ks + hi));
                    acc[hh2][pb] = __builtin_amdgcn_mfma_f32_32x32x16_bf16(a, cf[ks], acc[hh2][pb], 0, 0, 0); }
                const float e = __expf(tab[512 + (2 * hp + hh2) * 128 + l_loc]);
#pragma unroll
                for (int r = 0; r < 16; ++r) acc[hh2][pb][r] *= e;
            }
        }
    const bf16* XTg = (const bf16*)(ws + WS_XT) + ((size_t)(b * 16 + c) * 512 + g * 256) * 128;
    for (int sb = 0; sb <= lb; ++sb) {
        f32x16 gt;
#pragma unroll
        for (int r = 0; r < 16; ++r) gt[r] = 0.f;
        const bf16* brow = BCg + (size_t)(32 * sb + pi32(r32)) * 512 + g * 128 + 8 * hi;
#pragma unroll
        for (int ks = 0; ks < 8; ++ks) { const bf16x8 bfr = *(const GAS bf16x8*)(brow + 16 * ks); gt = __builtin_amdgcn_mfma_f32_32x32x16_bf16(bfr, cf[ks], gt, 0, 0, 0); }
#pragma unroll
        for (int hh2 = 0; hh2 < 2; ++hh2) { const int hh = 2 * hp + hh2; const float acs_l = tab[512 + hh * 128 + l_loc], Dh = F.in[14][g * 4 + hh];
            float sc[16];
#pragma unroll
            for (int q4 = 0; q4 < 4; ++q4) { const int sbase = 32 * sb + 16 * (q4 >> 1) + 8 * hi + 4 * (q4 & 1);
                const f32x4 as = *(const LAS f32x4*)(tab + 512 + hh * 128 + sbase), ds = *(const LAS f32x4*)(tab + hh * 128 + sbase);
#pragma unroll
                for (int e = 0; e < 4; ++e) { const int r = 4 * q4 + e; float v = gt[r] * __builtin_amdgcn_exp2f(fminf(acs_l - as[e], 0.f) * LOG2E) * ds[e];
                    if (sb == lb) { const int sl = 16 * (r >> 3) + 8 * hi + (r & 7); if (sl > r32) v = 0.f; if (sl == r32) v += Dh; }
                    sc[r] = v; } }
            v4u scb[2];
            scb[0] = (v4u){att::cvtpk(sc[0], sc[1]), att::cvtpk(sc[2], sc[3]), att::cvtpk(sc[4], sc[5]), att::cvtpk(sc[6], sc[7])};
            scb[1] = (v4u){att::cvtpk(sc[8], sc[9]), att::cvtpk(sc[10], sc[11]), att::cvtpk(sc[12], sc[13]), att::cvtpk(sc[14], sc[15])};
#pragma unroll
            for (int pb = 0; pb < 2; ++pb)
#pragma unroll
                for (int k2 = 0; k2 < 2; ++k2) { const bf16x8 xf = *(const GAS bf16x8*)(XTg + (size_t)(hh * 64 + 32 * pb + r32) * 128 + 32 * sb + 16 * k2 + 8 * hi);
                    acc[hh2][pb] = __builtin_amdgcn_mfma_f32_32x32x16_bf16(xf, __builtin_bit_cast(bf16x8, scb[k2]), acc[hh2][pb], 0, 0, 0); }
        }
    }
    const size_t t = t0 + l_loc; const bf16* Zg = (const bf16*)(ws + WS_Z) + t * 512 + g * 256;
    float ss = 0.f;
#pragma unroll
    for (int hh2 = 0; hh2 < 2; ++hh2)
#pragma unroll
        for (int pb = 0; pb < 2; ++pb)
#pragma unroll
            for (int rg = 0; rg < 4; ++rg) { const int ch = (2 * hp + hh2) * 64 + 32 * pb + 8 * rg + 4 * hi; const v2u z = *(const GAS v2u*)(Zg + ch);
                const float y0 = acc[hh2][pb][4 * rg] * bflo(z.x), y1 = acc[hh2][pb][4 * rg + 1] * bfhi(z.x), y2 = acc[hh2][pb][4 * rg + 2] * bflo(z.y), y3 = acc[hh2][pb][4 * rg + 3] * bfhi(z.y);
                acc[hh2][pb][4 * rg] = y0; acc[hh2][pb][4 * rg + 1] = y1; acc[hh2][pb][4 * rg + 2] = y2; acc[hh2][pb][4 * rg + 3] = y3;
                ss += (y0 * y0 + y1 * y1) + (y2 * y2 + y3 * y3); }
    ss += other_half(ss);
    if (hi == 0) tab[1024 + hp * 128 + l_loc] = ss;
    __syncthreads();
    const float rs = rsqrtf((tab[1024 + l_loc] + tab[1024 + 128 + l_loc]) * (1.f / 256.f) + EPS);
    bf16* Og = (bf16*)(ws + WS_MIXED) + t * 2048 + 1024 + g * 256; const float* nw = F.in[15] + g * 256;
#pragma unroll
    for (int hh2 = 0; hh2 < 2; ++hh2)
#pragma unroll
        for (int pb = 0; pb < 2; ++pb)
#pragma unroll
            for (int rg = 0; rg < 4; ++rg) { const int ch = (2 * hp + hh2) * 64 + 32 * pb + 8 * rg + 4 * hi; const f32x4 wv = *(const GAS f32x4*)(nw + ch);
                v2u o; o.x = pk2(acc[hh2][pb][4 * rg] * rs * wv[0], acc[hh2][pb][4 * rg + 1] * rs * wv[1]); o.y = pk2(acc[hh2][pb][4 * rg + 2] * rs * wv[2], acc[hh2][pb][4 * rg + 3] * rs * wv[3]);
                *(GAS v2u*)(Og + ch) = o; }
    __syncthreads();
}
}
struct Sched2 {
    int G, c; const char *A, *B;
    __device__ __forceinline__ bool next(int i, pg8::Unit& u) const {
        const long L = (long)i * G + c; if (L >= 256) return false;
        int wgid = (int)L; { const int xcd = wgid % 8, off = wgid / 8; wgid = xcd * 32 + off; }
        u.pm = (wgid / 64) * 8 + ((wgid % 64) % 8); u.pn = (wgid % 64) / 8; u.kind = 0;
        u.a = A + (size_t)u.pm * TSTEP; u.b = B + (size_t)u.pn * TSTEP; return true;
    }
    __device__ __forceinline__ void a_ready(const pg8::Unit&) const {}
    __device__ __forceinline__ void done(const pg8::Unit&) const {}
};
struct EpiF32 {
    static constexpr bool PERM = false, AFTER_DRAIN = false;
    float* O; int ldc;
    __device__ __forceinline__ void operator()(const pg8::f32x4 (&acc)[2][2][4][2], const pg8::Unit& u, int wr, int wc, int fr, int fq) const {
        const int row0 = u.pm * 256 + wr * 64 + fr, col0 = u.pn * 256 + wc * 32 + 4 * fq;
#pragma unroll
        for (int ai = 0; ai < 2; ++ai)
#pragma unroll
            for (int m = 0; m < 4; ++m) { float* rowp = O + (size_t)(row0 + ai * 128 + m * 16) * ldc + col0;
#pragma unroll
                for (int bj = 0; bj < 2; ++bj)
#pragma unroll
                    for (int n = 0; n < 2; ++n) *(pg8::f32x4*)(rowp + bj * 128 + n * 16) = acc[ai][bj][m][n]; }
    }
};
__device__ __forceinline__ void p5_final(Frame& F) {
    const int gw = F.vcu * NWAVES + F.wave, NGW = F.G * NWAVES;
    const float* o2 = (const float*)(F.ws + WS_O2); const GAS f32x4* wr = (const GAS f32x4*)F.in[19] + F.lane;
    for (int mrow = gw; mrow < M; mrow += NGW) {
        const GAS f32x4* orow = (const GAS f32x4*)(o2 + (size_t)mrow * DM) + F.lane; const GAS f32x4* xr = (const GAS f32x4*)(F.in[0] + (size_t)mrow * DM) + F.lane;
        GAS f32x4* outr = (GAS f32x4*)(F.out + (size_t)mrow * DM) + F.lane;
        f32x4 v[8]; float s = 0.f;
#pragma unroll
        for (int j = 0; j < 8; ++j) { v[j] = orow[64 * j]; s += (v[j].x * v[j].x + v[j].y * v[j].y) + (v[j].z * v[j].z + v[j].w * v[j].w); }
        const float rstd = rsqrtf(wave_sum(s) * (1.f / DM) + EPS);
#pragma unroll
        for (int j = 0; j < 8; ++j) outr[64 * j] = xr[64 * j] + v[j] * rstd * wr[64 * j];
    }
}
struct Args { const float* in[20]; float* out; unsigned char* ws; int ph_lo, ph_hi; };
__global__ void __launch_bounds__(NTHR, 2) mega(Args args) {
    extern __shared__ __attribute__((aligned(16))) unsigned char lds[];
    Frame F;
    F.lds = (LAS unsigned char*)lds;
    F.tid = threadIdx.x; F.lane = F.tid & 63; F.wave = __builtin_amdgcn_readfirstlane(F.tid >> 6);
    F.G = gridDim.x; { const int bx = blockIdx.x; F.vcu = (F.G % 8 == 0) ? (bx % 8) * (F.G / 8) + bx / 8 : bx; }
#pragma unroll
    for (int i = 0; i < 20; ++i) F.in[i] = args.in[i];
    F.out = args.out; F.ws = args.ws;
    const int lo = args.ph_lo, hi = args.ph_hi;
#define IN(k) (lo <= (k) && (k) < hi)
    cooperative_groups::grid_group grid = cooperative_groups::this_grid();
#define SEAM(k) do { if (IN(k) && IN((k) + 1)) grid.sync(); } while (0)
    if (IN(0)) { p0_prologue(F); }
    SEAM(0);
    if (IN(1)) {
        pg8::Gemm g{DM}; Sched1 S{F.G, (int)blockIdx.x, (const char*)(F.ws + WS_HN), (const char*)(F.ws + WS_W1T), (const char*)(F.ws + WS_MEMN), (const char*)(F.ws + WS_WKVT)};
        EpiP1 E{F.ws};
        pg8::gemm_phase<EpiP1, Sched1, true, true>(F.lds, g, S, E);
    }
    SEAM(1);
    if (IN(2)) {
        for (int u = F.vcu; u < 256; u += F.G) { if (u < 128) att::xattn_unit(F, u >> 5, (u >> 3) & 3, u & 7); else { const int v = u - 128; ssd::unitA(F, v >> 5, (v >> 1) & 15, v & 1); } }
    }
    SEAM(2);
    if (IN(3)) {
        const float d1 = wave_sum(F.lane < 64 ? F.in[5][F.lane] * F.in[6][F.lane] : 0.f), d2 = wave_sum(F.in[7][F.lane] * F.in[8][F.lane]);
        const float lam = __expf(d1) - __expf(d2) + LAMBDA_INIT;
        for (int v = F.vcu; v < 256; v += F.G) { const int bh = v >> 3, s = v & 7;
            att::diff_unit(F, bh >> 3, bh & 7, s, lam); att::diff_unit(F, bh >> 3, bh & 7, 15 - s, lam); }
        for (int v = F.vcu; v < 128; v += F.G) ssd::unitB(F, v >> 5, (v >> 1) & 15, v & 1);
    }
    SEAM(3);
    if (IN(4)) {
        pg8::Gemm g{DM}; Sched2 S{F.G, (int)blockIdx.x, (const char*)(F.ws + WS_MIXED), (const char*)(F.ws + WS_WOT)};
        EpiF32 E{(float*)(F.ws + WS_O2), DM};
        pg8::gemm_phase<EpiF32, Sched2, false, true>(F.lds, g, S, E);
    }
    SEAM(4);
    if (IN(5)) p5_final(F);
#undef SEAM
#undef IN
}
constexpr int LDS_BYTES = 147456;
extern "C" void kernel_launch(void* const* d_in, const int* in_sizes, int n_in, void* d_out, int out_size, void* d_ws, size_t ws_size, hipStream_t stream) {
    static int grid = 0;
    if (grid == 0) {
        if (n_in != 20 || in_sizes[0] != M * DM || out_size != M * DM || ws_size < WS_END) { fprintf(stderr, "kernel_launch: unexpected shapes (n_in %d, ws %zu)\n", n_in, ws_size); grid = -1; return; }
        int dev = 0, cus = 0, per_cu = 0;
        (void)hipGetDevice(&dev); (void)hipDeviceGetAttribute(&cus, hipDeviceAttributeMultiprocessorCount, dev);
        (void)hipFuncSetAttribute((const void*)mega, hipFuncAttributeMaxDynamicSharedMemorySize, LDS_BYTES);
        (void)hipOccupancyMaxActiveBlocksPerMultiprocessor(&per_cu, (const void*)mega, NTHR, LDS_BYTES);
        if (per_cu < 1) { fprintf(stderr, "kernel_launch: occupancy query says %d\n", per_cu); per_cu = 1; }
        (void)hipGetLastError();
        grid = cus * (per_cu < 1 ? 1 : 1);
    }
    if (grid < 0) return;
    unsigned char* ws = (unsigned char*)d_ws;
    Args a{};
    for (int i = 0; i < 20; ++i) a.in[i] = (const float*)d_in[i];
    a.out = (float*)d_out; a.ws = ws;
    a.ph_lo = 0; a.ph_hi = 6;
    void* kargs[] = {&a};
    hipError_t e = hipLaunchCooperativeKernel((const void*)mega, dim3(grid), dim3(NTHR), kargs, LDS_BYTES, stream);
    if (e != hipSuccess) fprintf(stderr, "kernel_launch: cooperative launch failed: %s (grid %d)\n", hipGetErrorString(e), grid);
}
```

```cpp
#include <hip/hip_runtime.h>
#include <hip/hip_cooperative_groups.h>
#include <cstdio>
#include <cstdint>
#include <cmath>
namespace pg8 {
#define PG8_LAS __attribute__((address_space(3)))
typedef unsigned short bf16_t;
typedef short bf16x8 __attribute__((ext_vector_type(8)));
typedef float f32x4 __attribute__((ext_vector_type(4)));
typedef unsigned u32x4 __attribute__((ext_vector_type(4)));
constexpr int BM = 256, BK = 64, HALF = 128, HTB = HALF * BK * 2  , STAGE_BYTES = 8 * HTB, NXCD = 8, WGM = 8;

__host__ __device__ __forceinline__ int lds_byte(int r, int c) { const int st = (r >> 4) * 2 + (c >> 5), rr = r & 15, cc = c & 31, ob = rr * 64 + cc * 2; return st * 1024 + (ob ^ (((ob >> 9) & 1) << 5)); }
__host__ __device__ __forceinline__ void stage_rc(int b, int& R, int& C) { const int st = b / 1024, sb = b % 1024, swz = sb ^ (((sb >> 9) & 1) << 5); R = (st >> 1) * 16 + swz / 64; C = (st & 1) * 32 + (swz % 64) / 2; }
__host__ __device__ __forceinline__ int perm32(int rho) { const int n = rho >> 4, i = rho & 15; return 8 * (i >> 2) + 4 * n + (i & 3); }

struct Unit { const char* a; const char* b; int pm, pn, kind; };
struct Gemm { int K; };

__device__ __forceinline__ unsigned cvt_pk_bf16(float lo, float hi) { unsigned r; asm volatile("v_cvt_pk_bf16_f32 %0, %1, %2" : "=v"(r) : "v"(lo), "v"(hi)); return r; }
template <class Epi, class Sched, bool ALIGN_EPI = false, bool SP2 = false>
__device__ __forceinline__ void gemm_phase(PG8_LAS unsigned char* lds, const Gemm g, const Sched& S, const Epi& E) {
    const int tid = threadIdx.x, wid = __builtin_amdgcn_readfirstlane(tid >> 6), lane = tid & 63, wr = wid >> 2, wc = wid & 3, fr = lane & 15, fq = lane >> 4;
    const int K = g.K, nt = K / BK;
    unsigned voffA[2], voffB[2];
#pragma unroll
    for (int i = 0; i < 2; ++i) { int R, C; stage_rc(tid * 16 + i * 8192, R, C); const int Rb = Epi::PERM ? ((R & ~31) + perm32(R & 31)) : R;
        voffA[i] = (unsigned)(R * K + C) * 2u; voffB[i] = (unsigned)(Rb * K + C) * 2u; }
    const size_t kstep = (size_t)(BK * 2);
    const size_t hstep = (size_t)HALF * K * 2;
        const unsigned ldsw = (unsigned)wid * 1024u;
    const int aoff = lds_byte(wr * 64 + fr, fq * 8), boff = lds_byte(wc * 32 + fr, fq * 8);
#define PG8_SA(b, h) (((b) * 2 + (h)) * HTB)
#define PG8_SB(b, h) ((4 + (b) * 2 + (h)) * HTB)
#define PG8_STAGE(bufoff, gbase, voff) do { _Pragma("unroll") for (int _i = 0; _i < 2; ++_i) \
        __builtin_amdgcn_global_load_lds((const unsigned*)((const char*)(gbase) + (voff)[_i]), (PG8_LAS unsigned*)(lds + (bufoff) + ldsw + _i * 8192), 16, 0, 0); } while (0)
#define PG8_LDA(dst, b, h) do { _Pragma("unroll") for (int m = 0; m < 4; ++m) _Pragma("unroll") for (int k = 0; k < 2; ++k) dst[m][k] = *(const PG8_LAS bf16x8*)(lds + PG8_SA(b, h) + aoff + m * 2048 + k * 1024); } while (0)
#define PG8_LDB(dst, b, h) do { _Pragma("unroll") for (int n = 0; n < 2; ++n) _Pragma("unroll") for (int k = 0; k < 2; ++k) dst[n][k] = *(const PG8_LAS bf16x8*)(lds + PG8_SB(b, h) + boff + n * 2048 + k * 1024); } while (0)
#define PG8_MMA(ai, bj, At, Bt) do { __builtin_amdgcn_s_setprio(1); _Pragma("unroll") for (int m = 0; m < 4; ++m) _Pragma("unroll") for (int n = 0; n < 2; ++n) _Pragma("unroll") for (int k = 0; k < 2; ++k) \
        acc[ai][bj][m][n] = __builtin_amdgcn_mfma_f32_16x16x32_bf16(Bt[n][k], At[m][k], acc[ai][bj][m][n], 0, 0, 0); __builtin_amdgcn_s_setprio(0); } while (0)
#define PG8_WAIT_V(n) asm volatile("s_waitcnt vmcnt(" #n ")" ::: "memory")
#define PG8_WAIT_L(n) asm volatile("s_waitcnt lgkmcnt(" #n ")" ::: "memory")
#define PG8_BAR __builtin_amdgcn_s_barrier()
#define PG8_SCHED __builtin_amdgcn_sched_barrier(0)
    Unit cur, nxt; int ui = 0;
    if (!S.next(0, cur)) return;
    f32x4 acc[2][2][4][2];
#pragma unroll
    for (int a = 0; a < 2; ++a)
#pragma unroll
        for (int b = 0; b < 2; ++b)
#pragma unroll
            for (int m = 0; m < 4; ++m)
#pragma unroll
                for (int n = 0; n < 2; ++n) acc[a][b][m][n] = (f32x4){0.f, 0.f, 0.f, 0.f};
    bf16x8 At[4][2], B0[2][2], B1[2][2];
    const char* cA = cur.a; const char* cB = cur.b;
    S.a_ready(cur);
    if constexpr (SP2) {
        PG8_STAGE(PG8_SB(0, 0), cB, voffB); PG8_STAGE(PG8_SB(0, 1), cB + hstep, voffB); PG8_STAGE(PG8_SA(0, 0), cA, voffA); PG8_STAGE(PG8_SA(0, 1), cA + hstep, voffA);
        if (wr == 1) PG8_BAR;
        PG8_WAIT_V(2); PG8_BAR;
        PG8_STAGE(PG8_SB(1, 0), cB + kstep, voffB); PG8_STAGE(PG8_SA(1, 0), cA + kstep, voffA); PG8_STAGE(PG8_SB(1, 1), cB + hstep + kstep, voffB);
        PG8_WAIT_V(6); PG8_BAR;
    } else {
        PG8_STAGE(PG8_SB(0, 0), cB, voffB); PG8_STAGE(PG8_SA(0, 0), cA, voffA); PG8_STAGE(PG8_SB(0, 1), cB + hstep, voffB); PG8_STAGE(PG8_SA(0, 1), cA + hstep, voffA);
        if (wr == 1) PG8_BAR;
        PG8_WAIT_V(4); PG8_BAR;
        PG8_STAGE(PG8_SB(1, 0), cB + kstep, voffB); PG8_STAGE(PG8_SA(1, 0), cA + kstep, voffA); PG8_STAGE(PG8_SB(1, 1), cB + hstep + kstep, voffB);
        PG8_WAIT_V(6); PG8_BAR;
    }
    for (;;) {
        const bool has_next = S.next(ui + 1, nxt);
        const char* nA = has_next ? nxt.a : cA; const char* nB = has_next ? nxt.b : cB;
        for (int t = 0; t < nt; t += 2) {
            const bool last = (t == nt - 2);
            const char* a1 = cA + (size_t)(t + 1) * kstep;
            const char* a2 = last ? nA : cA + (size_t)(t + 2) * kstep; const char* b2 = last ? nB : cB + (size_t)(t + 2) * kstep;
            const char* a3 = a2 + kstep; const char* b3 = b2 + kstep;
            if (last && has_next) S.a_ready(nxt);
            if constexpr (SP2) {
            PG8_LDB(B0, 0, 0); PG8_LDB(B1, 0, 1); PG8_SCHED; PG8_LDA(At, 0, 0); PG8_STAGE(PG8_SA(1, 1), a1 + hstep, voffA);
            PG8_WAIT_V(8); PG8_WAIT_L(0); PG8_BAR; PG8_MMA(0, 0, At, B0); PG8_MMA(0, 1, At, B1); PG8_BAR; PG8_SCHED;
            PG8_LDA(At, 0, 1); PG8_STAGE(PG8_SB(0, 0), b2, voffB); PG8_STAGE(PG8_SB(0, 1), b2 + hstep, voffB); PG8_STAGE(PG8_SA(0, 0), a2, voffA);
            PG8_WAIT_V(8); PG8_WAIT_L(0); PG8_BAR; PG8_MMA(1, 0, At, B0); PG8_MMA(1, 1, At, B1); PG8_BAR; PG8_SCHED;
            PG8_LDB(B0, 1, 0); PG8_LDB(B1, 1, 1); PG8_SCHED; PG8_LDA(At, 1, 0); PG8_STAGE(PG8_SA(0, 1), a2 + hstep, voffA);
            PG8_WAIT_V(8); PG8_WAIT_L(0); PG8_BAR; PG8_MMA(0, 0, At, B0); PG8_MMA(0, 1, At, B1); PG8_BAR; PG8_SCHED;
            PG8_LDA(At, 1, 1); PG8_STAGE(PG8_SB(1, 0), b3, voffB); PG8_STAGE(PG8_SB(1, 1), b3 + hstep, voffB); PG8_STAGE(PG8_SA(1, 0), a3, voffA);
            PG8_WAIT_V(8); PG8_WAIT_L(0); PG8_BAR; PG8_MMA(1, 0, At, B0); PG8_MMA(1, 1, At, B1); PG8_BAR; PG8_SCHED;
            } else {
            PG8_LDB(B0, 0, 0); PG8_SCHED; PG8_LDA(At, 0, 0); PG8_STAGE(PG8_SA(1, 1), a1 + hstep, voffA);
            PG8_WAIT_L(8); PG8_BAR; PG8_WAIT_L(0); PG8_MMA(0, 0, At, B0); PG8_BAR; PG8_SCHED;
            PG8_LDB(B1, 0, 1); PG8_STAGE(PG8_SB(0, 0), b2, voffB);
            PG8_BAR; PG8_WAIT_L(0); PG8_MMA(0, 1, At, B1); PG8_BAR;
            PG8_LDA(At, 0, 1); PG8_STAGE(PG8_SA(0, 0), a2, voffA);
            PG8_BAR; PG8_WAIT_L(0); PG8_MMA(1, 0, At, B0); PG8_BAR; PG8_SCHED;
            PG8_STAGE(PG8_SB(0, 1), b2 + hstep, voffB);
            PG8_WAIT_V(6); PG8_BAR; PG8_MMA(1, 1, At, B1); PG8_BAR;
            PG8_LDB(B0, 1, 0); PG8_SCHED; PG8_LDA(At, 1, 0); PG8_STAGE(PG8_SA(0, 1), a2 + hstep, voffA);
            PG8_WAIT_L(8); PG8_BAR; PG8_WAIT_L(0); PG8_MMA(0, 0, At, B0); PG8_BAR; PG8_SCHED;
            PG8_LDB(B1, 1, 1); PG8_STAGE(PG8_SB(1, 0), b3, voffB);
            PG8_BAR; PG8_WAIT_L(0); PG8_MMA(0, 1, At, B1); PG8_BAR;
            PG8_LDA(At, 1, 1); PG8_STAGE(PG8_SA(1, 0), a3, voffA);
            PG8_BAR; PG8_WAIT_L(0); PG8_MMA(1, 0, At, B0); PG8_BAR; PG8_SCHED;
            PG8_STAGE(PG8_SB(1, 1), b3 + hstep, voffB);
            PG8_WAIT_V(6); PG8_BAR; PG8_MMA(1, 1, At, B1); PG8_BAR;
            }
        }
        if constexpr (ALIGN_EPI) { if (wr == 0) PG8_BAR; }
        if constexpr (!Epi::AFTER_DRAIN) { E(acc, cur, wr, wc, fr, fq); S.done(cur); }
        if (!has_next) break;
#pragma unroll
        for (int a = 0; a < 2; ++a)
#pragma unroll
            for (int b = 0; b < 2; ++b)
#pragma unroll
                for (int m = 0; m < 4; ++m)
#pragma unroll
                    for (int n = 0; n < 2; ++n) acc[a][b][m][n] = (f32x4){0.f, 0.f, 0.f, 0.f};
        cur = nxt; cA = nA; cB = nB; ++ui;
        if constexpr (ALIGN_EPI) { if (wr == 1) PG8_BAR; }
    }
    PG8_WAIT_V(0);
    if constexpr (!ALIGN_EPI) { if (wr == 0) PG8_BAR; }
    PG8_BAR;
    if constexpr (Epi::AFTER_DRAIN) { E.fused(acc, cur, wr, wc, fr, fq, lds, wid, lane); S.done(cur); }
#undef PG8_SA
#undef PG8_SB
#undef PG8_STAGE
#undef PG8_LDA
#undef PG8_LDB
#undef PG8_MMA
#undef PG8_WAIT_V
#undef PG8_WAIT_L
#undef PG8_BAR
#undef PG8_SCHED
}
}
constexpr int NWAVES = 8, NTHR = NWAVES * 64;
constexpr int BATCH = 4, SEQ = 2048, DM = 2048, M = BATCH * SEQ, DIN = 6664, MEMLEN = 256, MM = BATCH * MEMLEN;
constexpr int NW1 = 6656;
constexpr float EPS = 1e-6f, LOG2E = 1.4426950408889634f;
constexpr float C2Q = 0.125f * LOG2E;
constexpr float C2X = 0.08838834764831845f * LOG2E;
constexpr float LAMBDA_INIT = 0.2f;
constexpr size_t MiB = 1u << 20;
constexpr size_t WS_CTL = 0, CTL_ZERO_BYTES = 1 * MiB;
constexpr size_t WS_W1T = 1 * MiB, WS_WOT = 27 * MiB, WS_WKVT = 35 * MiB, WS_HN = 39 * MiB, WS_MEMN = 71 * MiB;
constexpr size_t WS_DT = 75 * MiB, WS_ACS = 75 * MiB + 256 * 1024, WS_ROPE = 76 * MiB;
constexpr size_t WS_Q = 78 * MiB, WS_K = 94 * MiB, WS_VT = 110 * MiB, WS_G = 126 * MiB, WS_Z = 142 * MiB, WS_XBC = 150 * MiB, WS_XQ = 166 * MiB, WS_XG = 174 * MiB;
constexpr size_t WS_MK = 182 * MiB, WS_MVT = 183 * MiB, WS_XT = 184 * MiB, WS_BC = 192 * MiB, WS_CS = 200 * MiB, WS_MIXED = 216 * MiB, WS_END = 248 * MiB;
constexpr size_t WS_O2 = 39 * MiB;
constexpr size_t TSTEP = (size_t)256 * DM * 2;

#define GAS __attribute__((address_space(1)))
#define LAS __attribute__((address_space(3)))
typedef unsigned short bf16;
typedef unsigned v4u __attribute__((ext_vector_type(4)));
typedef unsigned v2u __attribute__((ext_vector_type(2)));
typedef float f32x4 __attribute__((ext_vector_type(4)));
typedef float f32x16 __attribute__((ext_vector_type(16)));
typedef short bf16x8 __attribute__((ext_vector_type(8)));
#define LDS_WAIT() asm volatile("s_waitcnt lgkmcnt(0)" ::: "memory")
#define VM_WAIT() asm volatile("s_waitcnt vmcnt(0)" ::: "memory")
__device__ __forceinline__ unsigned f2bf(float f) { unsigned u = __builtin_bit_cast(unsigned, f); return (u + 0x7fffu + ((u >> 16) & 1u)) >> 16; }
__device__ __forceinline__ unsigned pk2(float lo, float hi) { return f2bf(lo) | (f2bf(hi) << 16); }
__device__ __forceinline__ float bf2f(bf16 v) { return __builtin_bit_cast(float, (unsigned)v << 16); }
__device__ __forceinline__ float bflo(unsigned w) { return __builtin_bit_cast(float, w << 16); }
__device__ __forceinline__ float bfhi(unsigned w) { return __builtin_bit_cast(float, w & 0xffff0000u); }
__device__ __forceinline__ float silu_f(float v) { return v / (1.f + __expf(-v)); }
__device__ __forceinline__ float wave_sum(float v) {
#pragma unroll
    for (int o = 1; o < 64; o <<= 1) v += __shfl_xor(v, o);
    return v;
}

struct Frame {
    LAS unsigned char* lds;
    int tid, lane, wave, vcu, G;
    const float* in[20]; float* out; unsigned char* ws;
};

__device__ __forceinline__ int w1_src_col(int r) {
    if (r < 2048) { const int p = r & 63, i = p >> 2, j = p & 3; return (r & ~63) + 2 * i + (j & 1) + 32 * (j >> 1); }
    if (r < 3072) return 3072 + (r - 2048);
    if (r < 3584) return 4096 + (r - 3072);
    if (r < 4608) return 4608 + (r - 3584);
    if (r < 5120) return 5640 + (r - 4608);
    if (r < 5632) return 6152 + (r - 5120);
    return 2048 + (r - 5632);
}
template <bool MAP>
__device__ __forceinline__ void p0_transpose_item(const float* W, int K, int N, bf16* WT, LAS float* scr, int item, int lane) {
    const int nkb = K / 64, nb = item / nkb, kb = item % nkb, k0 = 64 * kb, n0 = 32 * nb;
    const int sc = MAP ? w1_src_col(n0 + (lane & 31)) : n0 + (lane & 31);
#pragma unroll 8
    for (int i = 0; i < 32; ++i) { const int kk = 2 * i + (lane >> 5); scr[kk * 33 + (lane & 31)] = W[(size_t)(k0 + kk) * N + sc]; }
    LDS_WAIT(); asm volatile("" ::: "memory");
    const int c = lane & 7;
#pragma unroll
    for (int j = 0; j < 4; ++j) { const int n = (lane >> 3) + 8 * j; const LAS float* s = scr + (8 * c) * 33 + n;
        v4u o; o.x = pk2(s[0 * 33], s[1 * 33]); o.y = pk2(s[2 * 33], s[3 * 33]); o.z = pk2(s[4 * 33], s[5 * 33]); o.w = pk2(s[6 * 33], s[7 * 33]);
        *(GAS v4u*)(WT + (size_t)(n0 + n) * K + k0 + 8 * c) = o; }
    LDS_WAIT(); asm volatile("" ::: "memory");
}
template <bool WITH_DT>
__device__ __forceinline__ void p0_norm_row(const float* xrow, const float* w, bf16* orow, const LAS float* wdt, const float* dtb, float* dtrow, int lane) {
    const GAS f32x4* xr = (const GAS f32x4*)xrow + lane; const GAS f32x4* wr = (const GAS f32x4*)w + lane;
    f32x4 v[8]; float s = 0.f;
#pragma unroll
    for (int j = 0; j < 8; ++j) { v[j] = xr[64 * j]; s += (v[j].x * v[j].x + v[j].y * v[j].y) + (v[j].z * v[j].z + v[j].w * v[j].w); }
    const float rstd = rsqrtf(wave_sum(s) * (1.f / DM) + EPS);
    GAS v2u* o8 = (GAS v2u*)orow + lane;
#pragma unroll
    for (int j = 0; j < 8; ++j) { v[j] = v[j] * rstd * wr[64 * j]; v2u o; o.x = pk2(v[j].x, v[j].y); o.y = pk2(v[j].z, v[j].w); o8[64 * j] = o; }
    if (WITH_DT) {
        float d[8];
#pragma unroll
        for (int h = 0; h < 8; ++h) { float a = 0.f;
#pragma unroll
            for (int j = 0; j < 8; ++j) { const f32x4 ww = *(const LAS f32x4*)(wdt + h * DM + 4 * (lane + 64 * j)); a += (v[j].x * ww.x + v[j].y * ww.y) + (v[j].z * ww.z + v[j].w * ww.w); }
            d[h] = wave_sum(a); }
        float mine = 0.f;
#pragma unroll
        for (int h = 0; h < 8; ++h) mine = (lane == h) ? d[h] : mine;
        if (lane < 8) { const float r = mine + dtb[lane]; dtrow[lane] = (r > 20.f) ? r : log1pf(__expf(r)); }
    }
}
__device__ __forceinline__ void p0_prologue(Frame& F) {
    LAS float* scr = (LAS float*)(F.lds + F.wave * 16384);
    const int gw = F.vcu * NWAVES + F.wave, NGW = F.G * NWAVES;
    unsigned char* ws = F.ws;
    constexpr int I_1 = (NW1 / 32) * (DM / 64), I_O = (DM / 32) * (DM / 64), I_KV = (1024 / 32) * (DM / 64);
    for (int it = gw; it < I_1 + I_O + I_KV; it += NGW) {
        int r = it;
        if (r < I_1) { p0_transpose_item<true>(F.in[4], DM, DIN, (bf16*)(ws + WS_W1T), scr, r, F.lane); continue; } r -= I_1;
        if (r < I_O) { p0_transpose_item<false>(F.in[18], DM, DM, (bf16*)(ws + WS_WOT), scr, r, F.lane); continue; } r -= I_O;
        p0_transpose_item<false>(F.in[17], DM, 1024, (bf16*)(ws + WS_WKVT), scr, r, F.lane);
    }
    { const int* pos = (const int*)F.in[2]; float* rope = (float*)(ws + WS_ROPE);
      for (int idx = (F.vcu * NTHR + F.tid); idx < M * 32; idx += F.G * NTHR) { const int t = idx >> 5, f = idx & 31;
          const float inv = 1.0f / powf(10000.f, (float)(2 * f) / 64.f); const float ang = (float)pos[t] * inv;
          rope[2 * idx] = cosf(ang); rope[2 * idx + 1] = sinf(ang); } }
    __syncthreads();
    LAS float* wdt = (LAS float*)F.lds;
    for (int idx = F.tid; idx < DM * 8; idx += NTHR) { const int k = idx >> 3, h = idx & 7; wdt[h * DM + k] = F.in[4][(size_t)k * DIN + 5632 + h]; }
    __syncthreads();
    for (int m = gw; m < M + MM; m += NGW) {
        if (m < M) p0_norm_row<true>(F.in[0] + (size_t)m * DM, F.in[3], (bf16*)(ws + WS_HN) + (size_t)m * DM, wdt, F.in[12], (float*)(ws + WS_DT) + (size_t)m * 8, F.lane);
        else p0_norm_row<false>(F.in[1] + (size_t)(m - M) * DM, F.in[16], (bf16*)(ws + WS_MEMN) + (size_t)(m - M) * DM, wdt, nullptr, nullptr, F.lane);
    }
    __syncthreads();
}

struct Sched1 {
    int G, c; const char *HN, *W1T, *MEMN, *WKVT;
    __device__ __forceinline__ bool next(int i, pg8::Unit& u) const {
        const long L = (long)i * G + c; if (L >= 848) return false;
        if (L < 704) {
            int wgid = (int)L; { const int xcd = wgid % 8, off = wgid / 8; wgid = xcd * 88 + off; }
            const int pm = (wgid / 176) * 8 + ((wgid % 176) % 8), pn = (wgid % 176) / 8;
            u.kind = 0; u.pm = pm; u.pn = pn; u.a = HN + (size_t)pm * TSTEP; u.b = W1T + (size_t)pn * TSTEP;
        } else if (L < 832) { const int r = (int)L - 704;
            u.kind = 1; u.pm = r & 3; u.pn = r >> 2; u.a = W1T + (size_t)(22 + u.pm) * TSTEP; u.b = HN + (size_t)u.pn * TSTEP;
        } else if (L < 840) { const int r = (int)L - 832;
            u.kind = 2; u.pm = r & 3; u.pn = r >> 2; u.a = MEMN + (size_t)u.pm * TSTEP; u.b = WKVT + (size_t)u.pn * TSTEP;
        } else { const int r = (int)L - 840;
            u.kind = 3; u.pm = r & 1; u.pn = r >> 1; u.a = WKVT + (size_t)(2 + u.pm) * TSTEP; u.b = MEMN + (size_t)u.pn * TSTEP; }
        return true;
    }
    __device__ __forceinline__ void a_ready(const pg8::Unit&) const {}
    __device__ __forceinline__ void done(const pg8::Unit&) const {}
};
struct EpiP1 {
    static constexpr bool PERM = true, AFTER_DRAIN = false;
    unsigned char* ws;
    __device__ __forceinline__ void operator()(const pg8::f32x4 (&acc)[2][2][4][2], const pg8::Unit& u, int wr, int wc, int fr, int fq) const {
        bf16* base; int ldc, op = 0, colt; float sc = 1.f;
        if (u.kind == 0) { const int pn = u.pn;
            if (pn < 4) { base = (bf16*)(ws + WS_Q); ldc = 1024; colt = pn * 256; op = 2; sc = C2Q; }
            else if (pn < 8) { base = (bf16*)(ws + WS_K); ldc = 1024; colt = (pn - 4) * 256; op = 2; }
            else if (pn < 12) { base = (bf16*)(ws + WS_G); ldc = 1024; colt = (pn - 8) * 256; op = 1; }
            else if (pn < 14) { base = (bf16*)(ws + WS_Z); ldc = 512; colt = (pn - 12) * 256; op = 1; }
            else if (pn < 18) { base = (bf16*)(ws + WS_XBC); ldc = 1024; colt = (pn - 14) * 256; }
            else if (pn < 20) { base = (bf16*)(ws + WS_XQ); ldc = 512; colt = (pn - 18) * 256; sc = C2X; }
            else { base = (bf16*)(ws + WS_XG); ldc = 512; colt = (pn - 20) * 256; op = 1; }
        } else if (u.kind == 1) { base = (bf16*)(ws + WS_VT); ldc = M; colt = u.pn * 256; }
        else if (u.kind == 2) { base = (bf16*)(ws + WS_MK); ldc = 512; colt = u.pn * 256; }
        else { base = (bf16*)(ws + WS_MVT); ldc = MM; colt = u.pn * 256; }
        const int row0 = u.pm * 256 + wr * 64 + fr, col0 = colt + wc * 32 + 8 * fq;
        const float* rope = (const float*)(ws + WS_ROPE); const int i0 = 8 * (wc & 1) + 2 * fq;
#pragma unroll
        for (int ai = 0; ai < 2; ++ai)
#pragma unroll
            for (int m = 0; m < 4; ++m) { const int row = row0 + ai * 128 + m * 16; bf16* rowp = base + (size_t)row * ldc + col0;
                f32x4 cs0 = {1.f, 0.f, 1.f, 0.f}, cs1 = {1.f, 0.f, 1.f, 0.f};
                if (op == 2) { cs0 = *(const f32x4*)(rope + ((size_t)row * 32 + 2 * i0) * 2); cs1 = *(const f32x4*)(rope + ((size_t)row * 32 + 2 * i0 + 2) * 2); }
#pragma unroll
                for (int bj = 0; bj < 2; ++bj) { f32x4 v0 = acc[ai][bj][m][0], v1 = acc[ai][bj][m][1];
                    if (op == 1) { v0 = (f32x4){silu_f(v0[0]), silu_f(v0[1]), silu_f(v0[2]), silu_f(v0[3])}; v1 = (f32x4){silu_f(v1[0]), silu_f(v1[1]), silu_f(v1[2]), silu_f(v1[3])}; }
                    if (op == 2) {
                        v0 = (f32x4){v0[0] * cs0[0] - v0[2] * cs0[1], v0[1] * cs0[2] - v0[3] * cs0[3], v0[2] * cs0[0] + v0[0] * cs0[1], v0[3] * cs0[2] + v0[1] * cs0[3]};
                        v1 = (f32x4){v1[0] * cs1[0] - v1[2] * cs1[1], v1[1] * cs1[2] - v1[3] * cs1[3], v1[2] * cs1[0] + v1[0] * cs1[1], v1[3] * cs1[2] + v1[1] * cs1[3]}; }
                    v0 = v0 * sc; v1 = v1 * sc;
                    v4u w; w.x = pg8::cvt_pk_bf16(v0[0], v0[1]); w.y = pg8::cvt_pk_bf16(v0[2], v0[3]); w.z = pg8::cvt_pk_bf16(v1[0], v1[1]); w.w = pg8::cvt_pk_bf16(v1[2], v1[3]);
                    *(v4u*)(rowp + bj * 128) = w; } }
    }
};
#define XB_TMO      128
#define XB_XCNT(j)  (256  + 64 * (j))
#define XB_XSUB(j)  (1280 + 64 * (j))
#define XB_XGEN(j)  (2304 + 64 * (j))
#define XB_TOP      3328
#define XB_TOPGEN   3392
#define XCD_BAR_WORDS 3456
#define XB_SPIN_CAP (1u << 18)

__device__ __forceinline__ unsigned xb_ld(unsigned* p)              { return __hip_atomic_load(p, __ATOMIC_RELAXED, __HIP_MEMORY_SCOPE_AGENT); }
__device__ __forceinline__ unsigned xb_add(unsigned* p, unsigned v) { return __hip_atomic_fetch_add(p, v, __ATOMIC_RELAXED, __HIP_MEMORY_SCOPE_AGENT); }
__device__ __forceinline__ unsigned xb_xcc_id() { return (unsigned)__builtin_amdgcn_s_getreg((3 << 11) | 20) & 0xFu; }
#define XB_SPIN(cond, bar) do { unsigned _sp = 0; while (cond) { __builtin_amdgcn_s_sleep(1); \
    if ((++_sp & 255u) == 0u) { if (xb_ld(&(bar)[XB_TMO])) break; if (_sp > XB_SPIN_CAP) { atomicAdd(&(bar)[XB_TMO], 1u); break; } } } } while (0)

struct XcdBarrier {
    unsigned* bar; unsigned x;
    volatile LAS unsigned* st;
};

__device__ __forceinline__ XcdBarrier xcd_barrier_post(unsigned* bar, volatile LAS unsigned* st) {
    XcdBarrier b; b.bar = bar; b.x = xb_xcc_id(); b.st = st;
    if (threadIdx.x == 0) (void)xb_add(&bar[XB_XCNT(b.x)], 1u);
    return b;
}
__device__ __forceinline__ void xcd_barrier_complete(unsigned* bar, unsigned x, unsigned& nloc, unsigned& nx) {
    const unsigned G = gridDim.x * gridDim.y * gridDim.z;
    unsigned sum, cnt, mine, sp = 0u;
    for (;;) {
        sum = 0u; cnt = 0u; mine = 0u;
#pragma unroll
        for (unsigned j = 0; j < 16; ++j) { const unsigned c = xb_ld(&bar[XB_XCNT(j)]); sum += c; cnt += (c > 0u) ? 1u : 0u; mine = (j == x) ? c : mine; }
        if (sum == G) break;
        __builtin_amdgcn_s_sleep(1);
        if ((++sp & 255u) == 0u) { if (xb_ld(&bar[XB_TMO])) break; if (sp > XB_SPIN_CAP) { atomicAdd(&bar[XB_TMO], 1u); break; } }
    }
    nloc = mine > 0u ? mine : 1u; nx = cnt > 0u ? cnt : 1u;
}

__device__ __forceinline__ void xcd_barrier(const XcdBarrier& b) {
    asm volatile("s_waitcnt vmcnt(0)" ::: "memory");
    __syncthreads();
    if (threadIdx.x == 0) {
        unsigned* bar = b.bar;
        __builtin_amdgcn_s_waitcnt(0);
        unsigned nloc = b.st[0], nx = b.st[1];
        if (nloc == 0u) { xcd_barrier_complete(bar, b.x, nloc, nx); b.st[0] = nloc; b.st[1] = nx; }
        const unsigned old = xb_add(&bar[XB_XSUB(b.x)], 1u);
        const unsigned gen = old / nloc;
        if (old + 1u == (gen + 1u) * nloc) {
            __builtin_amdgcn_fence(__ATOMIC_RELEASE, "agent");
            asm volatile("s_waitcnt vmcnt(0)" ::: "memory");
            const unsigned og = xb_add(&bar[XB_TOP], 1u);
            const unsigned tg = og / nx;
            if (og + 1u == (tg + 1u) * nx) xb_add(&bar[XB_TOPGEN], 1u);
            else XB_SPIN(xb_ld(&bar[XB_TOPGEN]) == tg, bar);
            __builtin_amdgcn_fence(__ATOMIC_ACQUIRE, "agent");
            xb_add(&bar[XB_XGEN(b.x)], 1u);
            asm volatile("s_waitcnt vmcnt(0)" ::: "memory");
        } else {
            XB_SPIN(xb_ld(&bar[XB_XGEN(b.x)]) == gen, bar);
            __builtin_amdgcn_fence(__ATOMIC_ACQUIRE, "agent");
            asm volatile("s_waitcnt vmcnt(0)" ::: "memory");
        }
    }
    __syncthreads();
}
namespace att {
constexpr int STAGE = 32768;
__device__ __forceinline__ int k_off(int row, int ch) { return row * 256 + ((ch ^ (row & 15)) << 4); }
__device__ __forceinline__ int v_off(int row, int ch) { return 16384 + (row >> 1) * 256 + ((((row & 1) << 3) | (ch ^ ((row >> 1) & 7))) << 4); }
__device__ __forceinline__ int pi32(int i) { return (i & 0x13) | ((i & 4) << 1) | ((i & 8) >> 1); }
__device__ __forceinline__ float other_half(float v) {
    return __shfl_xor(v, 32);
}
__device__ __forceinline__ unsigned cvtpk(float lo, float hi) { typedef float f2 __attribute__((ext_vector_type(2))); typedef __bf16 b2 __attribute__((ext_vector_type(2))); f2 v = {lo, hi}; b2 b = __builtin_convertvector(v, b2); return __builtin_bit_cast(unsigned, b); }
struct StageRegs { v4u k[2], v[2]; };
__device__ __forceinline__ void stage_load(StageRegs& s, const bf16* Kp, int ldk, const bf16* VTp, int ldv, int kv0, int tid) {
#pragma unroll
    for (int i = 0; i < 2; ++i) { const int ci = tid + i * NTHR;
        s.k[i] = *(const GAS v4u*)(Kp + (size_t)(kv0 + (ci >> 4)) * ldk + (ci & 15) * 8);
        s.v[i] = *(const GAS v4u*)(VTp + (size_t)(ci >> 3) * ldv + kv0 + (ci & 7) * 8); }
}
__device__ __forceinline__ void stage_store(const StageRegs& s, LAS unsigned char* buf, int tid) {
#pragma unroll
    for (int i = 0; i < 2; ++i) { const int ci = tid + i * NTHR;
        *(LAS v4u*)(buf + k_off(ci >> 4, ci & 15)) = s.k[i];
        *(LAS v4u*)(buf + v_off(ci >> 3, ci & 7)) = s.v[i]; }
}
template <int KSTEPS, bool CAUSAL>
__device__ __forceinline__ void attn_core(LAS unsigned char* lds, const bf16* Qw, int ldq, const bf16* Kp, int ldk, const bf16* VTp, int ldv, int ntiles, int q0rel, int coff,
                                          f32x16 (&o)[4], float& m_out, float& l_out, int tid, int lane) {
    const int r32 = lane & 31, hi = lane >> 5;
    bf16x8 qf[KSTEPS];
#pragma unroll
    for (int ks = 0; ks < KSTEPS; ++ks) qf[ks] = *(const GAS bf16x8*)(Qw + (size_t)r32 * ldq + ks * 16 + hi * 8);
#pragma unroll
    for (int d = 0; d < 4; ++d)
#pragma unroll
        for (int r = 0; r < 16; ++r) o[d][r] = 0.f;
    float m = -1e30f, l = 0.f;
    const int krow = pi32(r32), kch0 = (coff >> 3) + hi;
    StageRegs sr;
    stage_load(sr, Kp, ldk, VTp, ldv, 0, tid);
    stage_store(sr, lds, tid);
    __syncthreads();
    for (int t = 0; t < ntiles; ++t) {
        LAS unsigned char* buf = lds + (t & 1) * STAGE;
        const bool more = (t + 1 < ntiles);
        if (more) stage_load(sr, Kp, ldk, VTp, ldv, (t + 1) * 64, tid);
        const int kv0 = t * 64;
        const bool active = !CAUSAL || (kv0 <= q0rel + 31);
        if (active) {
            f32x16 p0, p1;
#pragma unroll
            for (int r = 0; r < 16; ++r) { p0[r] = 0.f; p1[r] = 0.f; }
#pragma unroll
            for (int ks = 0; ks < KSTEPS; ++ks) {
                const bf16x8 a0 = *(const LAS bf16x8*)(buf + k_off(krow, kch0 + 2 * ks));
                const bf16x8 a1 = *(const LAS bf16x8*)(buf + k_off(32 + krow, kch0 + 2 * ks));
                p0 = __builtin_amdgcn_mfma_f32_32x32x16_bf16(a0, qf[ks], p0, 0, 0, 0);
                p1 = __builtin_amdgcn_mfma_f32_32x32x16_bf16(a1, qf[ks], p1, 0, 0, 0);
            }
            if (CAUSAL && (kv0 + 63 > q0rel)) {
                const int qg = q0rel + r32;
#pragma unroll
                for (int r = 0; r < 16; ++r) { const int kv = kv0 + 16 * (r >> 3) + 8 * hi + (r & 7); if (kv > qg) p0[r] = -INFINITY; if (kv + 32 > qg) p1[r] = -INFINITY; }
            }
            float rm = fmaxf(p0[0], p1[0]);
#pragma unroll
            for (int r = 1; r < 16; ++r) rm = fmaxf(rm, fmaxf(p0[r], p1[r]));
            rm = fmaxf(rm, other_half(rm));
            if (__any(rm > m + 8.f)) {
                const float mn = fmaxf(m, rm), al = __builtin_amdgcn_exp2f(m - mn);
                l *= al; m = mn;
#pragma unroll
                for (int d = 0; d < 4; ++d)
#pragma unroll
                    for (int r = 0; r < 16; ++r) o[d][r] *= al;
            }
            float ls = 0.f;
#pragma unroll
            for (int r = 0; r < 16; ++r) { p0[r] = __builtin_amdgcn_exp2f(p0[r] - m); p1[r] = __builtin_amdgcn_exp2f(p1[r] - m); ls += p0[r] + p1[r]; }
            l += ls;
            v4u pw[4];
#pragma unroll
            for (int s = 0; s < 2; ++s) {
                pw[s] = (v4u){cvtpk(p0[8 * s], p0[8 * s + 1]), cvtpk(p0[8 * s + 2], p0[8 * s + 3]), cvtpk(p0[8 * s + 4], p0[8 * s + 5]), cvtpk(p0[8 * s + 6], p0[8 * s + 7])};
                pw[2 + s] = (v4u){cvtpk(p1[8 * s], p1[8 * s + 1]), cvtpk(p1[8 * s + 2], p1[8 * s + 3]), cvtpk(p1[8 * s + 4], p1[8 * s + 5]), cvtpk(p1[8 * s + 6], p1[8 * s + 7])};
            }
#pragma unroll
            for (int d = 0; d < 4; ++d)
#pragma unroll
                for (int ks = 0; ks < 4; ++ks) {
                    const bf16x8 vf = *(const LAS bf16x8*)(buf + v_off(32 * d + r32, 2 * ks + hi));
                    o[d] = __builtin_amdgcn_mfma_f32_32x32x16_bf16(vf, __builtin_bit_cast(bf16x8, pw[ks]), o[d], 0, 0, 0);
                }
        }
        if (more) stage_store(sr, lds + ((t + 1) & 1) * STAGE, tid);
        __syncthreads();
    }
    m_out = m; l_out = l + other_half(l);
}
__device__ __forceinline__ int crow(int r, int hi) { return (r & 3) + 8 * (r >> 2) + 4 * hi; }

__device__ __forceinline__ void diff_unit(Frame& F, int b, int h, int qb, float lam) {
    unsigned char* ws = F.ws; int tid_ = F.tid; asm volatile("" : "+v"(tid_)); const int w = F.wave, c = w >> 2, sb = w & 3, lane = tid_ & 63, r32 = lane & 31, hi = lane >> 5;
    const int q0 = qb * 128, q0w = q0 + 32 * sb; const size_t trow0 = (size_t)b * SEQ;
    const bf16* Qw = (const bf16*)(ws + WS_Q) + (trow0 + q0w) * 1024 + h * 128 + c * 64;
    const bf16* Kp = (const bf16*)(ws + WS_K) + trow0 * 1024 + h * 128;
    const bf16* VTp = (const bf16*)(ws + WS_VT) + (size_t)(h * 128) * M + trow0;
    f32x16 o[4]; float m, l;
    attn_core<4, true>(F.lds, Qw, 1024, Kp, 1024, VTp, M, (q0 + 128) / 64, q0w, c * 64, o, m, l, tid_, lane);
    const float inv = 1.f / l;
    LAS float* xch = (LAS float*)F.lds + sb * 4096 + lane;
    if (c == 1) {
        const float f = lam * inv;
#pragma unroll
        for (int d = 0; d < 4; ++d)
#pragma unroll
            for (int r = 0; r < 16; ++r) xch[(d * 16 + r) * 64] = o[d][r] * f;
    }
    __syncthreads();
    if (c == 0) {
        float ss = 0.f;
#pragma unroll
        for (int d = 0; d < 4; ++d)
#pragma unroll
            for (int r = 0; r < 16; ++r) { const float v = o[d][r] * inv - xch[(d * 16 + r) * 64]; o[d][r] = v; ss += v * v; }
        ss += other_half(ss);
        const float rs = rsqrtf(ss * (1.f / 128.f) + EPS) * (1.f - LAMBDA_INIT);
        const size_t t = trow0 + q0w + r32;
        const bf16* Gp = (const bf16*)(ws + WS_G) + t * 1024 + h * 128; bf16* Op = (bf16*)(ws + WS_MIXED) + t * 2048 + h * 128;
        const float* sw = F.in[9];
#pragma unroll
        for (int d = 0; d < 4; ++d)
#pragma unroll
            for (int rg = 0; rg < 4; ++rg) { const int dv = 32 * d + 8 * rg + 4 * hi;
                const v2u g = *(const GAS v2u*)(Gp + dv); const f32x4 wv = *(const GAS f32x4*)(sw + dv);
                v2u ov; ov.x = pk2(o[d][4 * rg] * rs * wv[0] * bflo(g.x), o[d][4 * rg + 1] * rs * wv[1] * bfhi(g.x));
                ov.y = pk2(o[d][4 * rg + 2] * rs * wv[2] * bflo(g.y), o[d][4 * rg + 3] * rs * wv[3] * bfhi(g.y));
                *(GAS v2u*)(Op + dv) = ov; }
    }
    __syncthreads();
}
__device__ __forceinline__ void xattn_unit(Frame& F, int b, int h, int qb) {
    unsigned char* ws = F.ws; int tid_ = F.tid; asm volatile("" : "+v"(tid_)); const int w = F.wave, lane = tid_ & 63, r32 = lane & 31, hi = lane >> 5;
    const int q0w = qb * 256 + 32 * w; const size_t trow0 = (size_t)b * SEQ;
    const bf16* Qw = (const bf16*)(ws + WS_XQ) + (trow0 + q0w) * 512 + h * 128;
    const bf16* Kp = (const bf16*)(ws + WS_MK) + (size_t)(b * MEMLEN) * 512 + h * 128;
    const bf16* VTp = (const bf16*)(ws + WS_MVT) + (size_t)(h * 128) * MM + b * MEMLEN;
    f32x16 o[4]; float m, l;
    attn_core<8, false>(F.lds, Qw, 512, Kp, 512, VTp, MM, MEMLEN / 64, 0, 0, o, m, l, tid_, lane);
    const float inv = 1.f / l; const size_t t = trow0 + q0w + r32;
    const bf16* Gp = (const bf16*)(ws + WS_XG) + t * 512 + h * 128; bf16* Op = (bf16*)(ws + WS_MIXED) + t * 2048 + 1536 + h * 128;
#pragma unroll
    for (int d = 0; d < 4; ++d)
#pragma unroll
        for (int rg = 0; rg < 4; ++rg) { const int dv = 32 * d + 8 * rg + 4 * hi;
            const v2u g = *(const GAS v2u*)(Gp + dv);
            v2u ov; ov.x = pk2(o[d][4 * rg] * inv * bflo(g.x), o[d][4 * rg + 1] * inv * bfhi(g.x));
            ov.y = pk2(o[d][4 * rg + 2] * inv * bflo(g.y), o[d][4 * rg + 3] * inv * bfhi(g.y));
            *(GAS v2u*)(Op + dv) = ov; }
}
}
namespace ssd {
using att::k_off; using att::pi32; using att::crow; using att::other_half;
__device__ __forceinline__ v4u pack8(const float (&s)[8]) { return (v4u){att::cvtpk(s[0], s[1]), att::cvtpk(s[2], s[3]), att::cvtpk(s[4], s[5]), att::cvtpk(s[6], s[7])}; }
__device__ __forceinline__ void unitA(Frame& F, int b, int c, int g) {
    unsigned char* ws = F.ws; int tid_ = F.tid; asm volatile("" : "+v"(tid_)); const int tid = tid_, lane = tid & 63, w = F.wave, r32 = lane & 31, hi = lane >> 5;
    const size_t t0 = (size_t)b * SEQ + c * 128;
    LAS unsigned char* tile = F.lds;
    LAS float* tab = (LAS float*)(F.lds + 98304);
    const float* DTg = (const float*)(ws + WS_DT); float* ACSg = (float*)(ws + WS_ACS);
    { const int hh = tid >> 7, l = tid & 127, h = g * 4 + hh;
      const float dt = DTg[(t0 + l) * 8 + h]; float v = dt * (-__expf(F.in[13][h]));
#pragma unroll
      for (int o = 1; o < 64; o <<= 1) { const float t = __shfl_up(v, o); if (lane >= o) v += t; }
      if ((w & 1) == 0 && lane == 63) tab[1536 + hh] = v;
      __syncthreads();
      if (w & 1) v += tab[1536 + hh];
      tab[hh * 128 + l] = dt; tab[512 + hh * 128 + l] = v; ACSg[(t0 + l) * 8 + h] = v;
      __syncthreads();
      tab[1024 + hh * 128 + l] = dt * __expf(tab[512 + hh * 128 + 127] - v);
      __syncthreads(); }
    { const int ch = tid; const int col = (ch < 256) ? g * 256 + ch : (ch < 384) ? 512 + g * 128 + (ch - 256) : 768 + g * 128 + (ch - 384);
      const float* cw = F.in[10]; const float w0 = cw[col], w1 = cw[1024 + col], w2 = cw[2048 + col], w3 = cw[3072 + col], bias = F.in[11][col];
      const bf16* src = (const bf16*)(ws + WS_XBC) + t0 * 1024 + col;
      float xx[11]; xx[0] = xx[1] = xx[2] = 0.f;
      if (c > 0) { xx[0] = bf2f(src[-3 * 1024]); xx[1] = bf2f(src[-2 * 1024]); xx[2] = bf2f(src[-1 * 1024]); }
      bf16* XTg = (bf16*)(ws + WS_XT) + ((size_t)(b * 16 + c) * 512 + g * 256 + ch) * 128;
      bf16* BCg = (bf16*)(ws + WS_BC) + t0 * 512 + ((ch < 384) ? g * 128 + (ch - 256) : 256 + g * 128 + (ch - 384));
      const int hh = (ch >> 6) & 3;
#pragma unroll 1
      for (int lg = 0; lg < 16; ++lg) {
#pragma unroll
          for (int j = 0; j < 8; ++j) xx[3 + j] = bf2f(src[(size_t)(lg * 8 + j) * 1024]);
          float s[8];
#pragma unroll
          for (int j = 0; j < 8; ++j) { const float y = bias + w0 * xx[j] + w1 * xx[j + 1] + w2 * xx[j + 2] + w3 * xx[j + 3]; s[j] = y / (1.f + __expf(-y)); }
          xx[0] = xx[8]; xx[1] = xx[9]; xx[2] = xx[10];
          if (ch < 256) {
              *(GAS v4u*)(XTg + lg * 8) = pack8(s);
              const f32x4 wa = *(const LAS f32x4*)(tab + 1024 + hh * 128 + lg * 8), wb = *(const LAS f32x4*)(tab + 1024 + hh * 128 + lg * 8 + 4);
              float sw[8] = {s[0] * wa[0], s[1] * wa[1], s[2] * wa[2], s[3] * wa[3], s[4] * wb[0], s[5] * wb[1], s[6] * wb[2], s[7] * wb[3]};
              *(LAS v4u*)(tile + k_off(ch, lg)) = pack8(sw);
          } else {
#pragma unroll
              for (int j = 0; j < 8; ++j) BCg[(size_t)(lg * 8 + j) * 512] = (bf16)f2bf(s[j]);
              if (ch < 384) *(LAS v4u*)(tile + k_off(ch, lg)) = pack8(s);
          }
      } }
    __syncthreads();
    { const int hh = w >> 1, nh = w & 1;
      f32x16 acc[2][2];
#pragma unroll
      for (int i = 0; i < 2; ++i)
#pragma unroll
          for (int j = 0; j < 2; ++j)
#pragma unroll
              for (int r = 0; r < 16; ++r) acc[i][j][r] = 0.f;
#pragma unroll
      for (int ks = 0; ks < 8; ++ks) {
          const bf16x8 a0 = *(const LAS bf16x8*)(tile + k_off(hh * 64 + r32, 2 * ks + hi)), a1 = *(const LAS bf16x8*)(tile + k_off(hh * 64 + 32 + r32, 2 * ks + hi));
          const bf16x8 b0 = *(const LAS bf16x8*)(tile + k_off(256 + nh * 64 + r32, 2 * ks + hi)), b1 = *(const LAS bf16x8*)(tile + k_off(256 + nh * 64 + 32 + r32, 2 * ks + hi));
          acc[0][0] = __builtin_amdgcn_mfma_f32_32x32x16_bf16(a0, b0, acc[0][0], 0, 0, 0); acc[0][1] = __builtin_amdgcn_mfma_f32_32x32x16_bf16(a0, b1, acc[0][1], 0, 0, 0);
          acc[1][0] = __builtin_amdgcn_mfma_f32_32x32x16_bf16(a1, b0, acc[1][0], 0, 0, 0); acc[1][1] = __builtin_amdgcn_mfma_f32_32x32x16_bf16(a1, b1, acc[1][1], 0, 0, 0);
      }
      float* cs = (float*)(ws + WS_CS) + (size_t)((b * 16 + c) * 8 + g * 4 + hh) * 8192;
#pragma unroll
      for (int pb = 0; pb < 2; ++pb)
#pragma unroll
          for (int nb = 0; nb < 2; ++nb)
#pragma unroll
              for (int r = 0; r < 16; ++r) cs[(32 * pb + crow(r, hi)) * 128 + nh * 64 + 32 * nb + r32] = acc[pb][nb][r]; }
    __syncthreads();
}

__device__ __forceinline__ void unitB(Frame& F, int b, int c, int g) {
    unsigned char* ws = F.ws; int tid_ = F.tid; asm volatile("" : "+v"(tid_)); const int tid = tid_, lane = tid & 63, w = F.wave, r32 = lane & 31, hi = lane >> 5;
    const size_t t0 = (size_t)b * SEQ + c * 128;
    LAS unsigned char* ptile = F.lds;
    LAS float* tab = (LAS float*)(F.lds + 65536);
    const float* DTg = (const float*)(ws + WS_DT); const float* ACSg = (const float*)(ws + WS_ACS);
    { const int hh = tid >> 7, l = tid & 127; tab[hh * 128 + l] = DTg[(t0 + l) * 8 + g * 4 + hh]; tab[512 + hh * 128 + l] = ACSg[(t0 + l) * 8 + g * 4 + hh]; }
    { f32x4 acc[4][4]; float wgt[4];
#pragma unroll
      for (int hh = 0; hh < 4; ++hh) { wgt[hh] = 1.f;
#pragma unroll
          for (int j = 0; j < 4; ++j) acc[hh][j] = (f32x4){0.f, 0.f, 0.f, 0.f}; }
      for (int cp = c - 1; cp >= 0; --cp) {
#pragma unroll
          for (int hh = 0; hh < 4; ++hh) {
              if (wgt[hh] > 1e-30f) { const float* src = (const float*)(ws + WS_CS) + (size_t)((b * 16 + cp) * 8 + g * 4 + hh) * 8192;
#pragma unroll
                  for (int j = 0; j < 4; ++j) acc[hh][j] += *(const GAS f32x4*)(src + 4 * (tid + 512 * j)) * wgt[hh]; }
              wgt[hh] *= __expf(ACSg[((size_t)b * SEQ + cp * 128 + 127) * 8 + g * 4 + hh]); }
      }
#pragma unroll
      for (int hh = 0; hh < 4; ++hh)
#pragma unroll
          for (int j = 0; j < 4; ++j) { const int e = 4 * (tid + 512 * j), p = e >> 7, n = e & 127;
              v2u o; o.x = att::cvtpk(acc[hh][j][0], acc[hh][j][1]); o.y = att::cvtpk(acc[hh][j][2], acc[hh][j][3]);
              *(LAS v2u*)(ptile + k_off(hh * 64 + p, n >> 3) + (n & 7) * 2) = o; } }
    __syncthreads();
    const int lb = w & 3, hp = w >> 2, l_loc = 32 * lb + r32;
    const bf16* BCg = (const bf16*)(ws + WS_BC) + t0 * 512;
    bf16x8 cf[8];
#pragma unroll
    for (int ks = 0; ks < 8; ++ks) cf[ks] = *(const GAS bf16x8*)(BCg + (size_t)l_loc * 512 + 256 + g * 128 + 16 * ks + 8 * hi);
    f32x16 acc[2][2];
#pragma unroll
    for (int hh2 = 0; hh2 < 2; ++hh2)
#pragma unroll
        for (int pb = 0; pb < 2; ++pb) {
#pragma unroll
            for (int r = 0; r < 16; ++r) acc[hh2][pb][r] = 0.f;
            if (c > 0) {
#pragma unroll
                for (int ks = 0; ks < 8; ++ks) { const bf16x8 a = *(const LAS bf16x8*)(ptile + k_off((2 * hp + hh2) * 64 + 32 * pb + r32, 2 * ks + hi));
                    acc[hh2][pb] = __builtin_amdgcn_mfma_f32_32x32x16_bf16(a, cf[ks], acc[hh2][pb], 0, 0, 0); }
                const float e = __expf(tab[512 + (2 * hp + hh2) * 128 + l_loc]);
#pragma unroll
                for (int r = 0; r < 16; ++r) acc[hh2][pb][r] *= e;
            }
        }
    const bf16* XTg = (const bf16*)(ws + WS_XT) + ((size_t)(b * 16 + c) * 512 + g * 256) * 128;
    for (int sb = 0; sb <= lb; ++sb) {
        f32x16 gt;
#pragma unroll
        for (int r = 0; r < 16; ++r) gt[r] = 0.f;
        const bf16* brow = BCg + (size_t)(32 * sb + pi32(r32)) * 512 + g * 128 + 8 * hi;
#pragma unroll
        for (int ks = 0; ks < 8; ++ks) { const bf16x8 bfr = *(const GAS bf16x8*)(brow + 16 * ks); gt = __builtin_amdgcn_mfma_f32_32x32x16_bf16(bfr, cf[ks], gt, 0, 0, 0); }
#pragma unroll
        for (int hh2 = 0; hh2 < 2; ++hh2) { const int hh = 2 * hp + hh2; const float acs_l = tab[512 + hh * 128 + l_loc], Dh = F.in[14][g * 4 + hh];
            float sc[16];
#pragma unroll
            for (int q4 = 0; q4 < 4; ++q4) { const int sbase = 32 * sb + 16 * (q4 >> 1) + 8 * hi + 4 * (q4 & 1);
                const f32x4 as = *(const LAS f32x4*)(tab + 512 + hh * 128 + sbase), ds = *(const LAS f32x4*)(tab + hh * 128 + sbase);
#pragma unroll
                for (int e = 0; e < 4; ++e) { const int r = 4 * q4 + e; float v = gt[r] * __builtin_amdgcn_exp2f(fminf(acs_l - as[e], 0.f) * LOG2E) * ds[e];
                    if (sb == lb) { const int sl = 16 * (r >> 3) + 8 * hi + (r & 7); if (sl > r32) v = 0.f; if (sl == r32) v += Dh; }
                    sc[r] = v; } }
            v4u scb[2];
            scb[0] = (v4u){att::cvtpk(sc[0], sc[1]), att::cvtpk(sc[2], sc[3]), att::cvtpk(sc[4], sc[5]), att::cvtpk(sc[6], sc[7])};
            scb[1] = (v4u){att::cvtpk(sc[8], sc[9]), att::cvtpk(sc[10], sc[11]), att::cvtpk(sc[12], sc[13]), att::cvtpk(sc[14], sc[15])};
#pragma unroll
            for (int pb = 0; pb < 2; ++pb)
#pragma unroll
                for (int k2 = 0; k2 < 2; ++k2) { const bf16x8 xf = *(const GAS bf16x8*)(XTg + (size_t)(hh * 64 + 32 * pb + r32) * 128 + 32 * sb + 16 * k2 + 8 * hi);
                    acc[hh2][pb] = __builtin_amdgcn_mfma_f32_32x32x16_bf16(xf, __builtin_bit_cast(bf16x8, scb[k2]), acc[hh2][pb], 0, 0, 0); }
        }
    }
    const size_t t = t0 + l_loc; const bf16* Zg = (const bf16*)(ws + WS_Z) + t * 512 + g * 256;
    float ss = 0.f;
#pragma unroll
    for (int hh2 = 0; hh2 < 2; ++hh2)
#pragma unroll
        for (int pb = 0; pb < 2; ++pb)
#pragma unroll
            for (int rg = 0; rg < 4; ++rg) { const int ch = (2 * hp + hh2) * 64 + 32 * pb + 8 * rg + 4 * hi; const v2u z = *(const GAS v2u*)(Zg + ch);
                const float y0 = acc[hh2][pb][4 * rg] * bflo(z.x), y1 = acc[hh2][pb][4 * rg + 1] * bfhi(z.x), y2 = acc[hh2][pb][4 * rg + 2] * bflo(z.y), y3 = acc[hh2][pb][4 * rg + 3] * bfhi(z.y);
                acc[hh2][pb][4 * rg] = y0; acc[hh2][pb][4 * rg + 1] = y1; acc[hh2][pb][4 * rg + 2] = y2; acc[hh2][pb][4 * rg + 3] = y3;
                ss += (y0 * y0 + y1 * y1) + (y2 * y2 + y3 * y3); }
    ss += other_half(ss);
    if (hi == 0) tab[1024 + hp * 128 + l_loc] = ss;
    __syncthreads();
    const float rs = rsqrtf((tab[1024 + l_loc] + tab[1024 + 128 + l_loc]) * (1.f / 256.f) + EPS);
    bf16* Og = (bf16*)(ws + WS_MIXED) + t * 2048 + 1024 + g * 256; const float* nw = F.in[15] + g * 256;
#pragma unroll
    for (int hh2 = 0; hh2 < 2; ++hh2)
#pragma unroll
        for (int pb = 0; pb < 2; ++pb)
#pragma unroll
            for (int rg = 0; rg < 4; ++rg) { const int ch = (2 * hp + hh2) * 64 + 32 * pb + 8 * rg + 4 * hi; const f32x4 wv = *(const GAS f32x4*)(nw + ch);
                v2u o; o.x = pk2(acc[hh2][pb][4 * rg] * rs * wv[0], acc[hh2][pb][4 * rg + 1] * rs * wv[1]); o.y = pk2(acc[hh2][pb][4 * rg + 2] * rs * wv[2], acc[hh2][pb][4 * rg + 3] * rs * wv[3]);
                *(GAS v2u*)(Og + ch) = o; }
    __syncthreads();
}
}
struct Sched2 {
    int G, c; const char *A, *B;
    __device__ __forceinline__ bool next(int i, pg8::Unit& u) const {
        const long L = (long)i * G + c; if (L >= 256) return false;
        int wgid = (int)L; { const int xcd = wgid % 8, off = wgid / 8; wgid = xcd * 32 + off; }
        u.pm = (wgid / 64) * 8 + ((wgid % 64) % 8); u.pn = (wgid % 64) / 8; u.kind = 0;
        u.a = A + (size_t)u.pm * TSTEP; u.b = B + (size_t)u.pn * TSTEP; return true;
    }
    __device__ __forceinline__ void a_ready(const pg8::Unit&) const {}
    __device__ __forceinline__ void done(const pg8::Unit&) const {}
};
struct EpiF32 {
    static constexpr bool PERM = false, AFTER_DRAIN = false;
    float* O; int ldc;
    __device__ __forceinline__ void operator()(const pg8::f32x4 (&acc)[2][2][4][2], const pg8::Unit& u, int wr, int wc, int fr, int fq) const {
        const int row0 = u.pm * 256 + wr * 64 + fr, col0 = u.pn * 256 + wc * 32 + 4 * fq;
#pragma unroll
        for (int ai = 0; ai < 2; ++ai)
#pragma unroll
            for (int m = 0; m < 4; ++m) { float* rowp = O + (size_t)(row0 + ai * 128 + m * 16) * ldc + col0;
#pragma unroll
                for (int bj = 0; bj < 2; ++bj)
#pragma unroll
                    for (int n = 0; n < 2; ++n) *(pg8::f32x4*)(rowp + bj * 128 + n * 16) = acc[ai][bj][m][n]; }
    }
};
__device__ __forceinline__ void p5_final(Frame& F) {
    const int gw = F.vcu * NWAVES + F.wave, NGW = F.G * NWAVES;
    const float* o2 = (const float*)(F.ws + WS_O2); const GAS f32x4* wr = (const GAS f32x4*)F.in[19] + F.lane;
    for (int mrow = gw; mrow < M; mrow += NGW) {
        const GAS f32x4* orow = (const GAS f32x4*)(o2 + (size_t)mrow * DM) + F.lane; const GAS f32x4* xr = (const GAS f32x4*)(F.in[0] + (size_t)mrow * DM) + F.lane;
        GAS f32x4* outr = (GAS f32x4*)(F.out + (size_t)mrow * DM) + F.lane;
        f32x4 v[8]; float s = 0.f;
#pragma unroll
        for (int j = 0; j < 8; ++j) { v[j] = orow[64 * j]; s += (v[j].x * v[j].x + v[j].y * v[j].y) + (v[j].z * v[j].z + v[j].w * v[j].w); }
        const float rstd = rsqrtf(wave_sum(s) * (1.f / DM) + EPS);
#pragma unroll
        for (int j = 0; j < 8; ++j) outr[64 * j] = xr[64 * j] + v[j] * rstd * wr[64 * j];
    }
}
constexpr int LDS_BYTES = 147456;
struct Args { const float* in[20]; float* out; unsigned char* ws; int ph_lo, ph_hi; };
__global__ void __launch_bounds__(NTHR, 2) mega(Args args) {
    extern __shared__ __attribute__((aligned(16))) unsigned char lds[];
    Frame F;
    F.lds = (LAS unsigned char*)lds;
    F.tid = threadIdx.x; F.lane = F.tid & 63; F.wave = __builtin_amdgcn_readfirstlane(F.tid >> 6);
    F.G = gridDim.x; { const int bx = blockIdx.x; F.vcu = (F.G % 8 == 0) ? (bx % 8) * (F.G / 8) + bx / 8 : bx; }
#pragma unroll
    for (int i = 0; i < 20; ++i) F.in[i] = args.in[i];
    F.out = args.out; F.ws = args.ws;
    const int lo = args.ph_lo, hi = args.ph_hi;
#define IN(k) (lo <= (k) && (k) < hi)
    volatile LAS unsigned* MISC = (volatile LAS unsigned*)(F.lds + LDS_BYTES - 64);
    if (F.tid < 16) MISC[F.tid] = 0u;
    __syncthreads();
    const XcdBarrier bar = xcd_barrier_post((unsigned*)(F.ws + WS_CTL) + 4096, MISC + 8);
#define SEAM(k) do { if (IN(k) && IN((k) + 1)) xcd_barrier(bar); } while (0)
    if (IN(0)) { p0_prologue(F); }
    SEAM(0);
    if (IN(1)) {
        pg8::Gemm g{DM}; Sched1 S{F.G, (int)blockIdx.x, (const char*)(F.ws + WS_HN), (const char*)(F.ws + WS_W1T), (const char*)(F.ws + WS_MEMN), (const char*)(F.ws + WS_WKVT)};
        EpiP1 E{F.ws};
        pg8::gemm_phase<EpiP1, Sched1, true, true>(F.lds, g, S, E);
    }
    SEAM(1);
    if (IN(2)) {
        for (int u = F.vcu; u < 256; u += F.G) { if (u < 128) att::xattn_unit(F, u >> 5, (u >> 3) & 3, u & 7); else { const int v = u - 128; ssd::unitA(F, v >> 5, (v >> 1) & 15, v & 1); } }
    }
    SEAM(2);
    if (IN(3)) {
        const float d1 = wave_sum(F.lane < 64 ? F.in[5][F.lane] * F.in[6][F.lane] : 0.f), d2 = wave_sum(F.in[7][F.lane] * F.in[8][F.lane]);
        const float lam = __expf(d1) - __expf(d2) + LAMBDA_INIT;
        for (int v = F.vcu; v < 256; v += F.G) { const int bh = v >> 3, s = v & 7;
            att::diff_unit(F, bh >> 3, bh & 7, s, lam); att::diff_unit(F, bh >> 3, bh & 7, 15 - s, lam); }
        for (int v = F.vcu; v < 128; v += F.G) ssd::unitB(F, v >> 5, (v >> 1) & 15, v & 1);
    }
    SEAM(3);
    if (IN(4)) {
        pg8::Gemm g{DM}; Sched2 S{F.G, (int)blockIdx.x, (const char*)(F.ws + WS_MIXED), (const char*)(F.ws + WS_WOT)};
        EpiF32 E{(float*)(F.ws + WS_O2), DM};
        pg8::gemm_phase<EpiF32, Sched2, false, true>(F.lds, g, S, E);
    }
    SEAM(4);
    if (IN(5)) p5_final(F);
#undef SEAM
#undef IN
}
extern "C" void kernel_launch(void* const* d_in, const int* in_sizes, int n_in, void* d_out, int out_size, void* d_ws, size_t ws_size, hipStream_t stream) {
    static int grid = 0;
    if (grid == 0) {
        if (n_in != 20 || in_sizes[0] != M * DM || out_size != M * DM || ws_size < WS_END) { fprintf(stderr, "kernel_launch: unexpected shapes (n_in %d, ws %zu)\n", n_in, ws_size); grid = -1; return; }
        int dev = 0, cus = 0, per_cu = 0;
        (void)hipGetDevice(&dev); (void)hipDeviceGetAttribute(&cus, hipDeviceAttributeMultiprocessorCount, dev);
        (void)hipFuncSetAttribute((const void*)mega, hipFuncAttributeMaxDynamicSharedMemorySize, LDS_BYTES);
        (void)hipOccupancyMaxActiveBlocksPerMultiprocessor(&per_cu, (const void*)mega, NTHR, LDS_BYTES);
        if (per_cu < 1) { fprintf(stderr, "kernel_launch: occupancy query says %d\n", per_cu); per_cu = 1; }
        (void)hipGetLastError();
        grid = cus * (per_cu < 1 ? 1 : 1);
    }
    if (grid < 0) return;
    unsigned char* ws = (unsigned char*)d_ws;
    Args a{};
    for (int i = 0; i < 20; ++i) a.in[i] = (const float*)d_in[i];
    a.out = (float*)d_out; a.ws = ws;
    if (hipMemsetAsync(ws + WS_CTL, 0, 65536, stream) != hipSuccess) { fprintf(stderr, "kernel_launch: memset failed\n"); return; }
    a.ph_lo = 0; a.ph_hi = 6;
    void* kargs[] = {&a};
    hipError_t e = hipLaunchCooperativeKernel((const void*)mega, dim3(grid), dim3(NTHR), kargs, LDS_BYTES, stream);
    if (e != hipSuccess) fprintf(stderr, "kernel_launch: cooperative launch failed: %s (grid %d)\n", hipGetErrorString(e), grid);
}
```

```cpp
#include <hip/hip_runtime.h>
#include <hip/hip_cooperative_groups.h>
#include <cstdio>
#include <cstdint>
#include <cmath>
namespace pg8 {
#define PG8_LAS __attribute__((address_space(3)))
typedef unsigned short bf16_t;
typedef short bf16x8 __attribute__((ext_vector_type(8)));
typedef float f32x4 __attribute__((ext_vector_type(4)));
typedef unsigned u32x4 __attribute__((ext_vector_type(4)));
constexpr int BM = 256, BK = 64, HALF = 128, HTB = HALF * BK * 2  , STAGE_BYTES = 8 * HTB, NXCD = 8, WGM = 8;

__host__ __device__ __forceinline__ int lds_byte(int r, int c) { const int st = (r >> 4) * 2 + (c >> 5), rr = r & 15, cc = c & 31, ob = rr * 64 + cc * 2; return st * 1024 + (ob ^ (((ob >> 9) & 1) << 5)); }
__host__ __device__ __forceinline__ void stage_rc(int b, int& R, int& C) { const int st = b / 1024, sb = b % 1024, swz = sb ^ (((sb >> 9) & 1) << 5); R = (st >> 1) * 16 + swz / 64; C = (st & 1) * 32 + (swz % 64) / 2; }
__host__ __device__ __forceinline__ int perm32(int rho) { const int n = rho >> 4, i = rho & 15; return 8 * (i >> 2) + 4 * n + (i & 3); }

struct Unit { const char* a; const char* b; int pm, pn, kind; };
struct Gemm { int K; };

__device__ __forceinline__ unsigned cvt_pk_bf16(float lo, float hi) { unsigned r; asm volatile("v_cvt_pk_bf16_f32 %0, %1, %2" : "=v"(r) : "v"(lo), "v"(hi)); return r; }
template <class Epi, class Sched, bool ALIGN_EPI = false, bool SP2 = false>
__device__ __forceinline__ void gemm_phase(PG8_LAS unsigned char* lds, const Gemm g, const Sched& S, const Epi& E) {
    int tid_ = threadIdx.x; asm volatile("" : "+v"(tid_));
    const int tid = tid_, wid = __builtin_amdgcn_readfirstlane(tid >> 6), lane = tid & 63, wr = wid >> 2, wc = wid & 3, fr = lane & 15, fq = lane >> 4;
    const int K = g.K, nt = K / BK;
    unsigned voffA[2], voffB[2];
#pragma unroll
    for (int i = 0; i < 2; ++i) { int R, C; stage_rc(tid * 16 + i * 8192, R, C); const int Rb = Epi::PERM ? ((R & ~31) + perm32(R & 31)) : R;
        voffA[i] = (unsigned)(R * K + C) * 2u; voffB[i] = (unsigned)(Rb * K + C) * 2u; }
    const size_t kstep = (size_t)(BK * 2);
    const size_t hstep = (size_t)HALF * K * 2;
        const unsigned ldsw = (unsigned)wid * 1024u;
    const int aoff = lds_byte(wr * 64 + fr, fq * 8), boff = lds_byte(wc * 32 + fr, fq * 8);
#define PG8_SA(b, h) (((b) * 2 + (h)) * HTB)
#define PG8_SB(b, h) ((4 + (b) * 2 + (h)) * HTB)
#define PG8_STAGE(bufoff, gbase, voff) do { _Pragma("unroll") for (int _i = 0; _i < 2; ++_i) \
        __builtin_amdgcn_global_load_lds((const unsigned*)((const char*)(gbase) + (voff)[_i]), (PG8_LAS unsigned*)(lds + (bufoff) + ldsw + _i * 8192), 16, 0, 0); } while (0)
#define PG8_LDA(dst, b, h) do { _Pragma("unroll") for (int m = 0; m < 4; ++m) _Pragma("unroll") for (int k = 0; k < 2; ++k) dst[m][k] = *(const PG8_LAS bf16x8*)(lds + PG8_SA(b, h) + aoff + m * 2048 + k * 1024); } while (0)
#define PG8_LDB(dst, b, h) do { _Pragma("unroll") for (int n = 0; n < 2; ++n) _Pragma("unroll") for (int k = 0; k < 2; ++k) dst[n][k] = *(const PG8_LAS bf16x8*)(lds + PG8_SB(b, h) + boff + n * 2048 + k * 1024); } while (0)
#define PG8_MMA(ai, bj, At, Bt) do { __builtin_amdgcn_s_setprio(1); _Pragma("unroll") for (int m = 0; m < 4; ++m) _Pragma("unroll") for (int n = 0; n < 2; ++n) _Pragma("unroll") for (int k = 0; k < 2; ++k) \
        acc[ai][bj][m][n] = __builtin_amdgcn_mfma_f32_16x16x32_bf16(Bt[n][k], At[m][k], acc[ai][bj][m][n], 0, 0, 0); __builtin_amdgcn_s_setprio(0); } while (0)
#define PG8_WAIT_V(n) asm volatile("s_waitcnt vmcnt(" #n ")" ::: "memory")
#define PG8_WAIT_L(n) asm volatile("s_waitcnt lgkmcnt(" #n ")" ::: "memory")
#define PG8_BAR __builtin_amdgcn_s_barrier()
#define PG8_SCHED __builtin_amdgcn_sched_barrier(0)
    Unit cur, nxt; int ui = 0;
    if (!S.next(0, cur)) return;
    f32x4 acc[2][2][4][2];
#pragma unroll
    for (int a = 0; a < 2; ++a)
#pragma unroll
        for (int b = 0; b < 2; ++b)
#pragma unroll
            for (int m = 0; m < 4; ++m)
#pragma unroll
                for (int n = 0; n < 2; ++n) acc[a][b][m][n] = (f32x4){0.f, 0.f, 0.f, 0.f};
    bf16x8 At[4][2], B0[2][2], B1[2][2];
    const char* cA = cur.a; const char* cB = cur.b;
    S.a_ready(cur);
    if constexpr (SP2) {
        PG8_STAGE(PG8_SB(0, 0), cB, voffB); PG8_STAGE(PG8_SB(0, 1), cB + hstep, voffB); PG8_STAGE(PG8_SA(0, 0), cA, voffA); PG8_STAGE(PG8_SA(0, 1), cA + hstep, voffA);
        if (wr == 1) PG8_BAR;
        PG8_WAIT_V(2); PG8_BAR;
        PG8_STAGE(PG8_SB(1, 0), cB + kstep, voffB); PG8_STAGE(PG8_SA(1, 0), cA + kstep, voffA); PG8_STAGE(PG8_SB(1, 1), cB + hstep + kstep, voffB);
        PG8_WAIT_V(6); PG8_BAR;
    } else {
        PG8_STAGE(PG8_SB(0, 0), cB, voffB); PG8_STAGE(PG8_SA(0, 0), cA, voffA); PG8_STAGE(PG8_SB(0, 1), cB + hstep, voffB); PG8_STAGE(PG8_SA(0, 1), cA + hstep, voffA);
        if (wr == 1) PG8_BAR;
        PG8_WAIT_V(4); PG8_BAR;
        PG8_STAGE(PG8_SB(1, 0), cB + kstep, voffB); PG8_STAGE(PG8_SA(1, 0), cA + kstep, voffA); PG8_STAGE(PG8_SB(1, 1), cB + hstep + kstep, voffB);
        PG8_WAIT_V(6); PG8_BAR;
    }
    for (;;) {
        const bool has_next = S.next(ui + 1, nxt);
        const char* nA = has_next ? nxt.a : cA; const char* nB = has_next ? nxt.b : cB;
        for (int t = 0; t < nt; t += 2) {
            const bool last = (t == nt - 2);
            const char* a1 = cA + (size_t)(t + 1) * kstep;
            const char* a2 = last ? nA : cA + (size_t)(t + 2) * kstep; const char* b2 = last ? nB : cB + (size_t)(t + 2) * kstep;
            const char* a3 = a2 + kstep; const char* b3 = b2 + kstep;
            if (last && has_next) S.a_ready(nxt);
            if constexpr (SP2) {
            PG8_LDB(B0, 0, 0); PG8_LDB(B1, 0, 1); PG8_SCHED; PG8_LDA(At, 0, 0); PG8_STAGE(PG8_SA(1, 1), a1 + hstep, voffA);
            PG8_WAIT_V(8); PG8_WAIT_L(0); PG8_BAR; PG8_MMA(0, 0, At, B0); PG8_MMA(0, 1, At, B1); PG8_BAR; PG8_SCHED;
            PG8_LDA(At, 0, 1); PG8_STAGE(PG8_SB(0, 0), b2, voffB); PG8_STAGE(PG8_SB(0, 1), b2 + hstep, voffB); PG8_STAGE(PG8_SA(0, 0), a2, voffA);
            PG8_WAIT_V(8); PG8_WAIT_L(0); PG8_BAR; PG8_MMA(1, 0, At, B0); PG8_MMA(1, 1, At, B1); PG8_BAR; PG8_SCHED;
            PG8_LDB(B0, 1, 0); PG8_LDB(B1, 1, 1); PG8_SCHED; PG8_LDA(At, 1, 0); PG8_STAGE(PG8_SA(0, 1), a2 + hstep, voffA);
            PG8_WAIT_V(8); PG8_WAIT_L(0); PG8_BAR; PG8_MMA(0, 0, At, B0); PG8_MMA(0, 1, At, B1); PG8_BAR; PG8_SCHED;
            PG8_LDA(At, 1, 1); PG8_STAGE(PG8_SB(1, 0), b3, voffB); PG8_STAGE(PG8_SB(1, 1), b3 + hstep, voffB); PG8_STAGE(PG8_SA(1, 0), a3, voffA);
            PG8_WAIT_V(8); PG8_WAIT_L(0); PG8_BAR; PG8_MMA(1, 0, At, B0); PG8_MMA(1, 1, At, B1); PG8_BAR; PG8_SCHED;
            } else {
            PG8_LDB(B0, 0, 0); PG8_SCHED; PG8_LDA(At, 0, 0); PG8_STAGE(PG8_SA(1, 1), a1 + hstep, voffA);
            PG8_WAIT_L(8); PG8_BAR; PG8_WAIT_L(0); PG8_MMA(0, 0, At, B0); PG8_BAR; PG8_SCHED;
            PG8_LDB(B1, 0, 1); PG8_STAGE(PG8_SB(0, 0), b2, voffB);
            PG8_BAR; PG8_WAIT_L(0); PG8_MMA(0, 1, At, B1); PG8_BAR;
            PG8_LDA(At, 0, 1); PG8_STAGE(PG8_SA(0, 0), a2, voffA);
            PG8_BAR; PG8_WAIT_L(0); PG8_MMA(1, 0, At, B0); PG8_BAR; PG8_SCHED;
            PG8_STAGE(PG8_SB(0, 1), b2 + hstep, voffB);
            PG8_WAIT_V(6); PG8_BAR; PG8_MMA(1, 1, At, B1); PG8_BAR;
            PG8_LDB(B0, 1, 0); PG8_SCHED; PG8_LDA(At, 1, 0); PG8_STAGE(PG8_SA(0, 1), a2 + hstep, voffA);
            PG8_WAIT_L(8); PG8_BAR; PG8_WAIT_L(0); PG8_MMA(0, 0, At, B0); PG8_BAR; PG8_SCHED;
            PG8_LDB(B1, 1, 1); PG8_STAGE(PG8_SB(1, 0), b3, voffB);
            PG8_BAR; PG8_WAIT_L(0); PG8_MMA(0, 1, At, B1); PG8_BAR;
            PG8_LDA(At, 1, 1); PG8_STAGE(PG8_SA(1, 0), a3, voffA);
            PG8_BAR; PG8_WAIT_L(0); PG8_MMA(1, 0, At, B0); PG8_BAR; PG8_SCHED;
            PG8_STAGE(PG8_SB(1, 1), b3 + hstep, voffB);
            PG8_WAIT_V(6); PG8_BAR; PG8_MMA(1, 1, At, B1); PG8_BAR;
            }
        }
        if constexpr (ALIGN_EPI) { if (wr == 0) PG8_BAR; }
        if constexpr (!Epi::AFTER_DRAIN) { E(acc, cur, wr, wc, fr, fq); S.done(cur); }
        if (!has_next) break;
#pragma unroll
        for (int a = 0; a < 2; ++a)
#pragma unroll
            for (int b = 0; b < 2; ++b)
#pragma unroll
                for (int m = 0; m < 4; ++m)
#pragma unroll
                    for (int n = 0; n < 2; ++n) acc[a][b][m][n] = (f32x4){0.f, 0.f, 0.f, 0.f};
        cur = nxt; cA = nA; cB = nB; ++ui;
        if constexpr (ALIGN_EPI) { if (wr == 1) PG8_BAR; }
    }
    PG8_WAIT_V(0);
    if constexpr (!ALIGN_EPI) { if (wr == 0) PG8_BAR; }
    PG8_BAR;
    if constexpr (Epi::AFTER_DRAIN) { E.fused(acc, cur, wr, wc, fr, fq, lds, wid, lane); S.done(cur); }
#undef PG8_SA
#undef PG8_SB
#undef PG8_STAGE
#undef PG8_LDA
#undef PG8_LDB
#undef PG8_MMA
#undef PG8_WAIT_V
#undef PG8_WAIT_L
#undef PG8_BAR
#undef PG8_SCHED
}
}
constexpr int NWAVES = 8, NTHR = NWAVES * 64;
constexpr int BATCH = 4, SEQ = 2048, DM = 2048, M = BATCH * SEQ, DIN = 6664, MEMLEN = 256, MM = BATCH * MEMLEN;
constexpr int NW1 = 6656;
constexpr float EPS = 1e-6f, LOG2E = 1.4426950408889634f;
constexpr float C2Q = 0.125f * LOG2E;
constexpr float C2X = 0.08838834764831845f * LOG2E;
constexpr float LAMBDA_INIT = 0.2f;
constexpr size_t MiB = 1u << 20;
constexpr size_t WS_CTL = 0, CTL_ZERO_BYTES = 1 * MiB;
constexpr size_t WS_W1T = 1 * MiB, WS_WOT = 27 * MiB, WS_WKVT = 35 * MiB, WS_HN = 39 * MiB, WS_MEMN = 71 * MiB;
constexpr size_t WS_DT = 75 * MiB, WS_ACS = 75 * MiB + 256 * 1024, WS_ROPE = 76 * MiB;
constexpr size_t WS_Q = 78 * MiB, WS_K = 94 * MiB, WS_VT = 110 * MiB, WS_G = 126 * MiB, WS_Z = 142 * MiB, WS_XBC = 150 * MiB, WS_XQ = 166 * MiB, WS_XG = 174 * MiB;
constexpr size_t WS_MK = 182 * MiB, WS_MVT = 183 * MiB, WS_XT = 184 * MiB, WS_BC = 192 * MiB, WS_CS = 200 * MiB, WS_MIXED = 216 * MiB, WS_PREV = 248 * MiB, WS_END = 256 * MiB;
constexpr size_t WS_SLOTS = 75 * MiB + 512 * 1024;
constexpr size_t WS_O2 = 39 * MiB;
constexpr size_t TSTEP = (size_t)256 * DM * 2;

#define GAS __attribute__((address_space(1)))
#define LAS __attribute__((address_space(3)))
typedef unsigned short bf16;
typedef unsigned v4u __attribute__((ext_vector_type(4)));
typedef unsigned v2u __attribute__((ext_vector_type(2)));
typedef float f32x4 __attribute__((ext_vector_type(4)));
typedef float f32x16 __attribute__((ext_vector_type(16)));
typedef short bf16x8 __attribute__((ext_vector_type(8)));
#define LDS_WAIT() asm volatile("s_waitcnt lgkmcnt(0)" ::: "memory")
#define VM_WAIT() asm volatile("s_waitcnt vmcnt(0)" ::: "memory")
__device__ __forceinline__ unsigned f2bf(float f) { unsigned u = __builtin_bit_cast(unsigned, f); return (u + 0x7fffu + ((u >> 16) & 1u)) >> 16; }
__device__ __forceinline__ unsigned pk2(float lo, float hi) { return f2bf(lo) | (f2bf(hi) << 16); }
__device__ __forceinline__ float bf2f(bf16 v) { return __builtin_bit_cast(float, (unsigned)v << 16); }
__device__ __forceinline__ float bflo(unsigned w) { return __builtin_bit_cast(float, w << 16); }
__device__ __forceinline__ float bfhi(unsigned w) { return __builtin_bit_cast(float, w & 0xffff0000u); }
__device__ __forceinline__ float silu_f(float v) { return v / (1.f + __expf(-v)); }
__device__ __forceinline__ float wave_sum(float v) {
#pragma unroll
    for (int o = 1; o < 64; o <<= 1) v += __shfl_xor(v, o);
    return v;
}

struct Frame {
    LAS unsigned char* lds;
    int tid, lane, wave, vcu, G;
    const float* in[20]; float* out; unsigned char* ws;
    unsigned long long tacc[8];
};

__device__ __forceinline__ int w1_src_col(int r) {
    if (r < 2048) { const int p = r & 63, i = p >> 2, j = p & 3; return (r & ~63) + 2 * i + (j & 1) + 32 * (j >> 1); }
    if (r < 3072) return 3072 + (r - 2048);
    if (r < 3584) return 4096 + (r - 3072);
    if (r < 4608) return 4608 + (r - 3584);
    if (r < 5120) return 5640 + (r - 4608);
    if (r < 5632) return 6152 + (r - 5120);
    return 2048 + (r - 5632);
}
template <bool MAP>
__device__ __forceinline__ void p0_transpose_item(const float* W, int K, int N, bf16* WT, LAS float* scr, int item, int lane) {
    const int nkb = K / 64, nb = item / nkb, kb = item % nkb, k0 = 64 * kb, n0 = 32 * nb;
    const int sc = MAP ? w1_src_col(n0 + (lane & 31)) : n0 + (lane & 31);
    float tv[32];
#pragma unroll
    for (int i = 0; i < 32; ++i) tv[i] = W[(size_t)(k0 + 2 * i + (lane >> 5)) * N + sc];
#pragma unroll
    for (int i = 0; i < 32; ++i) scr[(2 * i + (lane >> 5)) * 33 + (lane & 31)] = tv[i];
    LDS_WAIT(); asm volatile("" ::: "memory");
    const int c = lane & 7;
#pragma unroll
    for (int j = 0; j < 4; ++j) { const int n = (lane >> 3) + 8 * j; const LAS float* s = scr + (8 * c) * 33 + n;
        v4u o; o.x = pk2(s[0 * 33], s[1 * 33]); o.y = pk2(s[2 * 33], s[3 * 33]); o.z = pk2(s[4 * 33], s[5 * 33]); o.w = pk2(s[6 * 33], s[7 * 33]);
        *(GAS v4u*)(WT + (size_t)(n0 + n) * K + k0 + 8 * c) = o; }
    LDS_WAIT(); asm volatile("" ::: "memory");
}
template <bool WITH_DT>
__device__ __forceinline__ void p0_norm_row(const float* xrow, const float* w, bf16* orow, const LAS float* wdt, const float* dtb, float* dtrow, int lane) {
    const GAS f32x4* xr = (const GAS f32x4*)xrow + lane; const GAS f32x4* wr = (const GAS f32x4*)w + lane;
    f32x4 v[8]; float s = 0.f;
#pragma unroll
    for (int j = 0; j < 8; ++j) { v[j] = xr[64 * j]; s += (v[j].x * v[j].x + v[j].y * v[j].y) + (v[j].z * v[j].z + v[j].w * v[j].w); }
    const float rstd = rsqrtf(wave_sum(s) * (1.f / DM) + EPS);
    GAS v2u* o8 = (GAS v2u*)orow + lane;
#pragma unroll
    for (int j = 0; j < 8; ++j) { v[j] = v[j] * rstd * wr[64 * j]; v2u o; o.x = pk2(v[j].x, v[j].y); o.y = pk2(v[j].z, v[j].w); o8[64 * j] = o; }
    if (WITH_DT) {
        float d[8];
#pragma unroll
        for (int h = 0; h < 8; ++h) { float a = 0.f;
#pragma unroll
            for (int j = 0; j < 8; ++j) { const f32x4 ww = *(const LAS f32x4*)(wdt + h * DM + 4 * (lane + 64 * j)); a += (v[j].x * ww.x + v[j].y * ww.y) + (v[j].z * ww.z + v[j].w * ww.w); }
            d[h] = wave_sum(a); }
        float mine = 0.f;
#pragma unroll
        for (int h = 0; h < 8; ++h) mine = (lane == h) ? d[h] : mine;
        if (lane < 8) { const float r = mine + dtb[lane]; dtrow[lane] = (r > 20.f) ? r : log1pf(__expf(r)); }
    }
}
__device__ __forceinline__ void p0_prologue(Frame& F) {
    LAS float* scr = (LAS float*)(F.lds + F.wave * 16384);
    const int gw = F.vcu * NWAVES + F.wave, NGW = F.G * NWAVES;
    unsigned char* ws = F.ws;
    constexpr int I_1 = (NW1 / 32) * (DM / 64), I_O = (DM / 32) * (DM / 64), I_KV = (1024 / 32) * (DM / 64);
    for (int it = gw; it < I_1 + I_O + I_KV; it += NGW) {
        int r = it;
        if (r < I_1) { p0_transpose_item<true>(F.in[4], DM, DIN, (bf16*)(ws + WS_W1T), scr, r, F.lane); continue; } r -= I_1;
        if (r < I_O) { p0_transpose_item<false>(F.in[18], DM, DM, (bf16*)(ws + WS_WOT), scr, r, F.lane); continue; } r -= I_O;
        p0_transpose_item<false>(F.in[17], DM, 1024, (bf16*)(ws + WS_WKVT), scr, r, F.lane);
    }
    { const int* pos = (const int*)F.in[2]; float* rope = (float*)(ws + WS_ROPE);
      for (int idx = (F.vcu * NTHR + F.tid); idx < M * 32; idx += F.G * NTHR) { const int t = idx >> 5, f = idx & 31;
          const float inv = 1.0f / powf(10000.f, (float)(2 * f) / 64.f); const float ang = (float)pos[t] * inv;
          rope[2 * idx] = cosf(ang); rope[2 * idx + 1] = sinf(ang); } }
    __syncthreads();
    LAS float* wdt = (LAS float*)F.lds;
    for (int idx = F.tid; idx < DM * 8; idx += NTHR) { const int k = idx >> 3, h = idx & 7; wdt[h * DM + k] = F.in[4][(size_t)k * DIN + 5632 + h]; }
    __syncthreads();
    for (int m = gw; m < M + MM; m += NGW) {
        if (m < M) p0_norm_row<true>(F.in[0] + (size_t)m * DM, F.in[3], (bf16*)(ws + WS_HN) + (size_t)m * DM, wdt, F.in[12], (float*)(ws + WS_DT) + (size_t)m * 8, F.lane);
        else p0_norm_row<false>(F.in[1] + (size_t)(m - M) * DM, F.in[16], (bf16*)(ws + WS_MEMN) + (size_t)(m - M) * DM, wdt, nullptr, nullptr, F.lane);
    }
    __syncthreads();
}

struct Sched1 {
    int G, c; const char *HN, *W1T, *MEMN, *WKVT;
    __device__ __forceinline__ bool next(int i, pg8::Unit& u) const {
        const long L = (long)i * G + c; if (L >= 848) return false;
        if (L < 704) {
            int wgid = (int)L; { const int xcd = wgid % 8, off = wgid / 8; wgid = xcd * 88 + off; }
            const int pm = (wgid / 176) * 8 + ((wgid % 176) % 8), pn = (wgid % 176) / 8;
            u.kind = 0; u.pm = pm; u.pn = pn; u.a = HN + (size_t)pm * TSTEP; u.b = W1T + (size_t)pn * TSTEP;
        } else if (L < 832) { const int r = (int)L - 704;
            u.kind = 1; u.pm = r & 3; u.pn = r >> 2; u.a = W1T + (size_t)(22 + u.pm) * TSTEP; u.b = HN + (size_t)u.pn * TSTEP;
        } else if (L < 840) { const int r = (int)L - 832;
            u.kind = 2; u.pm = r & 3; u.pn = r >> 2; u.a = MEMN + (size_t)u.pm * TSTEP; u.b = WKVT + (size_t)u.pn * TSTEP;
        } else { const int r = (int)L - 840;
            u.kind = 3; u.pm = r & 1; u.pn = r >> 1; u.a = WKVT + (size_t)(2 + u.pm) * TSTEP; u.b = MEMN + (size_t)u.pn * TSTEP; }
        return true;
    }
    __device__ __forceinline__ void a_ready(const pg8::Unit&) const {}
    __device__ __forceinline__ void done(const pg8::Unit&) const {}
};
struct EpiP1 {
    static constexpr bool PERM = true, AFTER_DRAIN = false;
    unsigned char* ws;
    __device__ __forceinline__ void operator()(const pg8::f32x4 (&acc)[2][2][4][2], const pg8::Unit& u, int wr, int wc, int fr, int fq) const {
        bf16* base; int ldc, op = 0, colt; float sc = 1.f;
        if (u.kind == 0) { const int pn = u.pn;
            if (pn < 4) { base = (bf16*)(ws + WS_Q); ldc = 1024; colt = pn * 256; op = 2; sc = C2Q; }
            else if (pn < 8) { base = (bf16*)(ws + WS_K); ldc = 1024; colt = (pn - 4) * 256; op = 2; }
            else if (pn < 12) { base = (bf16*)(ws + WS_G); ldc = 1024; colt = (pn - 8) * 256; op = 1; }
            else if (pn < 14) { base = (bf16*)(ws + WS_Z); ldc = 512; colt = (pn - 12) * 256; op = 1; }
            else if (pn < 18) { base = (bf16*)(ws + WS_XBC); ldc = 1024; colt = (pn - 14) * 256; }
            else if (pn < 20) { base = (bf16*)(ws + WS_XQ); ldc = 512; colt = (pn - 18) * 256; sc = C2X; }
            else { base = (bf16*)(ws + WS_XG); ldc = 512; colt = (pn - 20) * 256; op = 1; }
        } else if (u.kind == 1) { base = (bf16*)(ws + WS_VT); ldc = M; colt = u.pn * 256; }
        else if (u.kind == 2) { base = (bf16*)(ws + WS_MK); ldc = 512; colt = u.pn * 256; }
        else { base = (bf16*)(ws + WS_MVT); ldc = MM; colt = u.pn * 256; }
        const int row0 = u.pm * 256 + wr * 64 + fr, col0 = colt + wc * 32 + 8 * fq;
        const float* rope = (const float*)(ws + WS_ROPE); const int i0 = 8 * (wc & 1) + 2 * fq;
#pragma unroll
        for (int ai = 0; ai < 2; ++ai)
#pragma unroll
            for (int m = 0; m < 4; ++m) { const int row = row0 + ai * 128 + m * 16; bf16* rowp = base + (size_t)row * ldc + col0;
                f32x4 cs0 = {1.f, 0.f, 1.f, 0.f}, cs1 = {1.f, 0.f, 1.f, 0.f};
                if (op == 2) { cs0 = *(const f32x4*)(rope + ((size_t)row * 32 + 2 * i0) * 2); cs1 = *(const f32x4*)(rope + ((size_t)row * 32 + 2 * i0 + 2) * 2); }
#pragma unroll
                for (int bj = 0; bj < 2; ++bj) { f32x4 v0 = acc[ai][bj][m][0], v1 = acc[ai][bj][m][1];
                    if (op == 1) { v0 = (f32x4){silu_f(v0[0]), silu_f(v0[1]), silu_f(v0[2]), silu_f(v0[3])}; v1 = (f32x4){silu_f(v1[0]), silu_f(v1[1]), silu_f(v1[2]), silu_f(v1[3])}; }
                    if (op == 2) {
                        v0 = (f32x4){v0[0] * cs0[0] - v0[2] * cs0[1], v0[1] * cs0[2] - v0[3] * cs0[3], v0[2] * cs0[0] + v0[0] * cs0[1], v0[3] * cs0[2] + v0[1] * cs0[3]};
                        v1 = (f32x4){v1[0] * cs1[0] - v1[2] * cs1[1], v1[1] * cs1[2] - v1[3] * cs1[3], v1[2] * cs1[0] + v1[0] * cs1[1], v1[3] * cs1[2] + v1[1] * cs1[3]}; }
                    v0 = v0 * sc; v1 = v1 * sc;
                    v4u w; w.x = pg8::cvt_pk_bf16(v0[0], v0[1]); w.y = pg8::cvt_pk_bf16(v0[2], v0[3]); w.z = pg8::cvt_pk_bf16(v1[0], v1[1]); w.w = pg8::cvt_pk_bf16(v1[2], v1[3]);
                    *(v4u*)(rowp + bj * 128) = w; } }
    }
};
#define XB_TMO      128
#define XB_XCNT(j)  (256  + 64 * (j))
#define XB_XSUB(j)  (1280 + 64 * (j))
#define XB_XGEN(j)  (2304 + 64 * (j))
#define XB_TOP      3328
#define XB_TOPGEN   3392
#define XCD_BAR_WORDS 3456
#define XB_SPIN_CAP (1u << 18)

__device__ __forceinline__ unsigned xb_ld(unsigned* p)              { return __hip_atomic_load(p, __ATOMIC_RELAXED, __HIP_MEMORY_SCOPE_AGENT); }
__device__ __forceinline__ unsigned xb_add(unsigned* p, unsigned v) { return __hip_atomic_fetch_add(p, v, __ATOMIC_RELAXED, __HIP_MEMORY_SCOPE_AGENT); }
__device__ __forceinline__ unsigned xb_xcc_id() { return (unsigned)__builtin_amdgcn_s_getreg((3 << 11) | 20) & 0xFu; }
#define XB_SPIN(cond, bar) do { unsigned _sp = 0; while (cond) { __builtin_amdgcn_s_sleep(1); \
    if ((++_sp & 255u) == 0u) { if (xb_ld(&(bar)[XB_TMO])) break; if (_sp > XB_SPIN_CAP) { atomicAdd(&(bar)[XB_TMO], 1u); break; } } } } while (0)

struct XcdBarrier {
    unsigned* bar; unsigned x;
    volatile LAS unsigned* st;
};

__device__ __forceinline__ XcdBarrier xcd_barrier_post(unsigned* bar, volatile LAS unsigned* st) {
    XcdBarrier b; b.bar = bar; b.x = xb_xcc_id(); b.st = st;
    if (threadIdx.x == 0) (void)xb_add(&bar[XB_XCNT(b.x)], 1u);
    return b;
}
__device__ __forceinline__ void xcd_barrier_complete(unsigned* bar, unsigned x, unsigned& nloc, unsigned& nx) {
    const unsigned G = gridDim.x * gridDim.y * gridDim.z;
    unsigned sum, cnt, mine, sp = 0u;
    for (;;) {
        sum = 0u; cnt = 0u; mine = 0u;
#pragma unroll
        for (unsigned j = 0; j < 16; ++j) { const unsigned c = xb_ld(&bar[XB_XCNT(j)]); sum += c; cnt += (c > 0u) ? 1u : 0u; mine = (j == x) ? c : mine; }
        if (sum == G) break;
        __builtin_amdgcn_s_sleep(1);
        if ((++sp & 255u) == 0u) { if (xb_ld(&bar[XB_TMO])) break; if (sp > XB_SPIN_CAP) { atomicAdd(&bar[XB_TMO], 1u); break; } }
    }
    nloc = mine > 0u ? mine : 1u; nx = cnt > 0u ? cnt : 1u;
}

__device__ __forceinline__ void xcd_barrier(const XcdBarrier& b) {
    asm volatile("s_waitcnt vmcnt(0)" ::: "memory");
    __syncthreads();
    if (threadIdx.x == 0) {
        unsigned* bar = b.bar;
        __builtin_amdgcn_s_waitcnt(0);
        unsigned nloc = b.st[0], nx = b.st[1];
        if (nloc == 0u) { xcd_barrier_complete(bar, b.x, nloc, nx); b.st[0] = nloc; b.st[1] = nx; }
        const unsigned old = xb_add(&bar[XB_XSUB(b.x)], 1u);
        const unsigned gen = old / nloc;
        if (old + 1u == (gen + 1u) * nloc) {
            __builtin_amdgcn_fence(__ATOMIC_RELEASE, "agent");
            asm volatile("s_waitcnt vmcnt(0)" ::: "memory");
            const unsigned og = xb_add(&bar[XB_TOP], 1u);
            const unsigned tg = og / nx;
            if (og + 1u == (tg + 1u) * nx) xb_add(&bar[XB_TOPGEN], 1u);
            else XB_SPIN(xb_ld(&bar[XB_TOPGEN]) == tg, bar);
            __builtin_amdgcn_fence(__ATOMIC_ACQUIRE, "agent");
            xb_add(&bar[XB_XGEN(b.x)], 1u);
            asm volatile("s_waitcnt vmcnt(0)" ::: "memory");
        } else {
            XB_SPIN(xb_ld(&bar[XB_XGEN(b.x)]) == gen, bar);
            __builtin_amdgcn_fence(__ATOMIC_ACQUIRE, "agent");
            asm volatile("s_waitcnt vmcnt(0)" ::: "memory");
        }
    }
    __syncthreads();
}
namespace att {
#ifndef PROF
#define PROF 0
#endif
#if PROF
#define STAMP(k) do { unsigned long long t_; asm volatile("s_memtime %0\n\ts_waitcnt lgkmcnt(0)" : "=s"(t_) :: "memory"); F_tacc[k] += t_ - tlast; tlast = t_; } while (0)
#else
#define STAMP(k) do { } while (0)
#endif
constexpr int STAGE = 32768;
__device__ __forceinline__ int k_off(int row, int ch) { return row * 256 + ((ch ^ (row & 15)) << 4); }
__device__ __forceinline__ int v_off(int row, int ch) { return 16384 + (row >> 1) * 256 + ((((row & 1) << 3) | (ch ^ ((row >> 1) & 7))) << 4); }
__device__ __forceinline__ int pi32(int i) { return (i & 0x13) | ((i & 4) << 1) | ((i & 8) >> 1); }
__device__ __forceinline__ float other_half(float v) {
    return __shfl_xor(v, 32);
}
__device__ __forceinline__ unsigned cvtpk(float lo, float hi) { typedef float f2 __attribute__((ext_vector_type(2))); typedef __bf16 b2 __attribute__((ext_vector_type(2))); f2 v = {lo, hi}; b2 b = __builtin_convertvector(v, b2); return __builtin_bit_cast(unsigned, b); }
constexpr int NST = 4;
struct Stager {
    const bf16* ks[2]; const bf16* vs[2]; size_t kstep; unsigned kd[2], vd[2];
    __device__ __forceinline__ void init(const bf16* Kp, int ldk, const bf16* VTp, int ldv, int wave, int lane) {
#pragma unroll
        for (int i = 0; i < 2; ++i) { const int pc = wave * 2 + i;
            const int row = 4 * pc + (lane >> 4), ch = (lane & 15) ^ (row & 15);
            ks[i] = Kp + (size_t)row * ldk + ch * 8; kd[i] = pc * 1024;
            const int line = 4 * pc + (lane >> 4), slot = lane & 15, vrow = 2 * line + (slot >> 3), vch = (slot & 7) ^ (line & 7);
            vs[i] = VTp + (size_t)vrow * ldv + vch * 8; vd[i] = 16384 + pc * 1024; }
        kstep = (size_t)64 * ldk;
    }
    __device__ __forceinline__ void issue(LAS unsigned char* lds, int t) const {
        LAS unsigned char* buf = lds + (t & (NST - 1)) * STAGE;
#pragma unroll
        for (int i = 0; i < 2; ++i) {
            __builtin_amdgcn_global_load_lds((const unsigned*)(ks[i] + (size_t)t * kstep), (LAS unsigned*)(buf + kd[i]), 16, 0, 0);
            __builtin_amdgcn_global_load_lds((const unsigned*)(vs[i] + (size_t)t * 64), (LAS unsigned*)(buf + vd[i]), 16, 0, 0); }
    }
};
__device__ __forceinline__ void wait_bar(int ahead) {
    if (ahead >= 2) asm volatile("s_waitcnt vmcnt(8)\n\ts_barrier" ::: "memory");
    else if (ahead == 1) asm volatile("s_waitcnt vmcnt(4)\n\ts_barrier" ::: "memory");
    else asm volatile("s_waitcnt vmcnt(0)\n\ts_barrier" ::: "memory");
}
__device__ __forceinline__ float swap_max(float v) { auto r = __builtin_amdgcn_permlane32_swap(__float_as_uint(v), __float_as_uint(v), false, false); return fmaxf(__uint_as_float(r[0]), __uint_as_float(r[1])); }
__device__ __forceinline__ float swap_sum(float v) { auto r = __builtin_amdgcn_permlane32_swap(__float_as_uint(v), __float_as_uint(v), false, false); return __uint_as_float(r[0]) + __uint_as_float(r[1]); }
template <int KSTEPS, bool CAUSAL>
__device__ __forceinline__ void attn_core(LAS unsigned char* lds, const bf16* Qw, int ldq, const bf16* Kp, int ldk, const bf16* VTp, int ldv, int ntiles, int q0rel, int coff,
                                          f32x16 (&o)[4], float& l_out, int wave, int lane, unsigned long long* F_tacc) {
    const int r32 = lane & 31, hi = lane >> 5; const bool trail = wave >= 4;
#if PROF
    unsigned long long tlast; asm volatile("s_memtime %0\n\ts_waitcnt lgkmcnt(0)" : "=s"(tlast) :: "memory");
#endif
    bf16x8 qf[KSTEPS];
#pragma unroll
    for (int ks = 0; ks < KSTEPS; ++ks) qf[ks] = *(const GAS bf16x8*)(Qw + (size_t)r32 * ldq + ks * 16 + hi * 8);
    Stager sg; sg.init(Kp, ldk, VTp, ldv, wave, lane);
    asm volatile("s_waitcnt vmcnt(0)" ::: "memory");
#pragma unroll
    for (int t = 0; t < NST - 1; ++t) if (t < ntiles) sg.issue(lds, t);
#pragma unroll
    for (int d = 0; d < 4; ++d)
#pragma unroll
        for (int r = 0; r < 16; ++r) o[d][r] = 0.f;
    float mref = 0.f, l = 0.f;
    f32x16 negm;
#pragma unroll
    for (int r = 0; r < 16; ++r) negm[r] = 0.f;
    const int krow = pi32(r32), kch0 = (coff >> 3) + hi;
    STAMP(0);
    if (trail) __builtin_amdgcn_s_setprio(1);
    if (trail) wait_bar(ntiles - 1);
    for (int t = 0; t < ntiles; ++t) {
        if (!trail) wait_bar(ntiles - 1 - t); else asm volatile("s_barrier" ::: "memory");
        STAMP(1);
        if (trail && t + NST - 1 < ntiles) sg.issue(lds, t + NST - 1);
        LAS unsigned char* buf = lds + (t & (NST - 1)) * STAGE;
        const int kv0 = t * 64;
        const bool active = !CAUSAL || (kv0 <= q0rel + 31);
        v4u pw[4]; f32x16 pa, pb;
        if (active) {
            f32x16 p0 = negm, p1 = negm;
#pragma unroll
            for (int kb = 0; kb < KSTEPS; kb += 4) {
                bf16x8 kf[8];
#pragma unroll
                for (int ks = 0; ks < 4; ++ks) { kf[2 * ks] = *(const LAS bf16x8*)(buf + k_off(krow, kch0 + 2 * (kb + ks))); kf[2 * ks + 1] = *(const LAS bf16x8*)(buf + k_off(32 + krow, kch0 + 2 * (kb + ks))); }
                __builtin_amdgcn_sched_barrier(0);
#pragma unroll
                for (int ks = 0; ks < 4; ++ks) {
                    p0 = __builtin_amdgcn_mfma_f32_32x32x16_bf16(kf[2 * ks], qf[kb + ks], p0, 0, 0, 0);
                    p1 = __builtin_amdgcn_mfma_f32_32x32x16_bf16(kf[2 * ks + 1], qf[kb + ks], p1, 0, 0, 0);
                }
            }
            if (CAUSAL && (kv0 + 63 > q0rel)) {
                const int qg = q0rel + r32;
#pragma unroll
                for (int r = 0; r < 16; ++r) { const int kv = kv0 + 16 * (r >> 3) + 8 * hi + (r & 7); if (kv > qg) p0[r] = -INFINITY; if (kv + 32 > qg) p1[r] = -INFINITY; }
            }
            float ra = fmaxf(fmaxf(p0[0], p0[1]), p1[0]), rb = fmaxf(fmaxf(p0[2], p0[3]), p1[1]);
            ra = fmaxf(fmaxf(ra, p1[2]), p1[3]);
#pragma unroll
            for (int r = 4; r < 16; r += 4) { ra = fmaxf(fmaxf(ra, p0[r]), p0[r + 1]); rb = fmaxf(fmaxf(rb, p0[r + 2]), p0[r + 3]); ra = fmaxf(fmaxf(ra, p1[r]), p1[r + 1]); rb = fmaxf(fmaxf(rb, p1[r + 2]), p1[r + 3]); }
            const float rm = swap_max(fmaxf(ra, rb));
            if (t == 0) {
                mref = rm;
#pragma unroll
                for (int r = 0; r < 16; ++r) { p0[r] -= rm; p1[r] -= rm; negm[r] = -rm; }
            } else if (__any(rm > 8.f)) {
                const float dl = fmaxf(rm, 0.f), al = __builtin_amdgcn_exp2f(-dl);
                mref += dl; l *= al;
#pragma unroll
                for (int r = 0; r < 16; ++r) { p0[r] -= dl; p1[r] -= dl; negm[r] = -mref; }
#pragma unroll
                for (int d = 0; d < 4; ++d)
#pragma unroll
                    for (int r = 0; r < 16; ++r) o[d][r] *= al;
            }
#pragma unroll
            for (int r = 0; r < 16; ++r) p0[r] = __builtin_amdgcn_exp2f(p0[r]);
#pragma unroll
            for (int s = 0; s < 2; ++s)
                pw[s] = (v4u){cvtpk(p0[8 * s], p0[8 * s + 1]), cvtpk(p0[8 * s + 2], p0[8 * s + 3]), cvtpk(p0[8 * s + 4], p0[8 * s + 5]), cvtpk(p0[8 * s + 6], p0[8 * s + 7])};
            pa = p0; pb = p1;
        }
        STAMP(2);
        if (!trail) asm volatile("s_barrier" ::: "memory"); else if (t + 1 < ntiles) wait_bar(ntiles - 2 - t); else asm volatile("s_barrier" ::: "memory");
        STAMP(3);
        if (!trail && t + NST - 1 < ntiles) sg.issue(lds, t + NST - 1);
        if (active) {
            bf16x8 vf[8];
#pragma unroll
            for (int ks = 0; ks < 2; ++ks)
#pragma unroll
                for (int d = 0; d < 4; ++d) vf[4 * ks + d] = *(const LAS bf16x8*)(buf + v_off(32 * d + r32, 2 * ks + hi));
            float ls = 0.f;
#pragma unroll
            for (int r = 0; r < 16; ++r) { pb[r] = __builtin_amdgcn_exp2f(pb[r]); ls += pa[r]; }
#pragma unroll
            for (int ks = 0; ks < 2; ++ks)
#pragma unroll
                for (int d = 0; d < 4; ++d) o[d] = __builtin_amdgcn_mfma_f32_32x32x16_bf16(vf[4 * ks + d], __builtin_bit_cast(bf16x8, pw[ks]), o[d], 0, 0, 0);
#pragma unroll
            for (int ks = 2; ks < 4; ++ks)
#pragma unroll
                for (int d = 0; d < 4; ++d) vf[4 * (ks - 2) + d] = *(const LAS bf16x8*)(buf + v_off(32 * d + r32, 2 * ks + hi));
#pragma unroll
            for (int s = 0; s < 2; ++s)
                pw[2 + s] = (v4u){cvtpk(pb[8 * s], pb[8 * s + 1]), cvtpk(pb[8 * s + 2], pb[8 * s + 3]), cvtpk(pb[8 * s + 4], pb[8 * s + 5]), cvtpk(pb[8 * s + 6], pb[8 * s + 7])};
#pragma unroll
            for (int r = 0; r < 16; ++r) ls += pb[r];
            l += ls;
#pragma unroll
            for (int ks = 2; ks < 4; ++ks)
#pragma unroll
                for (int d = 0; d < 4; ++d) o[d] = __builtin_amdgcn_mfma_f32_32x32x16_bf16(vf[4 * (ks - 2) + d], __builtin_bit_cast(bf16x8, pw[ks]), o[d], 0, 0, 0);
        }
        STAMP(4);
    }
    if (!trail) asm volatile("s_barrier" ::: "memory");
    asm volatile("s_waitcnt lgkmcnt(0)\n\ts_barrier" ::: "memory");
    __builtin_amdgcn_s_setprio(0);
    l_out = swap_sum(l);
    STAMP(5);
}
__device__ __forceinline__ int crow(int r, int hi) { return (r & 3) + 8 * (r >> 2) + 4 * hi; }

__device__ __forceinline__ void diff_unit(Frame& F, int b, int h, int qb, float lam) {
    unsigned char* ws = F.ws; int tid_ = F.tid; asm volatile("" : "+v"(tid_)); const int w = F.wave, c = w >> 2, sb = w & 3, lane = tid_ & 63, r32 = lane & 31, hi = lane >> 5;
    const int q0 = qb * 128, q0w = q0 + 32 * sb; const size_t trow0 = (size_t)b * SEQ;
    const bf16* Qw = (const bf16*)(ws + WS_Q) + (trow0 + q0w) * 1024 + h * 128 + c * 64;
    const bf16* Kp = (const bf16*)(ws + WS_K) + trow0 * 1024 + h * 128;
    const bf16* VTp = (const bf16*)(ws + WS_VT) + (size_t)(h * 128) * M + trow0;
    f32x16 o[4]; float l;
#if PROF
    { unsigned long long t_; asm volatile("s_memtime %0\n\ts_waitcnt lgkmcnt(0)" : "=s"(t_) :: "memory"); F.tacc[7] = t_; }
#endif
    attn_core<4, true>(F.lds, Qw, 1024, Kp, 1024, VTp, M, (q0 + 128) / 64, q0w, c * 64, o, l, w, lane, F.tacc);
    const float inv = 1.f / l;
    LAS float* xch = (LAS float*)F.lds + sb * 4096 + lane;
    if (c == 1) {
        const float f = lam * inv;
#pragma unroll
        for (int d = 0; d < 4; ++d)
#pragma unroll
            for (int r = 0; r < 16; ++r) xch[(d * 16 + r) * 64] = o[d][r] * f;
    }
    __syncthreads();
    if (c == 0) {
        float ss = 0.f;
#pragma unroll
        for (int d = 0; d < 4; ++d)
#pragma unroll
            for (int r = 0; r < 16; ++r) { const float v = o[d][r] * inv - xch[(d * 16 + r) * 64]; o[d][r] = v; ss += v * v; }
        ss = swap_sum(ss);
        const float rs = rsqrtf(ss * (1.f / 128.f) + EPS) * (1.f - LAMBDA_INIT);
        const size_t t = trow0 + q0w + r32;
        const bf16* Gp = (const bf16*)(ws + WS_G) + t * 1024 + h * 128; bf16* Op = (bf16*)(ws + WS_MIXED) + t * 2048 + h * 128;
        const float* sw = F.in[9];
#pragma unroll
        for (int d = 0; d < 4; ++d)
#pragma unroll
            for (int rg = 0; rg < 4; ++rg) { const int dv = 32 * d + 8 * rg + 4 * hi;
                const v2u g = *(const GAS v2u*)(Gp + dv); const f32x4 wv = *(const GAS f32x4*)(sw + dv);
                v2u ov; ov.x = pk2(o[d][4 * rg] * rs * wv[0] * bflo(g.x), o[d][4 * rg + 1] * rs * wv[1] * bfhi(g.x));
                ov.y = pk2(o[d][4 * rg + 2] * rs * wv[2] * bflo(g.y), o[d][4 * rg + 3] * rs * wv[3] * bfhi(g.y));
                *(GAS v2u*)(Op + dv) = ov; }
    }
    __syncthreads();
#if PROF
    { unsigned long long t_; asm volatile("s_memtime %0\n\ts_waitcnt lgkmcnt(0)" : "=s"(t_) :: "memory"); F.tacc[6] += t_ - F.tacc[7]; }
#endif
}
__device__ __forceinline__ void xattn_unit(Frame& F, int b, int h, int qb) {
    unsigned char* ws = F.ws; int tid_ = F.tid; asm volatile("" : "+v"(tid_)); const int w = F.wave, lane = tid_ & 63, r32 = lane & 31, hi = lane >> 5;
    const int q0w = qb * 256 + 32 * w; const size_t trow0 = (size_t)b * SEQ;
    const bf16* Qw = (const bf16*)(ws + WS_XQ) + (trow0 + q0w) * 512 + h * 128;
    const bf16* Kp = (const bf16*)(ws + WS_MK) + (size_t)(b * MEMLEN) * 512 + h * 128;
    const bf16* VTp = (const bf16*)(ws + WS_MVT) + (size_t)(h * 128) * MM + b * MEMLEN;
    f32x16 o[4]; float l;
    attn_core<8, false>(F.lds, Qw, 512, Kp, 512, VTp, MM, MEMLEN / 64, 0, 0, o, l, w, lane, F.tacc);
    const float inv = 1.f / l; const size_t t = trow0 + q0w + r32;
    const bf16* Gp = (const bf16*)(ws + WS_XG) + t * 512 + h * 128; bf16* Op = (bf16*)(ws + WS_MIXED) + t * 2048 + 1536 + h * 128;
#pragma unroll
    for (int d = 0; d < 4; ++d)
#pragma unroll
        for (int rg = 0; rg < 4; ++rg) { const int dv = 32 * d + 8 * rg + 4 * hi;
            const v2u g = *(const GAS v2u*)(Gp + dv);
            v2u ov; ov.x = pk2(o[d][4 * rg] * inv * bflo(g.x), o[d][4 * rg + 1] * inv * bfhi(g.x));
            ov.y = pk2(o[d][4 * rg + 2] * inv * bflo(g.y), o[d][4 * rg + 3] * inv * bfhi(g.y));
            *(GAS v2u*)(Op + dv) = ov; }
}
}
namespace ssd {
using att::k_off; using att::pi32; using att::crow; using att::other_half;
__device__ __forceinline__ v4u pack8(const float (&s)[8]) { return (v4u){att::cvtpk(s[0], s[1]), att::cvtpk(s[2], s[3]), att::cvtpk(s[4], s[5]), att::cvtpk(s[6], s[7])}; }
__device__ __forceinline__ void unitA(Frame& F, int b, int c, int g) {
    unsigned char* ws = F.ws; int tid_ = F.tid; asm volatile("" : "+v"(tid_)); const int tid = tid_, lane = tid & 63, w = F.wave, r32 = lane & 31, hi = lane >> 5;
    const size_t t0 = (size_t)b * SEQ + c * 128;
    LAS unsigned char* tile = F.lds;
    LAS float* tab = (LAS float*)(F.lds + 98304);
    const float* DTg = (const float*)(ws + WS_DT); float* ACSg = (float*)(ws + WS_ACS);
    { const int hh = tid >> 7, l = tid & 127, h = g * 4 + hh;
      const float dt = DTg[(t0 + l) * 8 + h]; float v = dt * (-__expf(F.in[13][h]));
#pragma unroll
      for (int o = 1; o < 64; o <<= 1) { const float t = __shfl_up(v, o); if (lane >= o) v += t; }
      if ((w & 1) == 0 && lane == 63) tab[1536 + hh] = v;
      __syncthreads();
      if (w & 1) v += tab[1536 + hh];
      tab[hh * 128 + l] = dt; tab[512 + hh * 128 + l] = v; ACSg[(t0 + l) * 8 + h] = v;
      __syncthreads();
      tab[1024 + hh * 128 + l] = dt * __expf(tab[512 + hh * 128 + 127] - v);
      __syncthreads(); }
    { const int ch = tid; const int col = (ch < 256) ? g * 256 + ch : (ch < 384) ? 512 + g * 128 + (ch - 256) : 768 + g * 128 + (ch - 384);
      const float* cw = F.in[10]; const float w0 = cw[col], w1 = cw[1024 + col], w2 = cw[2048 + col], w3 = cw[3072 + col], bias = F.in[11][col];
      const bf16* src = (const bf16*)(ws + WS_XBC) + t0 * 1024 + col;
      float xx[11]; xx[0] = xx[1] = xx[2] = 0.f;
      if (c > 0) { xx[0] = bf2f(src[-3 * 1024]); xx[1] = bf2f(src[-2 * 1024]); xx[2] = bf2f(src[-1 * 1024]); }
      bf16* XTg = (bf16*)(ws + WS_XT) + ((size_t)(b * 16 + c) * 512 + g * 256 + ch) * 128;
      bf16* BCg = (bf16*)(ws + WS_BC) + t0 * 512 + ((ch < 384) ? g * 128 + (ch - 256) : 256 + g * 128 + (ch - 384));
      const int hh = (ch >> 6) & 3;
#pragma unroll 1
      for (int half = 0; half < 4; ++half) {
          bf16 raw[32];
#pragma unroll
          for (int j = 0; j < 32; ++j) raw[j] = src[(size_t)(half * 32 + j) * 1024];
#pragma unroll
          for (int lq = 0; lq < 4; ++lq) { const int lg = half * 4 + lq;
#pragma unroll
              for (int j = 0; j < 8; ++j) xx[3 + j] = bf2f(raw[lq * 8 + j]);
              float s[8];
#pragma unroll
              for (int j = 0; j < 8; ++j) { const float y = bias + w0 * xx[j] + w1 * xx[j + 1] + w2 * xx[j + 2] + w3 * xx[j + 3]; s[j] = y / (1.f + __expf(-y)); }
              xx[0] = xx[8]; xx[1] = xx[9]; xx[2] = xx[10];
              if (ch < 256) {
                  *(GAS v4u*)(XTg + lg * 8) = pack8(s);
                  const f32x4 wa = *(const LAS f32x4*)(tab + 1024 + hh * 128 + lg * 8), wb = *(const LAS f32x4*)(tab + 1024 + hh * 128 + lg * 8 + 4);
                  float sw[8] = {s[0] * wa[0], s[1] * wa[1], s[2] * wa[2], s[3] * wa[3], s[4] * wb[0], s[5] * wb[1], s[6] * wb[2], s[7] * wb[3]};
                  *(LAS v4u*)(tile + k_off(ch, lg)) = pack8(sw);
              } else {
#pragma unroll
                  for (int j = 0; j < 8; ++j) BCg[(size_t)(lg * 8 + j) * 512] = (bf16)f2bf(s[j]);
                  if (ch < 384) *(LAS v4u*)(tile + k_off(ch, lg)) = pack8(s);
              }
          }
      } }
    __syncthreads();
    { const int hh = w >> 1, nh = w & 1;
      f32x16 acc[2][2];
#pragma unroll
      for (int i = 0; i < 2; ++i)
#pragma unroll
          for (int j = 0; j < 2; ++j)
#pragma unroll
              for (int r = 0; r < 16; ++r) acc[i][j][r] = 0.f;
#pragma unroll
      for (int ks = 0; ks < 8; ++ks) {
          const bf16x8 a0 = *(const LAS bf16x8*)(tile + k_off(hh * 64 + r32, 2 * ks + hi)), a1 = *(const LAS bf16x8*)(tile + k_off(hh * 64 + 32 + r32, 2 * ks + hi));
          const bf16x8 b0 = *(const LAS bf16x8*)(tile + k_off(256 + nh * 64 + r32, 2 * ks + hi)), b1 = *(const LAS bf16x8*)(tile + k_off(256 + nh * 64 + 32 + r32, 2 * ks + hi));
          acc[0][0] = __builtin_amdgcn_mfma_f32_32x32x16_bf16(a0, b0, acc[0][0], 0, 0, 0); acc[0][1] = __builtin_amdgcn_mfma_f32_32x32x16_bf16(a0, b1, acc[0][1], 0, 0, 0);
          acc[1][0] = __builtin_amdgcn_mfma_f32_32x32x16_bf16(a1, b0, acc[1][0], 0, 0, 0); acc[1][1] = __builtin_amdgcn_mfma_f32_32x32x16_bf16(a1, b1, acc[1][1], 0, 0, 0);
      }
      float* cs = (float*)(ws + WS_CS) + (size_t)((b * 16 + c) * 8 + g * 4 + hh) * 8192;
#pragma unroll
      for (int pb = 0; pb < 2; ++pb)
#pragma unroll
          for (int nb = 0; nb < 2; ++nb)
#pragma unroll
              for (int r = 0; r < 16; ++r) cs[(32 * pb + crow(r, hi)) * 128 + nh * 64 + 32 * nb + r32] = acc[pb][nb][r]; }
    __syncthreads();
}

__device__ __forceinline__ void scan_unit(Frame& F, int b, int h, int sl) {
    unsigned char* ws = F.ws; int tid_ = F.tid; asm volatile("" : "+v"(tid_)); const int e = sl * 1024 + 2 * tid_;
    typedef float f32x2 __attribute__((ext_vector_type(2)));
    const float* CSg = (const float*)(ws + WS_CS) + (size_t)(b * 16 * 8 + h) * 8192 + e; const float* ACSg = (const float*)(ws + WS_ACS);
    unsigned* PVg = (unsigned*)((bf16*)(ws + WS_PREV) + (size_t)(b * 16 * 8 + h) * 8192 + e);
    f32x2 v[15]; float dec[15];
#pragma unroll
    for (int c = 0; c < 15; ++c) { v[c] = *(const GAS f32x2*)(CSg + (size_t)c * 8 * 8192); dec[c] = __expf(ACSg[((size_t)b * SEQ + c * 128 + 127) * 8 + h]); }
    f32x2 s = {0.f, 0.f};
#pragma unroll
    for (int c = 0; c < 16; ++c) { PVg[(size_t)c * 8 * 4096] = att::cvtpk(s[0], s[1]); if (c < 15) s = s * dec[c] + v[c]; }
}
__device__ __forceinline__ void scan_publish(Frame& F, int b, int g) {
    asm volatile("s_waitcnt vmcnt(0)" ::: "memory");
    __syncthreads();
    if (F.tid == 0) { __builtin_amdgcn_fence(__ATOMIC_RELEASE, "agent"); asm volatile("s_waitcnt vmcnt(0)" ::: "memory");
        __hip_atomic_fetch_add((unsigned*)(F.ws + WS_CTL) + 8192 + (b * 2 + g) * 64, 1u, __ATOMIC_RELAXED, __HIP_MEMORY_SCOPE_AGENT); }
}
__device__ __forceinline__ void scan_wait(Frame& F, int b, int g) {
    if (F.tid == 0) { unsigned* p = (unsigned*)(F.ws + WS_CTL) + 8192 + (b * 2 + g) * 64; unsigned sp = 0;
        while (__hip_atomic_load(p, __ATOMIC_RELAXED, __HIP_MEMORY_SCOPE_AGENT) < 32u) { __builtin_amdgcn_s_sleep(2); if (++sp > (1u << 22)) break; }
        __builtin_amdgcn_fence(__ATOMIC_ACQUIRE, "agent"); asm volatile("s_waitcnt vmcnt(0)" ::: "memory"); }
    __syncthreads();
}

__device__ __forceinline__ void unitB(Frame& F, int b, int c, int g) {
    unsigned char* ws = F.ws; int tid_ = F.tid; asm volatile("" : "+v"(tid_)); const int tid = tid_, lane = tid & 63, w = F.wave, r32 = lane & 31, hi = lane >> 5;
    const size_t t0 = (size_t)b * SEQ + c * 128;
    LAS float* tab = (LAS float*)F.lds;
    const float* DTg = (const float*)(ws + WS_DT); const float* ACSg = (const float*)(ws + WS_ACS);
    if (c > 0) scan_wait(F, b, g);
    { const int hh = tid >> 7, l = tid & 127; tab[hh * 128 + l] = DTg[(t0 + l) * 8 + g * 4 + hh]; tab[512 + hh * 128 + l] = ACSg[(t0 + l) * 8 + g * 4 + hh]; }
    __syncthreads();
    const int lb = w & 3, hp = w >> 2, l_loc = 32 * lb + r32;
    const bf16* BCg = (const bf16*)(ws + WS_BC) + t0 * 512;
    const bf16* PVg = (const bf16*)(ws + WS_PREV) + (size_t)((b * 16 + c) * 8 + g * 4) * 8192;
    bf16x8 cf[8];
#pragma unroll
    for (int ks = 0; ks < 8; ++ks) cf[ks] = *(const GAS bf16x8*)(BCg + (size_t)l_loc * 512 + 256 + g * 128 + 16 * ks + 8 * hi);
    f32x16 acc[2][2];
#pragma unroll
    for (int hh2 = 0; hh2 < 2; ++hh2)
#pragma unroll
        for (int pb = 0; pb < 2; ++pb) {
#pragma unroll
            for (int r = 0; r < 16; ++r) acc[hh2][pb][r] = 0.f;
            if (c > 0) {
#pragma unroll
                for (int ks = 0; ks < 8; ++ks) { const bf16x8 a = *(const GAS bf16x8*)(PVg + (size_t)(2 * hp + hh2) * 8192 + (32 * pb + r32) * 128 + 16 * ks + 8 * hi);
                    acc[hh2][pb] = __builtin_amdgcn_mfma_f32_32x32x16_bf16(a, cf[ks], acc[hh2][pb], 0, 0, 0); }
                const float e = __expf(tab[512 + (2 * hp + hh2) * 128 + l_loc]);
#pragma unroll
                for (int r = 0; r < 16; ++r) acc[hh2][pb][r] *= e;
            }
        }
    const bf16* XTg = (const bf16*)(ws + WS_XT) + ((size_t)(b * 16 + c) * 512 + g * 256) * 128;
#pragma unroll 1
    for (int sb = 0; sb <= lb; ++sb) {
        f32x16 gt;
#pragma unroll
        for (int r = 0; r < 16; ++r) gt[r] = 0.f;
        const bf16* brow = BCg + (size_t)(32 * sb + pi32(r32)) * 512 + g * 128 + 8 * hi;
#pragma unroll
        for (int ks = 0; ks < 8; ++ks) { const bf16x8 bfr = *(const GAS bf16x8*)(brow + 16 * ks); gt = __builtin_amdgcn_mfma_f32_32x32x16_bf16(bfr, cf[ks], gt, 0, 0, 0); }
#pragma unroll
        for (int hh2 = 0; hh2 < 2; ++hh2) { const int hh = 2 * hp + hh2; const float acs_l = tab[512 + hh * 128 + l_loc], Dh = F.in[14][g * 4 + hh];
            float sc[16];
#pragma unroll
            for (int q4 = 0; q4 < 4; ++q4) { const int sbase = 32 * sb + 16 * (q4 >> 1) + 8 * hi + 4 * (q4 & 1);
                const f32x4 as = *(const LAS f32x4*)(tab + 512 + hh * 128 + sbase), ds = *(const LAS f32x4*)(tab + hh * 128 + sbase);
#pragma unroll
                for (int e = 0; e < 4; ++e) { const int r = 4 * q4 + e; float v = gt[r] * __builtin_amdgcn_exp2f(fminf(acs_l - as[e], 0.f) * LOG2E) * ds[e];
                    if (sb == lb) { const int sl = 16 * (r >> 3) + 8 * hi + (r & 7); if (sl > r32) v = 0.f; if (sl == r32) v += Dh; }
                    sc[r] = v; } }
            v4u scb[2];
            scb[0] = (v4u){att::cvtpk(sc[0], sc[1]), att::cvtpk(sc[2], sc[3]), att::cvtpk(sc[4], sc[5]), att::cvtpk(sc[6], sc[7])};
            scb[1] = (v4u){att::cvtpk(sc[8], sc[9]), att::cvtpk(sc[10], sc[11]), att::cvtpk(sc[12], sc[13]), att::cvtpk(sc[14], sc[15])};
#pragma unroll
            for (int pb = 0; pb < 2; ++pb)
#pragma unroll
                for (int k2 = 0; k2 < 2; ++k2) { const bf16x8 xf = *(const GAS bf16x8*)(XTg + (size_t)(hh * 64 + 32 * pb + r32) * 128 + 32 * sb + 16 * k2 + 8 * hi);
                    acc[hh2][pb] = __builtin_amdgcn_mfma_f32_32x32x16_bf16(xf, __builtin_bit_cast(bf16x8, scb[k2]), acc[hh2][pb], 0, 0, 0); }
        }
    }
    const size_t t = t0 + l_loc; const bf16* Zg = (const bf16*)(ws + WS_Z) + t * 512 + g * 256;
    float ss = 0.f;
#pragma unroll
    for (int hh2 = 0; hh2 < 2; ++hh2)
#pragma unroll
        for (int pb = 0; pb < 2; ++pb)
#pragma unroll
            for (int rg = 0; rg < 4; ++rg) { const int ch = (2 * hp + hh2) * 64 + 32 * pb + 8 * rg + 4 * hi; const v2u z = *(const GAS v2u*)(Zg + ch);
                const float y0 = acc[hh2][pb][4 * rg] * bflo(z.x), y1 = acc[hh2][pb][4 * rg + 1] * bfhi(z.x), y2 = acc[hh2][pb][4 * rg + 2] * bflo(z.y), y3 = acc[hh2][pb][4 * rg + 3] * bfhi(z.y);
                acc[hh2][pb][4 * rg] = y0; acc[hh2][pb][4 * rg + 1] = y1; acc[hh2][pb][4 * rg + 2] = y2; acc[hh2][pb][4 * rg + 3] = y3;
                ss += (y0 * y0 + y1 * y1) + (y2 * y2 + y3 * y3); }
    ss += other_half(ss);
    if (hi == 0) tab[1024 + hp * 128 + l_loc] = ss;
    __syncthreads();
    const float rs = rsqrtf((tab[1024 + l_loc] + tab[1024 + 128 + l_loc]) * (1.f / 256.f) + EPS);
    bf16* Og = (bf16*)(ws + WS_MIXED) + t * 2048 + 1024 + g * 256; const float* nw = F.in[15] + g * 256;
#pragma unroll
    for (int hh2 = 0; hh2 < 2; ++hh2)
#pragma unroll
        for (int pb = 0; pb < 2; ++pb)
#pragma unroll
            for (int rg = 0; rg < 4; ++rg) { const int ch = (2 * hp + hh2) * 64 + 32 * pb + 8 * rg + 4 * hi; const f32x4 wv = *(const GAS f32x4*)(nw + ch);
                v2u o; o.x = pk2(acc[hh2][pb][4 * rg] * rs * wv[0], acc[hh2][pb][4 * rg + 1] * rs * wv[1]); o.y = pk2(acc[hh2][pb][4 * rg + 2] * rs * wv[2], acc[hh2][pb][4 * rg + 3] * rs * wv[3]);
                *(GAS v2u*)(Og + ch) = o; }
    __syncthreads();
}
}
struct Sched2 {
    int G, c; const char *A, *B;
    __device__ __forceinline__ bool next(int i, pg8::Unit& u) const {
        const long L = (long)i * G + c; if (L >= 256) return false;
        int wgid = (int)L; { const int xcd = wgid % 8, off = wgid / 8; wgid = xcd * 32 + off; }
        u.pm = (wgid / 64) * 8 + ((wgid % 64) % 8); u.pn = (wgid % 64) / 8; u.kind = 0;
        u.a = A + (size_t)u.pm * TSTEP; u.b = B + (size_t)u.pn * TSTEP; return true;
    }
    __device__ __forceinline__ void a_ready(const pg8::Unit&) const {}
    __device__ __forceinline__ void done(const pg8::Unit&) const {}
};
struct EpiF32 {
    static constexpr bool PERM = false, AFTER_DRAIN = false;
    float* O; int ldc;
    __device__ __forceinline__ void operator()(const pg8::f32x4 (&acc)[2][2][4][2], const pg8::Unit& u, int wr, int wc, int fr, int fq) const {
        const int row0 = u.pm * 256 + wr * 64 + fr, col0 = u.pn * 256 + wc * 32 + 4 * fq;
#pragma unroll
        for (int ai = 0; ai < 2; ++ai)
#pragma unroll
            for (int m = 0; m < 4; ++m) { float* rowp = O + (size_t)(row0 + ai * 128 + m * 16) * ldc + col0;
#pragma unroll
                for (int bj = 0; bj < 2; ++bj)
#pragma unroll
                    for (int n = 0; n < 2; ++n) *(pg8::f32x4*)(rowp + bj * 128 + n * 16) = acc[ai][bj][m][n]; }
    }
};

struct EpiRmsRes {
    static constexpr bool PERM = false, AFTER_DRAIN = true;
    const float* x; const float* w; float* out; float* slots; unsigned* cnt;
    __device__ __forceinline__ void fused(pg8::f32x4 (&acc)[2][2][4][2], const pg8::Unit& u, int wr, int wc, int fr, int fq, PG8_LAS unsigned char* lds, int wid, int lane) const {
        PG8_LAS float* P = (PG8_LAS float*)lds;
        PG8_LAS float* S = (PG8_LAS float*)(lds + 4096);
#pragma unroll
        for (int ai = 0; ai < 2; ++ai)
#pragma unroll
            for (int m = 0; m < 4; ++m) { float s = 0.f;
#pragma unroll
                for (int bj = 0; bj < 2; ++bj)
#pragma unroll
                    for (int n = 0; n < 2; ++n) { const pg8::f32x4 v = acc[ai][bj][m][n]; s += (v[0] * v[0] + v[1] * v[1]) + (v[2] * v[2] + v[3] * v[3]); }
                s += __shfl_xor(s, 16); s += __shfl_xor(s, 32);
                if (fq == 0) P[(ai * 128 + wr * 64 + m * 16 + fr) * 4 + wc] = s; }
        asm volatile("s_waitcnt lgkmcnt(0)" ::: "memory"); __builtin_amdgcn_s_barrier(); asm volatile("" ::: "memory");
        const int row = wid * 32 + (lane & 31);
        if (lane < 32) { const float t = (P[row * 4] + P[row * 4 + 1]) + (P[row * 4 + 2] + P[row * 4 + 3]);
            __hip_atomic_store(slots + (size_t)(u.pm * 256 + row) * 8 + u.pn, t, __ATOMIC_RELAXED, __HIP_MEMORY_SCOPE_AGENT); }
        asm volatile("s_waitcnt vmcnt(0)" ::: "memory");
        if (lane == 0) __hip_atomic_fetch_add(cnt + 64 * u.pm, 1u, __ATOMIC_RELAXED, __HIP_MEMORY_SCOPE_AGENT);
        if (wid == 0) { unsigned sp = 0;
            while ((unsigned)__builtin_amdgcn_readfirstlane(__hip_atomic_load(cnt + 64 * u.pm, __ATOMIC_RELAXED, __HIP_MEMORY_SCOPE_AGENT)) < 64u) { __builtin_amdgcn_s_sleep(2); if (++sp > (1u << 22)) break; }
            __builtin_amdgcn_fence(__ATOMIC_ACQUIRE, "agent"); }
        asm volatile("s_waitcnt vmcnt(0) lgkmcnt(0)" ::: "memory"); __builtin_amdgcn_s_barrier(); asm volatile("" ::: "memory");
        if (lane < 32) { const float* sl = slots + (size_t)(u.pm * 256 + row) * 8; float t = 0.f;
#pragma unroll
            for (int k = 0; k < 8; ++k) t += __hip_atomic_load(sl + k, __ATOMIC_RELAXED, __HIP_MEMORY_SCOPE_AGENT);
            S[row] = rsqrtf(t * (1.f / DM) + EPS); }
        asm volatile("s_waitcnt lgkmcnt(0)" ::: "memory"); __builtin_amdgcn_s_barrier(); asm volatile("" ::: "memory");
        const int col0 = u.pn * 256 + wc * 32 + 4 * fq;
        pg8::f32x4 wv[2][2];
#pragma unroll
        for (int bj = 0; bj < 2; ++bj)
#pragma unroll
            for (int n = 0; n < 2; ++n) wv[bj][n] = *(const pg8::f32x4*)(w + col0 + bj * 128 + n * 16);
#pragma unroll
        for (int ai = 0; ai < 2; ++ai)
#pragma unroll
            for (int m = 0; m < 4; ++m) { const int r = ai * 128 + wr * 64 + m * 16 + fr; const float rs = S[r]; const size_t off = (size_t)(u.pm * 256 + r) * DM + col0;
#pragma unroll
                for (int bj = 0; bj < 2; ++bj)
#pragma unroll
                    for (int n = 0; n < 2; ++n) { const pg8::f32x4 xv = *(const pg8::f32x4*)(x + off + bj * 128 + n * 16);
                        *(pg8::f32x4*)(out + off + bj * 128 + n * 16) = xv + acc[ai][bj][m][n] * rs * wv[bj][n]; }
                if (m & 1) asm volatile("" ::: "memory"); }
    }
};
__device__ __forceinline__ void p5_final(Frame& F) {
    const int gw = F.vcu * NWAVES + F.wave, NGW = F.G * NWAVES;
    const float* o2 = (const float*)(F.ws + WS_O2); const GAS f32x4* wr = (const GAS f32x4*)F.in[19] + F.lane;
    for (int mrow = gw; mrow < M; mrow += NGW) {
        const GAS f32x4* orow = (const GAS f32x4*)(o2 + (size_t)mrow * DM) + F.lane; const GAS f32x4* xr = (const GAS f32x4*)(F.in[0] + (size_t)mrow * DM) + F.lane;
        GAS f32x4* outr = (GAS f32x4*)(F.out + (size_t)mrow * DM) + F.lane;
        f32x4 v[8]; float s = 0.f;
#pragma unroll
        for (int j = 0; j < 8; ++j) { v[j] = orow[64 * j]; s += (v[j].x * v[j].x + v[j].y * v[j].y) + (v[j].z * v[j].z + v[j].w * v[j].w); }
        const float rstd = rsqrtf(wave_sum(s) * (1.f / DM) + EPS);
#pragma unroll
        for (int j = 0; j < 8; ++j) outr[64 * j] = xr[64 * j] + v[j] * rstd * wr[64 * j];
    }
}
constexpr int LDS_BYTES = 147456;
struct Args { const float* in[20]; float* out; unsigned char* ws; int ph_lo, ph_hi; int rep[10]; };
__global__ void __launch_bounds__(NTHR, 2) mega(Args args) {
    extern __shared__ __attribute__((aligned(16))) unsigned char lds[];
    Frame F;
    F.lds = (LAS unsigned char*)lds;
    F.tid = threadIdx.x; F.lane = F.tid & 63; F.wave = __builtin_amdgcn_readfirstlane(F.tid >> 6);
    F.G = gridDim.x; { const int bx = blockIdx.x; F.vcu = (F.G % 8 == 0) ? (bx % 8) * (F.G / 8) + bx / 8 : bx; }
#pragma unroll
    for (int i = 0; i < 20; ++i) F.in[i] = args.in[i];
    F.out = args.out; F.ws = args.ws;
#pragma unroll
    for (int i = 0; i < 8; ++i) F.tacc[i] = 0;
    const int lo = args.ph_lo, hi = args.ph_hi;
#define IN(k) (lo <= (k) && (k) < hi)
    volatile LAS unsigned* MISC = (volatile LAS unsigned*)(F.lds + LDS_BYTES - 64);
    if (F.tid < 16) MISC[F.tid] = 0u;
    __syncthreads();
    const XcdBarrier bar = xcd_barrier_post((unsigned*)(F.ws + WS_CTL) + 4096, MISC + 8);
#define SEAM(k) do { if (IN(k) && IN((k) + 1)) xcd_barrier(bar); } while (0)
#define REPS(k) (args.rep[k])
#define RETID() do { int t_ = threadIdx.x; asm volatile("" : "+v"(t_)); F.tid = t_; F.lane = t_ & 63; } while (0)
    for (int rp = 0; rp < REPS(0); ++rp) { if (rp) xcd_barrier(bar);
    if (IN(0)) { RETID(); p0_prologue(F); }
    }
    SEAM(0);
    for (int rp = 0; rp < REPS(1); ++rp) { if (rp) xcd_barrier(bar);
    if (IN(1)) {
        pg8::Gemm g{DM}; Sched1 S{F.G, (int)blockIdx.x, (const char*)(F.ws + WS_HN), (const char*)(F.ws + WS_W1T), (const char*)(F.ws + WS_MEMN), (const char*)(F.ws + WS_WKVT)};
        EpiP1 E{F.ws};
        pg8::gemm_phase<EpiP1, Sched1, true, true>(F.lds, g, S, E);
    }
    }
    SEAM(1);
    for (int rp = 0; rp < REPS(2); ++rp) { if (rp) xcd_barrier(bar);
    if (IN(2)) {
        for (int u = F.vcu; u < 256; u += F.G) { if (u < 128) att::xattn_unit(F, u >> 5, (u >> 3) & 3, u & 7); else { const int v = u - 128; ssd::unitA(F, v >> 5, (v >> 1) & 15, v & 1); } }
    }
    }
    SEAM(2);
    for (int rp = 0; rp < REPS(3); ++rp) { if (rp) xcd_barrier(bar);
    if (IN(3)) {
        const float d1 = wave_sum(F.lane < 64 ? F.in[5][F.lane] * F.in[6][F.lane] : 0.f), d2 = wave_sum(F.in[7][F.lane] * F.in[8][F.lane]);
        const float lam = __expf(d1) - __expf(d2) + LAMBDA_INIT;
        for (int r6 = 0; r6 < args.rep[6]; ++r6)
        for (int v = F.vcu; v < 256; v += F.G) { ssd::scan_unit(F, v >> 6, (v >> 3) & 7, v & 7); ssd::scan_publish(F, v >> 6, (v >> 5) & 1); }
        for (int r7 = 0; r7 < args.rep[7]; ++r7)
        for (int v = F.vcu; v < 256; v += F.G) { const int x = v >> 5, j = v & 31, bh1 = 4 * x + (j >> 4), bh2 = bh1 + 2, s = j & 15;
            att::diff_unit(F, bh1 >> 3, bh1 & 7, s, lam); att::diff_unit(F, bh2 >> 3, bh2 & 7, 15 - s, lam); }
#if PROF
        if (args.rep[9] > 0) { const int sel = args.rep[9]; unsigned long long acc = 0;
            acc = sel == 1 ? F.tacc[0] : sel == 2 ? F.tacc[1] : sel == 3 ? F.tacc[2] : sel == 4 ? F.tacc[3] : sel == 5 ? F.tacc[4] : sel == 6 ? F.tacc[5] : F.tacc[6];
            const unsigned long long t0 = __builtin_amdgcn_s_memtime(); while (__builtin_amdgcn_s_memtime() - t0 < acc) __builtin_amdgcn_s_sleep(4); }
#endif
        for (int r8 = 0; r8 < args.rep[8]; ++r8)
        for (int v = F.vcu; v < 128; v += F.G) ssd::unitB(F, v >> 5, (v >> 1) & 15, v & 1);
    }
    }
    SEAM(3);
    for (int rp = 0; rp < REPS(4); ++rp) { if (rp) xcd_barrier(bar);
    if (IN(4)) {
        pg8::Gemm g{DM}; Sched2 S{F.G, (int)blockIdx.x, (const char*)(F.ws + WS_MIXED), (const char*)(F.ws + WS_WOT)};
        if (F.G == 256) {
            EpiRmsRes E{F.in[0], F.in[19], F.out, (float*)(F.ws + WS_SLOTS), (unsigned*)(F.ws + WS_CTL) + 12288};
            pg8::gemm_phase<EpiRmsRes, Sched2, false, true>(F.lds, g, S, E);
        } else {
            EpiF32 E{(float*)(F.ws + WS_O2), DM};
            pg8::gemm_phase<EpiF32, Sched2, false, true>(F.lds, g, S, E);
        }
    }
    }
    if (F.G != 256) SEAM(4);
    for (int rp = 0; rp < REPS(5); ++rp) { if (rp) xcd_barrier(bar);
    if (IN(5) && F.G != 256) { RETID(); p5_final(F); }
    }
#undef SEAM
#undef IN
}
extern "C" void kernel_launch(void* const* d_in, const int* in_sizes, int n_in, void* d_out, int out_size, void* d_ws, size_t ws_size, hipStream_t stream) {
    static int grid = 0;
    if (grid == 0) {
        if (n_in != 20 || in_sizes[0] != M * DM || out_size != M * DM || ws_size < WS_END) { fprintf(stderr, "kernel_launch: unexpected shapes (n_in %d, ws %zu)\n", n_in, ws_size); grid = -1; return; }
        int dev = 0, cus = 0, per_cu = 0;
        (void)hipGetDevice(&dev); (void)hipDeviceGetAttribute(&cus, hipDeviceAttributeMultiprocessorCount, dev);
        (void)hipFuncSetAttribute((const void*)mega, hipFuncAttributeMaxDynamicSharedMemorySize, LDS_BYTES);
        (void)hipOccupancyMaxActiveBlocksPerMultiprocessor(&per_cu, (const void*)mega, NTHR, LDS_BYTES);
        if (per_cu < 1) { fprintf(stderr, "kernel_launch: occupancy query says %d\n", per_cu); per_cu = 1; }
        (void)hipGetLastError();
        grid = cus * (per_cu < 1 ? 1 : 1);
    }
    if (grid < 0) return;
    unsigned char* ws = (unsigned char*)d_ws;
    Args a{};
    for (int i = 0; i < 20; ++i) a.in[i] = (const float*)d_in[i];
    a.out = (float*)d_out; a.ws = ws;
    if (hipMemsetAsync(ws + WS_CTL, 0, 65536, stream) != hipSuccess) { fprintf(stderr, "kernel_launch: memset failed\n"); return; }
    a.ph_lo = 0; a.ph_hi = 6;
    for (int k = 0; k < 10; ++k) a.rep[k] = 1;
    void* kargs[] = {&a};
    hipError_t e = hipLaunchCooperativeKernel((const void*)mega, dim3(grid), dim3(NTHR), kargs, LDS_BYTES, stream);
    if (e != hipSuccess) fprintf(stderr, "kernel_launch: cooperative launch failed: %s (grid %d)\n", hipGetErrorString(e), grid);
}
```

```cpp
#include <hip/hip_runtime.h>
#include <hip/hip_cooperative_groups.h>
#include <cstdio>
#include <cstdint>
#include <cmath>
namespace pg8 {
#define PG8_LAS __attribute__((address_space(3)))
typedef unsigned short bf16_t;
typedef short bf16x8 __attribute__((ext_vector_type(8)));
typedef float f32x4 __attribute__((ext_vector_type(4)));
typedef unsigned u32x4 __attribute__((ext_vector_type(4)));
constexpr int BM = 256, BK = 64, HALF = 128, HTB = HALF * BK * 2  , STAGE_BYTES = 8 * HTB, NXCD = 8, WGM = 8;

__host__ __device__ __forceinline__ int lds_byte(int r, int c) { const int st = (r >> 4) * 2 + (c >> 5), rr = r & 15, cc = c & 31, ob = rr * 64 + cc * 2; return st * 1024 + (ob ^ (((ob >> 9) & 1) << 5)); }
__host__ __device__ __forceinline__ void stage_rc(int b, int& R, int& C) { const int st = b / 1024, sb = b % 1024, swz = sb ^ (((sb >> 9) & 1) << 5); R = (st >> 1) * 16 + swz / 64; C = (st & 1) * 32 + (swz % 64) / 2; }
__host__ __device__ __forceinline__ int perm32(int rho) { const int n = rho >> 4, i = rho & 15; return 8 * (i >> 2) + 4 * n + (i & 3); }

struct Unit { const char* a; const char* b; int pm, pn, kind; };
struct Gemm { int K; };

__device__ __forceinline__ unsigned cvt_pk_bf16(float lo, float hi) { unsigned r; asm volatile("v_cvt_pk_bf16_f32 %0, %1, %2" : "=v"(r) : "v"(lo), "v"(hi)); return r; }
template <class Epi, class Sched, bool ALIGN_EPI = false, bool SP2 = false>
__device__ __forceinline__ void gemm_phase(PG8_LAS unsigned char* lds, const Gemm g, const Sched& S, const Epi& E) {
    int tid_ = threadIdx.x; asm volatile("" : "+v"(tid_));
    const int tid = tid_, wid = __builtin_amdgcn_readfirstlane(tid >> 6), lane = tid & 63, wr = wid >> 2, wc = wid & 3, fr = lane & 15, fq = lane >> 4;
    const int K = g.K, nt = K / BK;
    unsigned voffA[2], voffB[2];
#pragma unroll
    for (int i = 0; i < 2; ++i) { int R, C; stage_rc(tid * 16 + i * 8192, R, C); const int Rb = Epi::PERM ? ((R & ~31) + perm32(R & 31)) : R;
        voffA[i] = (unsigned)(R * K + C) * 2u; voffB[i] = (unsigned)(Rb * K + C) * 2u; }
    const size_t kstep = (size_t)(BK * 2);
    const size_t hstep = (size_t)HALF * K * 2;
        const unsigned ldsw = (unsigned)wid * 1024u;
    const int aoff = lds_byte(wr * 64 + fr, fq * 8), boff = lds_byte(wc * 32 + fr, fq * 8);
#define PG8_SA(b, h) (((b) * 2 + (h)) * HTB)
#define PG8_SB(b, h) ((4 + (b) * 2 + (h)) * HTB)
#define PG8_STAGE(bufoff, gbase, voff) do { _Pragma("unroll") for (int _i = 0; _i < 2; ++_i) \
        __builtin_amdgcn_global_load_lds((const unsigned*)((const char*)(gbase) + (voff)[_i]), (PG8_LAS unsigned*)(lds + (bufoff) + ldsw + _i * 8192), 16, 0, 0); } while (0)
#define PG8_LDA(dst, b, h) do { _Pragma("unroll") for (int m = 0; m < 4; ++m) _Pragma("unroll") for (int k = 0; k < 2; ++k) dst[m][k] = *(const PG8_LAS bf16x8*)(lds + PG8_SA(b, h) + aoff + m * 2048 + k * 1024); } while (0)
#define PG8_LDB(dst, b, h) do { _Pragma("unroll") for (int n = 0; n < 2; ++n) _Pragma("unroll") for (int k = 0; k < 2; ++k) dst[n][k] = *(const PG8_LAS bf16x8*)(lds + PG8_SB(b, h) + boff + n * 2048 + k * 1024); } while (0)
#define PG8_MMA(ai, bj, At, Bt) do { __builtin_amdgcn_s_setprio(1); _Pragma("unroll") for (int m = 0; m < 4; ++m) _Pragma("unroll") for (int n = 0; n < 2; ++n) _Pragma("unroll") for (int k = 0; k < 2; ++k) \
        acc[ai][bj][m][n] = __builtin_amdgcn_mfma_f32_16x16x32_bf16(Bt[n][k], At[m][k], acc[ai][bj][m][n], 0, 0, 0); __builtin_amdgcn_s_setprio(0); } while (0)
#define PG8_WAIT_V(n) asm volatile("s_waitcnt vmcnt(" #n ")" ::: "memory")
#define PG8_WAIT_L(n) asm volatile("s_waitcnt lgkmcnt(" #n ")" ::: "memory")
#define PG8_BAR __builtin_amdgcn_s_barrier()
#define PG8_SCHED __builtin_amdgcn_sched_barrier(0)
    Unit cur, nxt; int ui = 0;
    if (!S.next(0, cur)) return;
    f32x4 acc[2][2][4][2];
#pragma unroll
    for (int a = 0; a < 2; ++a)
#pragma unroll
        for (int b = 0; b < 2; ++b)
#pragma unroll
            for (int m = 0; m < 4; ++m)
#pragma unroll
                for (int n = 0; n < 2; ++n) acc[a][b][m][n] = (f32x4){0.f, 0.f, 0.f, 0.f};
    bf16x8 At[4][2], B0[2][2], B1[2][2];
    const char* cA = cur.a; const char* cB = cur.b;
    S.a_ready(cur);
    if constexpr (SP2) {
        PG8_STAGE(PG8_SB(0, 0), cB, voffB); PG8_STAGE(PG8_SB(0, 1), cB + hstep, voffB); PG8_STAGE(PG8_SA(0, 0), cA, voffA); PG8_STAGE(PG8_SA(0, 1), cA + hstep, voffA);
        if (wr == 1) PG8_BAR;
        PG8_WAIT_V(2); PG8_BAR;
        PG8_STAGE(PG8_SB(1, 0), cB + kstep, voffB); PG8_STAGE(PG8_SA(1, 0), cA + kstep, voffA); PG8_STAGE(PG8_SB(1, 1), cB + hstep + kstep, voffB);
        PG8_WAIT_V(6); PG8_BAR;
    } else {
        PG8_STAGE(PG8_SB(0, 0), cB, voffB); PG8_STAGE(PG8_SA(0, 0), cA, voffA); PG8_STAGE(PG8_SB(0, 1), cB + hstep, voffB); PG8_STAGE(PG8_SA(0, 1), cA + hstep, voffA);
        if (wr == 1) PG8_BAR;
        PG8_WAIT_V(4); PG8_BAR;
        PG8_STAGE(PG8_SB(1, 0), cB + kstep, voffB); PG8_STAGE(PG8_SA(1, 0), cA + kstep, voffA); PG8_STAGE(PG8_SB(1, 1), cB + hstep + kstep, voffB);
        PG8_WAIT_V(6); PG8_BAR;
    }
    for (;;) {
        const bool has_next = S.next(ui + 1, nxt);
        const char* nA = has_next ? nxt.a : cA; const char* nB = has_next ? nxt.b : cB;
        for (int t = 0; t < nt; t += 2) {
            const bool last = (t == nt - 2);
            const char* a1 = cA + (size_t)(t + 1) * kstep;
            const char* a2 = last ? nA : cA + (size_t)(t + 2) * kstep; const char* b2 = last ? nB : cB + (size_t)(t + 2) * kstep;
            const char* a3 = a2 + kstep; const char* b3 = b2 + kstep;
            if (last && has_next) S.a_ready(nxt);
            if constexpr (SP2) {
            PG8_LDB(B0, 0, 0); PG8_LDB(B1, 0, 1); PG8_SCHED; PG8_LDA(At, 0, 0); PG8_STAGE(PG8_SA(1, 1), a1 + hstep, voffA);
            PG8_WAIT_V(8); PG8_WAIT_L(0); PG8_BAR; PG8_MMA(0, 0, At, B0); PG8_MMA(0, 1, At, B1); PG8_BAR; PG8_SCHED;
            PG8_LDA(At, 0, 1); PG8_STAGE(PG8_SB(0, 0), b2, voffB); PG8_STAGE(PG8_SB(0, 1), b2 + hstep, voffB); PG8_STAGE(PG8_SA(0, 0), a2, voffA);
            PG8_WAIT_V(8); PG8_WAIT_L(0); PG8_BAR; PG8_MMA(1, 0, At, B0); PG8_MMA(1, 1, At, B1); PG8_BAR; PG8_SCHED;
            PG8_LDB(B0, 1, 0); PG8_LDB(B1, 1, 1); PG8_SCHED; PG8_LDA(At, 1, 0); PG8_STAGE(PG8_SA(0, 1), a2 + hstep, voffA);
            PG8_WAIT_V(8); PG8_WAIT_L(0); PG8_BAR; PG8_MMA(0, 0, At, B0); PG8_MMA(0, 1, At, B1); PG8_BAR; PG8_SCHED;
            PG8_LDA(At, 1, 1); PG8_STAGE(PG8_SB(1, 0), b3, voffB); PG8_STAGE(PG8_SB(1, 1), b3 + hstep, voffB); PG8_STAGE(PG8_SA(1, 0), a3, voffA);
            PG8_WAIT_V(8); PG8_WAIT_L(0); PG8_BAR; PG8_MMA(1, 0, At, B0); PG8_MMA(1, 1, At, B1); PG8_BAR; PG8_SCHED;
            } else {
            PG8_LDB(B0, 0, 0); PG8_SCHED; PG8_LDA(At, 0, 0); PG8_STAGE(PG8_SA(1, 1), a1 + hstep, voffA);
            PG8_WAIT_L(8); PG8_BAR; PG8_WAIT_L(0); PG8_MMA(0, 0, At, B0); PG8_BAR; PG8_SCHED;
            PG8_LDB(B1, 0, 1); PG8_STAGE(PG8_SB(0, 0), b2, voffB);
            PG8_BAR; PG8_WAIT_L(0); PG8_MMA(0, 1, At, B1); PG8_BAR;
            PG8_LDA(At, 0, 1); PG8_STAGE(PG8_SA(0, 0), a2, voffA);
            PG8_BAR; PG8_WAIT_L(0); PG8_MMA(1, 0, At, B0); PG8_BAR; PG8_SCHED;
            PG8_STAGE(PG8_SB(0, 1), b2 + hstep, voffB);
            PG8_WAIT_V(6); PG8_BAR; PG8_MMA(1, 1, At, B1); PG8_BAR;
            PG8_LDB(B0, 1, 0); PG8_SCHED; PG8_LDA(At, 1, 0); PG8_STAGE(PG8_SA(0, 1), a2 + hstep, voffA);
            PG8_WAIT_L(8); PG8_BAR; PG8_WAIT_L(0); PG8_MMA(0, 0, At, B0); PG8_BAR; PG8_SCHED;
            PG8_LDB(B1, 1, 1); PG8_STAGE(PG8_SB(1, 0), b3, voffB);
            PG8_BAR; PG8_WAIT_L(0); PG8_MMA(0, 1, At, B1); PG8_BAR;
            PG8_LDA(At, 1, 1); PG8_STAGE(PG8_SA(1, 0), a3, voffA);
            PG8_BAR; PG8_WAIT_L(0); PG8_MMA(1, 0, At, B0); PG8_BAR; PG8_SCHED;
            PG8_STAGE(PG8_SB(1, 1), b3 + hstep, voffB);
            PG8_WAIT_V(6); PG8_BAR; PG8_MMA(1, 1, At, B1); PG8_BAR;
            }
        }
        if constexpr (ALIGN_EPI) { if (wr == 0) PG8_BAR; }
        if constexpr (!Epi::AFTER_DRAIN) { E(acc, cur, wr, wc, fr, fq); S.done(cur); }
        if (!has_next) break;
#pragma unroll
        for (int a = 0; a < 2; ++a)
#pragma unroll
            for (int b = 0; b < 2; ++b)
#pragma unroll
                for (int m = 0; m < 4; ++m)
#pragma unroll
                    for (int n = 0; n < 2; ++n) acc[a][b][m][n] = (f32x4){0.f, 0.f, 0.f, 0.f};
        cur = nxt; cA = nA; cB = nB; ++ui;
        if constexpr (ALIGN_EPI) { if (wr == 1) PG8_BAR; }
    }
    PG8_WAIT_V(0);
    if constexpr (!ALIGN_EPI) { if (wr == 0) PG8_BAR; }
    PG8_BAR;
    if constexpr (Epi::AFTER_DRAIN) { E.fused(acc, cur, wr, wc, fr, fq, lds, wid, lane); S.done(cur); }
#undef PG8_SA
#undef PG8_SB
#undef PG8_STAGE
#undef PG8_LDA
#undef PG8_LDB
#undef PG8_MMA
#undef PG8_WAIT_V
#undef PG8_WAIT_L
#undef PG8_BAR
#undef PG8_SCHED
}
}
constexpr int NWAVES = 8, NTHR = NWAVES * 64;
constexpr int BATCH = 4, SEQ = 2048, DM = 2048, M = BATCH * SEQ, DIN = 6664, MEMLEN = 256, MM = BATCH * MEMLEN;
constexpr int NW1 = 6656;
constexpr float EPS = 1e-6f, LOG2E = 1.4426950408889634f;
constexpr float C2Q = 0.125f * LOG2E;
constexpr float C2X = 0.08838834764831845f * LOG2E;
constexpr float LAMBDA_INIT = 0.2f;
constexpr size_t MiB = 1u << 20;
constexpr size_t WS_CTL = 0, CTL_ZERO_BYTES = 1 * MiB;
constexpr size_t WS_W1T = 1 * MiB, WS_WOT = 27 * MiB, WS_WKVT = 35 * MiB, WS_HN = 39 * MiB, WS_MEMN = 71 * MiB;
constexpr size_t WS_DT = 75 * MiB, WS_ACS = 75 * MiB + 256 * 1024, WS_ROPE = 76 * MiB;
constexpr size_t WS_Q = 78 * MiB, WS_K = 94 * MiB, WS_VT = 110 * MiB, WS_G = 126 * MiB, WS_Z = 142 * MiB, WS_XBC = 150 * MiB, WS_XQ = 166 * MiB, WS_XG = 174 * MiB;
constexpr size_t WS_MK = 182 * MiB, WS_MVT = 183 * MiB, WS_XT = 184 * MiB, WS_BC = 192 * MiB, WS_CS = 200 * MiB, WS_MIXED = 216 * MiB, WS_PREV = 248 * MiB, WS_END = 256 * MiB;
constexpr size_t WS_SLOTS = 75 * MiB + 512 * 1024;
constexpr size_t WS_O2 = 39 * MiB;
constexpr size_t TSTEP = (size_t)256 * DM * 2;

#define GAS __attribute__((address_space(1)))
#define LAS __attribute__((address_space(3)))
typedef unsigned short bf16;
typedef unsigned v4u __attribute__((ext_vector_type(4)));
typedef unsigned v2u __attribute__((ext_vector_type(2)));
typedef float f32x4 __attribute__((ext_vector_type(4)));
typedef float f32x16 __attribute__((ext_vector_type(16)));
typedef short bf16x8 __attribute__((ext_vector_type(8)));
#define LDS_WAIT() asm volatile("s_waitcnt lgkmcnt(0)" ::: "memory")
#define VM_WAIT() asm volatile("s_waitcnt vmcnt(0)" ::: "memory")
__device__ __forceinline__ unsigned f2bf(float f) { unsigned u = __builtin_bit_cast(unsigned, f); return (u + 0x7fffu + ((u >> 16) & 1u)) >> 16; }
__device__ __forceinline__ unsigned pk2(float lo, float hi) { return f2bf(lo) | (f2bf(hi) << 16); }
__device__ __forceinline__ float bf2f(bf16 v) { return __builtin_bit_cast(float, (unsigned)v << 16); }
__device__ __forceinline__ float bflo(unsigned w) { return __builtin_bit_cast(float, w << 16); }
__device__ __forceinline__ float bfhi(unsigned w) { return __builtin_bit_cast(float, w & 0xffff0000u); }
__device__ __forceinline__ float silu_f(float v) { return v / (1.f + __expf(-v)); }
__device__ __forceinline__ float wave_sum(float v) {
#pragma unroll
    for (int o = 1; o < 64; o <<= 1) v += __shfl_xor(v, o);
    return v;
}

struct Frame {
    LAS unsigned char* lds;
    int tid, lane, wave, vcu, G;
    const float* in[20]; float* out; unsigned char* ws;
    unsigned long long tacc[8];
};

__device__ __forceinline__ int w1_src_col(int r) {
    if (r < 2048) { const int p = r & 63, i = p >> 2, j = p & 3; return (r & ~63) + 2 * i + (j & 1) + 32 * (j >> 1); }
    if (r < 3072) return 3072 + (r - 2048);
    if (r < 3584) return 4096 + (r - 3072);
    if (r < 4608) return 4608 + (r - 3584);
    if (r < 5120) return 5640 + (r - 4608);
    if (r < 5632) return 6152 + (r - 5120);
    return 2048 + (r - 5632);
}
struct TItem { const float* src; bf16* dst; int N; };
__device__ __forceinline__ TItem p0_item(const Frame& F, int it, int lane) {
    constexpr int I_1 = (NW1 / 32) * (DM / 64), I_O = (DM / 32) * (DM / 64);
    const float* W; bf16* WT; int N, r = it; bool map = false;
    if (r < I_1) { W = F.in[4]; N = DIN; WT = (bf16*)(F.ws + WS_W1T); map = true; }
    else if (r < I_1 + I_O) { r -= I_1; W = F.in[18]; N = DM; WT = (bf16*)(F.ws + WS_WOT); }
    else { r -= I_1 + I_O; W = F.in[17]; N = 1024; WT = (bf16*)(F.ws + WS_WKVT); }
    const int nb = r >> 5, kb = r & 31, k0 = 64 * kb, n0 = 32 * nb;
    const int sc = map ? w1_src_col(n0 + (lane & 31)) : n0 + (lane & 31);
    TItem t; t.src = W + (size_t)(k0 + (lane >> 5)) * N + sc; t.dst = WT + (size_t)n0 * DM + k0; t.N = N; return t;
}
__device__ __forceinline__ void p0_item_load(float (&tv)[32], const TItem& t) {
#pragma unroll
    for (int i = 0; i < 32; ++i) tv[i] = t.src[(size_t)(2 * i) * t.N];
}
__device__ __forceinline__ void p0_item_store(const float (&tv)[32], const TItem& t, LAS float* scr, int lane) {
#pragma unroll
    for (int i = 0; i < 32; ++i) scr[(2 * i + (lane >> 5)) * 33 + (lane & 31)] = tv[i];
    LDS_WAIT(); asm volatile("" ::: "memory");
    const int c = lane & 7;
#pragma unroll
    for (int j = 0; j < 4; ++j) { const int n = (lane >> 3) + 8 * j; const LAS float* s = scr + (8 * c) * 33 + n;
        v4u o; o.x = pk2(s[0 * 33], s[1 * 33]); o.y = pk2(s[2 * 33], s[3 * 33]); o.z = pk2(s[4 * 33], s[5 * 33]); o.w = pk2(s[6 * 33], s[7 * 33]);
        *(GAS v4u*)(t.dst + (size_t)n * DM + 8 * c) = o; }
    LDS_WAIT(); asm volatile("" ::: "memory");
}
__device__ __forceinline__ void p0_row_load(f32x4 (&v)[8], const Frame& F, int m, int lane) {
    const GAS f32x4* xr = (const GAS f32x4*)((m < M) ? F.in[0] + (size_t)m * DM : F.in[1] + (size_t)(m - M) * DM) + lane;
#pragma unroll
    for (int j = 0; j < 8; ++j) v[j] = xr[64 * j];
}
__device__ __forceinline__ void p0_row_finish(f32x4 (&v)[8], const Frame& F, int m, const LAS float* wdt, int lane) {
    const bool isx = m < M;
    const GAS f32x4* wr = (const GAS f32x4*)(isx ? F.in[3] : F.in[16]) + lane;
    bf16* orow = isx ? (bf16*)(F.ws + WS_HN) + (size_t)m * DM : (bf16*)(F.ws + WS_MEMN) + (size_t)(m - M) * DM;
    float s = 0.f;
#pragma unroll
    for (int j = 0; j < 8; ++j) s += (v[j].x * v[j].x + v[j].y * v[j].y) + (v[j].z * v[j].z + v[j].w * v[j].w);
    const float rstd = rsqrtf(wave_sum(s) * (1.f / DM) + EPS);
    GAS v2u* o8 = (GAS v2u*)orow + lane;
#pragma unroll
    for (int j = 0; j < 8; ++j) { v[j] = v[j] * rstd * wr[64 * j]; v2u o; o.x = pk2(v[j].x, v[j].y); o.y = pk2(v[j].z, v[j].w); o8[64 * j] = o; }
    if (isx) {
        float d[8];
#pragma unroll
        for (int h = 0; h < 8; ++h) { float a = 0.f;
#pragma unroll
            for (int j = 0; j < 8; ++j) { const f32x4 ww = *(const LAS f32x4*)(wdt + h * DM + 4 * (lane + 64 * j)); a += (v[j].x * ww.x + v[j].y * ww.y) + (v[j].z * ww.z + v[j].w * ww.w); }
            d[h] = wave_sum(a); }
        float mine = 0.f;
#pragma unroll
        for (int h = 0; h < 8; ++h) mine = (lane == h) ? d[h] : mine;
        if (lane < 8) { const float r = mine + F.in[12][lane]; ((float*)(F.ws + WS_DT))[(size_t)m * 8 + lane] = (r > 20.f) ? r : log1pf(__expf(r)); }
    }
}
__device__ __forceinline__ void p0_prologue(Frame& F) {
#if PROF
    unsigned long long tlast; asm volatile("s_memtime %0\n\ts_waitcnt lgkmcnt(0)" : "=s"(tlast) :: "memory");
#define PSTAMP(k) do { unsigned long long t_; asm volatile("s_memtime %0\n\ts_waitcnt lgkmcnt(0)" : "=s"(t_) :: "memory"); F.tacc[k] += t_ - tlast; tlast = t_; } while (0)
#else
#define PSTAMP(k) do { } while (0)
#endif
    const int lane = F.lane;
    LAS float* scr = (LAS float*)(F.lds + F.wave * 8448);
    LAS float* wdt = (LAS float*)(F.lds + 69632);
    const int gw = F.vcu * NWAVES + F.wave, NGW = F.G * NWAVES;
    for (int idx = F.tid; idx < DM * 8; idx += NTHR) { const int k = idx >> 3, h = idx & 7; wdt[h * DM + k] = F.in[4][(size_t)k * DIN + 5632 + h]; }
    __syncthreads();
    PSTAMP(0);
    constexpr int NT = (NW1 / 32) * (DM / 64) + (DM / 32) * (DM / 64) + (1024 / 32) * (DM / 64);
    { float ta[32], tb[32]; TItem ia, ib; int it = gw;
      if (it < NT) { ia = p0_item(F, it, lane); p0_item_load(ta, ia); }
      for (; it < NT; it += 2 * NGW) {
          const int n1 = it + NGW, n2 = n1 + NGW;
          if (n1 < NT) { ib = p0_item(F, n1, lane); p0_item_load(tb, ib); }
          p0_item_store(ta, ia, scr, lane);
          if (n2 < NT) { ia = p0_item(F, n2, lane); p0_item_load(ta, ia); }
          if (n1 < NT) p0_item_store(tb, ib, scr, lane);
      } }
    PSTAMP(1);
    { f32x4 va[8], vb[8]; int m = gw; constexpr int NR = M + MM;
      if (m < NR) p0_row_load(va, F, m, lane);
      for (; m < NR; m += 2 * NGW) {
          const int m1 = m + NGW, m2 = m1 + NGW;
          if (m1 < NR) p0_row_load(vb, F, m1, lane);
          p0_row_finish(va, F, m, wdt, lane);
          if (m2 < NR) p0_row_load(va, F, m2, lane);
          if (m1 < NR) p0_row_finish(vb, F, m1, wdt, lane);
      } }
    PSTAMP(2);
    { const int* pos = (const int*)F.in[2]; float* rope = (float*)(F.ws + WS_ROPE);
      for (int idx = (F.vcu * NTHR + F.tid); idx < M * 32; idx += F.G * NTHR) { const int t = idx >> 5, f = idx & 31;
          const float inv = 1.0f / powf(10000.f, (float)(2 * f) / 64.f); const float ang = (float)pos[t] * inv;
          rope[2 * idx] = cosf(ang); rope[2 * idx + 1] = sinf(ang); } }
    PSTAMP(3);
    __syncthreads();
    PSTAMP(4);
}

constexpr int CW_P1DONE = 10240, P1_EARLY_UNITS = 272;
struct Sched1 {
    int G, c; const char *HN, *W1T, *MEMN, *WKVT; unsigned* cnt;
    __device__ __forceinline__ bool next(int i, pg8::Unit& u) const {
        const long L = (long)i * G + c; if (L >= 848) return false;
        if (L < 256) {
            int wgid = (int)L; { const int xcd = wgid % 8, off = wgid / 8; wgid = xcd * 32 + off; }
            const int pm = (wgid / 64) * 8 + ((wgid % 64) % 8), pn = 14 + (wgid % 64) / 8;
            u.kind = 0; u.pm = pm; u.pn = pn; u.a = HN + (size_t)pm * TSTEP; u.b = W1T + (size_t)pn * TSTEP;
        } else if (L < 264) { const int r = (int)L - 256;
            u.kind = 2; u.pm = r & 3; u.pn = r >> 2; u.a = MEMN + (size_t)u.pm * TSTEP; u.b = WKVT + (size_t)u.pn * TSTEP;
        } else if (L < 272) { const int r = (int)L - 264;
            u.kind = 3; u.pm = r & 1; u.pn = r >> 1; u.a = WKVT + (size_t)(2 + u.pm) * TSTEP; u.b = MEMN + (size_t)u.pn * TSTEP;
        } else if (L < 720) {
            int wgid = (int)L - 272; { const int xcd = wgid % 8, off = wgid / 8; wgid = xcd * 56 + off; }
            const int pm = (wgid / 112) * 8 + ((wgid % 112) % 8), pn = (wgid % 112) / 8;
            u.kind = 0; u.pm = pm; u.pn = pn; u.a = HN + (size_t)pm * TSTEP; u.b = W1T + (size_t)pn * TSTEP;
        } else { const int r = (int)L - 720;
            u.kind = 1; u.pm = r & 3; u.pn = r >> 2; u.a = W1T + (size_t)(22 + u.pm) * TSTEP; u.b = HN + (size_t)u.pn * TSTEP; }
        return true;
    }
    __device__ __forceinline__ void a_ready(const pg8::Unit&) const {}
    __device__ __forceinline__ void done(const pg8::Unit& u) const {
        if (u.kind == 2 || u.kind == 3 || (u.kind == 0 && u.pn >= 14)) {
            asm volatile("s_waitcnt vmcnt(0)\n\ts_barrier" ::: "memory");
            if (threadIdx.x == 0) { __builtin_amdgcn_fence(__ATOMIC_RELEASE, "agent"); asm volatile("s_waitcnt vmcnt(0)" ::: "memory");
                __hip_atomic_fetch_add(cnt, 1u, __ATOMIC_RELAXED, __HIP_MEMORY_SCOPE_AGENT); }
        }
    }
};
struct EpiP1 {
    static constexpr bool PERM = true, AFTER_DRAIN = false;
    unsigned char* ws;
    __device__ __forceinline__ void operator()(const pg8::f32x4 (&acc)[2][2][4][2], const pg8::Unit& u, int wr, int wc, int fr, int fq) const {
        bf16* base; int ldc, op = 0, colt; float sc = 1.f;
        if (u.kind == 0) { const int pn = u.pn;
            if (pn < 4) { base = (bf16*)(ws + WS_Q); ldc = 1024; colt = pn * 256; op = 2; sc = C2Q; }
            else if (pn < 8) { base = (bf16*)(ws + WS_K); ldc = 1024; colt = (pn - 4) * 256; op = 2; }
            else if (pn < 12) { base = (bf16*)(ws + WS_G); ldc = 1024; colt = (pn - 8) * 256; op = 1; }
            else if (pn < 14) { base = (bf16*)(ws + WS_Z); ldc = 512; colt = (pn - 12) * 256; op = 1; }
            else if (pn < 18) { base = (bf16*)(ws + WS_XBC); ldc = 1024; colt = (pn - 14) * 256; }
            else if (pn < 20) { base = (bf16*)(ws + WS_XQ); ldc = 512; colt = (pn - 18) * 256; sc = C2X; }
            else { base = (bf16*)(ws + WS_XG); ldc = 512; colt = (pn - 20) * 256; op = 1; }
        } else if (u.kind == 1) { base = (bf16*)(ws + WS_VT); ldc = M; colt = u.pn * 256; }
        else if (u.kind == 2) { base = (bf16*)(ws + WS_MK); ldc = 512; colt = u.pn * 256; }
        else { base = (bf16*)(ws + WS_MVT); ldc = MM; colt = u.pn * 256; }
        const int row0 = u.pm * 256 + wr * 64 + fr, col0 = colt + wc * 32 + 8 * fq;
        const float* rope = (const float*)(ws + WS_ROPE); const int i0 = 8 * (wc & 1) + 2 * fq;
#pragma unroll
        for (int ai = 0; ai < 2; ++ai)
#pragma unroll
            for (int m = 0; m < 4; ++m) { const int row = row0 + ai * 128 + m * 16; bf16* rowp = base + (size_t)row * ldc + col0;
                f32x4 cs0 = {1.f, 0.f, 1.f, 0.f}, cs1 = {1.f, 0.f, 1.f, 0.f};
                if (op == 2) { cs0 = *(const f32x4*)(rope + ((size_t)row * 32 + 2 * i0) * 2); cs1 = *(const f32x4*)(rope + ((size_t)row * 32 + 2 * i0 + 2) * 2); }
#pragma unroll
                for (int bj = 0; bj < 2; ++bj) { f32x4 v0 = acc[ai][bj][m][0], v1 = acc[ai][bj][m][1];
                    if (op == 1) { v0 = (f32x4){silu_f(v0[0]), silu_f(v0[1]), silu_f(v0[2]), silu_f(v0[3])}; v1 = (f32x4){silu_f(v1[0]), silu_f(v1[1]), silu_f(v1[2]), silu_f(v1[3])}; }
                    if (op == 2) {
                        v0 = (f32x4){v0[0] * cs0[0] - v0[2] * cs0[1], v0[1] * cs0[2] - v0[3] * cs0[3], v0[2] * cs0[0] + v0[0] * cs0[1], v0[3] * cs0[2] + v0[1] * cs0[3]};
                        v1 = (f32x4){v1[0] * cs1[0] - v1[2] * cs1[1], v1[1] * cs1[2] - v1[3] * cs1[3], v1[2] * cs1[0] + v1[0] * cs1[1], v1[3] * cs1[2] + v1[1] * cs1[3]}; }
                    v0 = v0 * sc; v1 = v1 * sc;
                    v4u w; w.x = pg8::cvt_pk_bf16(v0[0], v0[1]); w.y = pg8::cvt_pk_bf16(v0[2], v0[3]); w.z = pg8::cvt_pk_bf16(v1[0], v1[1]); w.w = pg8::cvt_pk_bf16(v1[2], v1[3]);
                    *(v4u*)(rowp + bj * 128) = w; } }
    }
};
#define XB_TMO      128
#define XB_XCNT(j)  (256  + 64 * (j))
#define XB_XSUB(j)  (1280 + 64 * (j))
#define XB_XGEN(j)  (2304 + 64 * (j))
#define XB_TOP      3328
#define XB_TOPGEN   3392
#define XCD_BAR_WORDS 3456
#define XB_SPIN_CAP (1u << 18)

__device__ __forceinline__ unsigned xb_ld(unsigned* p)              { return __hip_atomic_load(p, __ATOMIC_RELAXED, __HIP_MEMORY_SCOPE_AGENT); }
__device__ __forceinline__ unsigned xb_add(unsigned* p, unsigned v) { return __hip_atomic_fetch_add(p, v, __ATOMIC_RELAXED, __HIP_MEMORY_SCOPE_AGENT); }
__device__ __forceinline__ unsigned xb_xcc_id() { return (unsigned)__builtin_amdgcn_s_getreg((3 << 11) | 20) & 0xFu; }
#define XB_SPIN(cond, bar) do { unsigned _sp = 0; while (cond) { __builtin_amdgcn_s_sleep(1); \
    if ((++_sp & 255u) == 0u) { if (xb_ld(&(bar)[XB_TMO])) break; if (_sp > XB_SPIN_CAP) { atomicAdd(&(bar)[XB_TMO], 1u); break; } } } } while (0)

struct XcdBarrier {
    unsigned* bar; unsigned x;
    volatile LAS unsigned* st;
};

__device__ __forceinline__ XcdBarrier xcd_barrier_post(unsigned* bar, volatile LAS unsigned* st) {
    XcdBarrier b; b.bar = bar; b.x = xb_xcc_id(); b.st = st;
    if (threadIdx.x == 0) (void)xb_add(&bar[XB_XCNT(b.x)], 1u);
    return b;
}
__device__ __forceinline__ void xcd_barrier_complete(unsigned* bar, unsigned x, unsigned& nloc, unsigned& nx) {
    const unsigned G = gridDim.x * gridDim.y * gridDim.z;
    unsigned sum, cnt, mine, sp = 0u;
    for (;;) {
        sum = 0u; cnt = 0u; mine = 0u;
#pragma unroll
        for (unsigned j = 0; j < 16; ++j) { const unsigned c = xb_ld(&bar[XB_XCNT(j)]); sum += c; cnt += (c > 0u) ? 1u : 0u; mine = (j == x) ? c : mine; }
        if (sum == G) break;
        __builtin_amdgcn_s_sleep(1);
        if ((++sp & 255u) == 0u) { if (xb_ld(&bar[XB_TMO])) break; if (sp > XB_SPIN_CAP) { atomicAdd(&bar[XB_TMO], 1u); break; } }
    }
    nloc = mine > 0u ? mine : 1u; nx = cnt > 0u ? cnt : 1u;
}

__device__ __forceinline__ void xcd_barrier(const XcdBarrier& b) {
    asm volatile("s_waitcnt vmcnt(0)" ::: "memory");
    __syncthreads();
    if (threadIdx.x == 0) {
        unsigned* bar = b.bar;
        __builtin_amdgcn_s_waitcnt(0);
        unsigned nloc = b.st[0], nx = b.st[1];
        if (nloc == 0u) { xcd_barrier_complete(bar, b.x, nloc, nx); b.st[0] = nloc; b.st[1] = nx; }
        const unsigned old = xb_add(&bar[XB_XSUB(b.x)], 1u);
        const unsigned gen = old / nloc;
        if (old + 1u == (gen + 1u) * nloc) {
            __builtin_amdgcn_fence(__ATOMIC_RELEASE, "agent");
            asm volatile("s_waitcnt vmcnt(0)" ::: "memory");
            const unsigned og = xb_add(&bar[XB_TOP], 1u);
            const unsigned tg = og / nx;
            if (og + 1u == (tg + 1u) * nx) xb_add(&bar[XB_TOPGEN], 1u);
            else XB_SPIN(xb_ld(&bar[XB_TOPGEN]) == tg, bar);
            __builtin_amdgcn_fence(__ATOMIC_ACQUIRE, "agent");
            xb_add(&bar[XB_XGEN(b.x)], 1u);
            asm volatile("s_waitcnt vmcnt(0)" ::: "memory");
        } else {
            XB_SPIN(xb_ld(&bar[XB_XGEN(b.x)]) == gen, bar);
            __builtin_amdgcn_fence(__ATOMIC_ACQUIRE, "agent");
            asm volatile("s_waitcnt vmcnt(0)" ::: "memory");
        }
    }
    __syncthreads();
}
namespace att {
#ifndef PROF
#define PROF 0
#endif
#if PROF
#define STAMP(k) do { unsigned long long t_; asm volatile("s_memtime %0\n\ts_waitcnt lgkmcnt(0)" : "=s"(t_) :: "memory"); F_tacc[k] += t_ - tlast; tlast = t_; } while (0)
#else
#define STAMP(k) do { } while (0)
#endif
constexpr int STAGE = 32768;
__device__ __forceinline__ int k_off(int row, int ch) { return row * 256 + ((ch ^ (row & 15)) << 4); }
__device__ __forceinline__ int v_off(int row, int ch) { return 16384 + (row >> 1) * 256 + ((((row & 1) << 3) | (ch ^ ((row >> 1) & 7))) << 4); }
__device__ __forceinline__ int pi32(int i) { return (i & 0x13) | ((i & 4) << 1) | ((i & 8) >> 1); }
__device__ __forceinline__ float other_half(float v) {
    return __shfl_xor(v, 32);
}
__device__ __forceinline__ unsigned cvtpk(float lo, float hi) { typedef float f2 __attribute__((ext_vector_type(2))); typedef __bf16 b2 __attribute__((ext_vector_type(2))); f2 v = {lo, hi}; b2 b = __builtin_convertvector(v, b2); return __builtin_bit_cast(unsigned, b); }
constexpr int NST = 4;
struct Stager {
    const bf16* ks[2]; const bf16* vs[2]; size_t kstep; unsigned kd[2], vd[2];
    __device__ __forceinline__ void init(const bf16* Kp, int ldk, const bf16* VTp, int ldv, int wave, int lane) {
#pragma unroll
        for (int i = 0; i < 2; ++i) { const int pc = wave * 2 + i;
            const int row = 4 * pc + (lane >> 4), ch = (lane & 15) ^ (row & 15);
            ks[i] = Kp + (size_t)row * ldk + ch * 8; kd[i] = pc * 1024;
            const int line = 4 * pc + (lane >> 4), slot = lane & 15, vrow = 2 * line + (slot >> 3), vch = (slot & 7) ^ (line & 7);
            vs[i] = VTp + (size_t)vrow * ldv + vch * 8; vd[i] = 16384 + pc * 1024; }
        kstep = (size_t)64 * ldk;
    }
    __device__ __forceinline__ void issue(LAS unsigned char* lds, int t) const {
        LAS unsigned char* buf = lds + (t & (NST - 1)) * STAGE;
#pragma unroll
        for (int i = 0; i < 2; ++i) {
            __builtin_amdgcn_global_load_lds((const unsigned*)(ks[i] + (size_t)t * kstep), (LAS unsigned*)(buf + kd[i]), 16, 0, 0);
            __builtin_amdgcn_global_load_lds((const unsigned*)(vs[i] + (size_t)t * 64), (LAS unsigned*)(buf + vd[i]), 16, 0, 0); }
    }
};
__device__ __forceinline__ void wait_bar(int ahead) {
    if (ahead >= 2) asm volatile("s_waitcnt vmcnt(8)\n\ts_barrier" ::: "memory");
    else if (ahead == 1) asm volatile("s_waitcnt vmcnt(4)\n\ts_barrier" ::: "memory");
    else asm volatile("s_waitcnt vmcnt(0)\n\ts_barrier" ::: "memory");
}
__device__ __forceinline__ float swap_max(float v) { auto r = __builtin_amdgcn_permlane32_swap(__float_as_uint(v), __float_as_uint(v), false, false); return fmaxf(__uint_as_float(r[0]), __uint_as_float(r[1])); }
__device__ __forceinline__ float swap_sum(float v) { auto r = __builtin_amdgcn_permlane32_swap(__float_as_uint(v), __float_as_uint(v), false, false); return __uint_as_float(r[0]) + __uint_as_float(r[1]); }
template <int KSTEPS, bool CAUSAL>
__device__ __forceinline__ void attn_core(LAS unsigned char* lds, const bf16* Qw, int ldq, const bf16* Kp, int ldk, const bf16* VTp, int ldv, int ntiles, int q0rel, int coff,
                                          f32x16 (&o)[4], float& l_out, int wave, int lane, unsigned long long* F_tacc) {
    const int r32 = lane & 31, hi = lane >> 5; const bool trail = wave >= 4;
#if PROF
    unsigned long long tlast; asm volatile("s_memtime %0\n\ts_waitcnt lgkmcnt(0)" : "=s"(tlast) :: "memory");
#endif
    bf16x8 qf[KSTEPS];
#pragma unroll
    for (int ks = 0; ks < KSTEPS; ++ks) qf[ks] = *(const GAS bf16x8*)(Qw + (size_t)r32 * ldq + ks * 16 + hi * 8);
    Stager sg; sg.init(Kp, ldk, VTp, ldv, wave, lane);
    asm volatile("s_waitcnt vmcnt(0)" ::: "memory");
#pragma unroll
    for (int t = 0; t < NST - 1; ++t) if (t < ntiles) sg.issue(lds, t);
#pragma unroll
    for (int d = 0; d < 4; ++d)
#pragma unroll
        for (int r = 0; r < 16; ++r) o[d][r] = 0.f;
    float mref = 0.f, l = 0.f;
    f32x16 negm;
#pragma unroll
    for (int r = 0; r < 16; ++r) negm[r] = 0.f;
    const int krow = pi32(r32), kch0 = (coff >> 3) + hi;
    STAMP(0);
    if (trail) __builtin_amdgcn_s_setprio(1);
    if (trail) wait_bar(ntiles - 1);
    for (int t = 0; t < ntiles; ++t) {
        if (!trail) wait_bar(ntiles - 1 - t); else asm volatile("s_barrier" ::: "memory");
        STAMP(1);
        if (trail && t + NST - 1 < ntiles) sg.issue(lds, t + NST - 1);
        LAS unsigned char* buf = lds + (t & (NST - 1)) * STAGE;
        const int kv0 = t * 64;
        const bool active = !CAUSAL || (kv0 <= q0rel + 31);
        v4u pw[4]; f32x16 pa, pb;
        if (active) {
            f32x16 p0 = negm, p1 = negm;
#pragma unroll
            for (int kb = 0; kb < KSTEPS; kb += 4) {
                bf16x8 kf[8];
#pragma unroll
                for (int ks = 0; ks < 4; ++ks) { kf[2 * ks] = *(const LAS bf16x8*)(buf + k_off(krow, kch0 + 2 * (kb + ks))); kf[2 * ks + 1] = *(const LAS bf16x8*)(buf + k_off(32 + krow, kch0 + 2 * (kb + ks))); }
                __builtin_amdgcn_sched_barrier(0);
#pragma unroll
                for (int ks = 0; ks < 4; ++ks) {
                    p0 = __builtin_amdgcn_mfma_f32_32x32x16_bf16(kf[2 * ks], qf[kb + ks], p0, 0, 0, 0);
                    p1 = __builtin_amdgcn_mfma_f32_32x32x16_bf16(kf[2 * ks + 1], qf[kb + ks], p1, 0, 0, 0);
                }
            }
            if (CAUSAL && (kv0 + 63 > q0rel)) {
                const int qg = q0rel + r32;
#pragma unroll
                for (int r = 0; r < 16; ++r) { const int kv = kv0 + 16 * (r >> 3) + 8 * hi + (r & 7); if (kv > qg) p0[r] = -INFINITY; if (kv + 32 > qg) p1[r] = -INFINITY; }
            }
            float ra = fmaxf(fmaxf(p0[0], p0[1]), p1[0]), rb = fmaxf(fmaxf(p0[2], p0[3]), p1[1]);
            ra = fmaxf(fmaxf(ra, p1[2]), p1[3]);
#pragma unroll
            for (int r = 4; r < 16; r += 4) { ra = fmaxf(fmaxf(ra, p0[r]), p0[r + 1]); rb = fmaxf(fmaxf(rb, p0[r + 2]), p0[r + 3]); ra = fmaxf(fmaxf(ra, p1[r]), p1[r + 1]); rb = fmaxf(fmaxf(rb, p1[r + 2]), p1[r + 3]); }
            const float rm = swap_max(fmaxf(ra, rb));
            if (t == 0) {
                mref = rm;
#pragma unroll
                for (int r = 0; r < 16; ++r) { p0[r] -= rm; p1[r] -= rm; negm[r] = -rm; }
            } else if (__any(rm > 8.f)) {
                const float dl = fmaxf(rm, 0.f), al = __builtin_amdgcn_exp2f(-dl);
                mref += dl; l *= al;
#pragma unroll
                for (int r = 0; r < 16; ++r) { p0[r] -= dl; p1[r] -= dl; negm[r] = -mref; }
#pragma unroll
                for (int d = 0; d < 4; ++d)
#pragma unroll
                    for (int r = 0; r < 16; ++r) o[d][r] *= al;
            }
#pragma unroll
            for (int r = 0; r < 16; ++r) p0[r] = __builtin_amdgcn_exp2f(p0[r]);
#pragma unroll
            for (int s = 0; s < 2; ++s)
                pw[s] = (v4u){cvtpk(p0[8 * s], p0[8 * s + 1]), cvtpk(p0[8 * s + 2], p0[8 * s + 3]), cvtpk(p0[8 * s + 4], p0[8 * s + 5]), cvtpk(p0[8 * s + 6], p0[8 * s + 7])};
            pa = p0; pb = p1;
        }
        STAMP(2);
        if (!trail) asm volatile("s_barrier" ::: "memory"); else if (t + 1 < ntiles) wait_bar(ntiles - 2 - t); else asm volatile("s_barrier" ::: "memory");
        STAMP(3);
        if (!trail && t + NST - 1 < ntiles) sg.issue(lds, t + NST - 1);
        if (active) {
            bf16x8 vf[8];
#pragma unroll
            for (int ks = 0; ks < 2; ++ks)
#pragma unroll
                for (int d = 0; d < 4; ++d) vf[4 * ks + d] = *(const LAS bf16x8*)(buf + v_off(32 * d + r32, 2 * ks + hi));
            float ls = 0.f;
#pragma unroll
            for (int r = 0; r < 16; ++r) { pb[r] = __builtin_amdgcn_exp2f(pb[r]); ls += pa[r]; }
#pragma unroll
            for (int ks = 0; ks < 2; ++ks)
#pragma unroll
                for (int d = 0; d < 4; ++d) o[d] = __builtin_amdgcn_mfma_f32_32x32x16_bf16(vf[4 * ks + d], __builtin_bit_cast(bf16x8, pw[ks]), o[d], 0, 0, 0);
#pragma unroll
            for (int ks = 2; ks < 4; ++ks)
#pragma unroll
                for (int d = 0; d < 4; ++d) vf[4 * (ks - 2) + d] = *(const LAS bf16x8*)(buf + v_off(32 * d + r32, 2 * ks + hi));
#pragma unroll
            for (int s = 0; s < 2; ++s)
                pw[2 + s] = (v4u){cvtpk(pb[8 * s], pb[8 * s + 1]), cvtpk(pb[8 * s + 2], pb[8 * s + 3]), cvtpk(pb[8 * s + 4], pb[8 * s + 5]), cvtpk(pb[8 * s + 6], pb[8 * s + 7])};
#pragma unroll
            for (int r = 0; r < 16; ++r) ls += pb[r];
            l += ls;
#pragma unroll
            for (int ks = 2; ks < 4; ++ks)
#pragma unroll
                for (int d = 0; d < 4; ++d) o[d] = __builtin_amdgcn_mfma_f32_32x32x16_bf16(vf[4 * (ks - 2) + d], __builtin_bit_cast(bf16x8, pw[ks]), o[d], 0, 0, 0);
        }
        STAMP(4);
    }
    if (!trail) asm volatile("s_barrier" ::: "memory");
    asm volatile("s_waitcnt lgkmcnt(0)\n\ts_barrier" ::: "memory");
    __builtin_amdgcn_s_setprio(0);
    l_out = swap_sum(l);
    STAMP(5);
}
__device__ __forceinline__ int crow(int r, int hi) { return (r & 3) + 8 * (r >> 2) + 4 * hi; }

__device__ __forceinline__ void diff_unit(Frame& F, int b, int h, int qb, float lam) {
    unsigned char* ws = F.ws; int tid_ = F.tid; asm volatile("" : "+v"(tid_)); const int w = F.wave, c = w >> 2, sb = w & 3, lane = tid_ & 63, r32 = lane & 31, hi = lane >> 5;
    const int q0 = qb * 128, q0w = q0 + 32 * sb; const size_t trow0 = (size_t)b * SEQ;
    const bf16* Qw = (const bf16*)(ws + WS_Q) + (trow0 + q0w) * 1024 + h * 128 + c * 64;
    const bf16* Kp = (const bf16*)(ws + WS_K) + trow0 * 1024 + h * 128;
    const bf16* VTp = (const bf16*)(ws + WS_VT) + (size_t)(h * 128) * M + trow0;
    f32x16 o[4]; float l;
#if PROF
    { unsigned long long t_; asm volatile("s_memtime %0\n\ts_waitcnt lgkmcnt(0)" : "=s"(t_) :: "memory"); F.tacc[7] = t_; }
#endif
    attn_core<4, true>(F.lds, Qw, 1024, Kp, 1024, VTp, M, (q0 + 128) / 64, q0w, c * 64, o, l, w, lane, F.tacc);
    const float inv = 1.f / l;
    LAS float* xch = (LAS float*)F.lds + sb * 4096 + lane;
    if (c == 1) {
        const float f = lam * inv;
#pragma unroll
        for (int d = 0; d < 4; ++d)
#pragma unroll
            for (int r = 0; r < 16; ++r) xch[(d * 16 + r) * 64] = o[d][r] * f;
    }
    __syncthreads();
    if (c == 0) {
        float ss = 0.f;
#pragma unroll
        for (int d = 0; d < 4; ++d)
#pragma unroll
            for (int r = 0; r < 16; ++r) { const float v = o[d][r] * inv - xch[(d * 16 + r) * 64]; o[d][r] = v; ss += v * v; }
        ss = swap_sum(ss);
        const float rs = rsqrtf(ss * (1.f / 128.f) + EPS) * (1.f - LAMBDA_INIT);
        const size_t t = trow0 + q0w + r32;
        const bf16* Gp = (const bf16*)(ws + WS_G) + t * 1024 + h * 128; bf16* Op = (bf16*)(ws + WS_MIXED) + t * 2048 + h * 128;
        const float* sw = F.in[9];
#pragma unroll
        for (int d = 0; d < 4; ++d)
#pragma unroll
            for (int rg = 0; rg < 4; ++rg) { const int dv = 32 * d + 8 * rg + 4 * hi;
                const v2u g = *(const GAS v2u*)(Gp + dv); const f32x4 wv = *(const GAS f32x4*)(sw + dv);
                v2u ov; ov.x = pk2(o[d][4 * rg] * rs * wv[0] * bflo(g.x), o[d][4 * rg + 1] * rs * wv[1] * bfhi(g.x));
                ov.y = pk2(o[d][4 * rg + 2] * rs * wv[2] * bflo(g.y), o[d][4 * rg + 3] * rs * wv[3] * bfhi(g.y));
                *(GAS v2u*)(Op + dv) = ov; }
    }
    __syncthreads();
#if PROF
    { unsigned long long t_; asm volatile("s_memtime %0\n\ts_waitcnt lgkmcnt(0)" : "=s"(t_) :: "memory"); F.tacc[6] += t_ - F.tacc[7]; }
#endif
}
__device__ __forceinline__ void xattn_unit(Frame& F, int b, int h, int qb) {
    unsigned char* ws = F.ws; int tid_ = F.tid; asm volatile("" : "+v"(tid_)); const int w = F.wave, lane = tid_ & 63, r32 = lane & 31, hi = lane >> 5;
    const int q0w = qb * 256 + 32 * w; const size_t trow0 = (size_t)b * SEQ;
    const bf16* Qw = (const bf16*)(ws + WS_XQ) + (trow0 + q0w) * 512 + h * 128;
    const bf16* Kp = (const bf16*)(ws + WS_MK) + (size_t)(b * MEMLEN) * 512 + h * 128;
    const bf16* VTp = (const bf16*)(ws + WS_MVT) + (size_t)(h * 128) * MM + b * MEMLEN;
    f32x16 o[4]; float l;
    attn_core<8, false>(F.lds, Qw, 512, Kp, 512, VTp, MM, MEMLEN / 64, 0, 0, o, l, w, lane, F.tacc);
    const float inv = 1.f / l; const size_t t = trow0 + q0w + r32;
    const bf16* Gp = (const bf16*)(ws + WS_XG) + t * 512 + h * 128; bf16* Op = (bf16*)(ws + WS_MIXED) + t * 2048 + 1536 + h * 128;
#pragma unroll
    for (int d = 0; d < 4; ++d)
#pragma unroll
        for (int rg = 0; rg < 4; ++rg) { const int dv = 32 * d + 8 * rg + 4 * hi;
            const v2u g = *(const GAS v2u*)(Gp + dv);
            v2u ov; ov.x = pk2(o[d][4 * rg] * inv * bflo(g.x), o[d][4 * rg + 1] * inv * bfhi(g.x));
            ov.y = pk2(o[d][4 * rg + 2] * inv * bflo(g.y), o[d][4 * rg + 3] * inv * bfhi(g.y));
            *(GAS v2u*)(Op + dv) = ov; }
}
}
namespace ssd {
#if PROF
#define BSTAMP(k) do { unsigned long long t_; asm volatile("s_memtime %0\n\ts_waitcnt lgkmcnt(0)" : "=s"(t_) :: "memory"); F.tacc[k] += t_ - tlast; tlast = t_; } while (0)
#else
#define BSTAMP(k) do { } while (0)
#endif
using att::k_off; using att::pi32; using att::crow; using att::other_half;
__device__ __forceinline__ v4u pack8(const float (&s)[8]) { return (v4u){att::cvtpk(s[0], s[1]), att::cvtpk(s[2], s[3]), att::cvtpk(s[4], s[5]), att::cvtpk(s[6], s[7])}; }
__device__ __forceinline__ void unitA(Frame& F, int b, int c, int g) {
    unsigned char* ws = F.ws; int tid_ = F.tid; asm volatile("" : "+v"(tid_)); const int tid = tid_, lane = tid & 63, w = F.wave, r32 = lane & 31, hi = lane >> 5;
    const size_t t0 = (size_t)b * SEQ + c * 128;
    LAS unsigned char* tile = F.lds;
    LAS float* tab = (LAS float*)(F.lds + 98304);
    const float* DTg = (const float*)(ws + WS_DT); float* ACSg = (float*)(ws + WS_ACS);
    { const int hh = tid >> 7, l = tid & 127, h = g * 4 + hh;
      const float dt = DTg[(t0 + l) * 8 + h]; float v = dt * (-__expf(F.in[13][h]));
#pragma unroll
      for (int o = 1; o < 64; o <<= 1) { const float t = __shfl_up(v, o); if (lane >= o) v += t; }
      if ((w & 1) == 0 && lane == 63) tab[1536 + hh] = v;
      __syncthreads();
      if (w & 1) v += tab[1536 + hh];
      tab[hh * 128 + l] = dt; tab[512 + hh * 128 + l] = v; ACSg[(t0 + l) * 8 + h] = v;
      __syncthreads();
      tab[1024 + hh * 128 + l] = dt * __expf(tab[512 + hh * 128 + 127] - v);
      __syncthreads(); }
    { const int ch = tid; const int col = (ch < 256) ? g * 256 + ch : (ch < 384) ? 512 + g * 128 + (ch - 256) : 768 + g * 128 + (ch - 384);
      const float* cw = F.in[10]; const float w0 = cw[col], w1 = cw[1024 + col], w2 = cw[2048 + col], w3 = cw[3072 + col], bias = F.in[11][col];
      const bf16* src = (const bf16*)(ws + WS_XBC) + t0 * 1024 + col;
      float xx[11]; xx[0] = xx[1] = xx[2] = 0.f;
      if (c > 0) { xx[0] = bf2f(src[-3 * 1024]); xx[1] = bf2f(src[-2 * 1024]); xx[2] = bf2f(src[-1 * 1024]); }
      bf16* XTg = (bf16*)(ws + WS_XT) + ((size_t)(b * 16 + c) * 512 + g * 256 + ch) * 128;
      bf16* BCg = (bf16*)(ws + WS_BC) + t0 * 512 + ((ch < 384) ? g * 128 + (ch - 256) : 256 + g * 128 + (ch - 384));
      const int hh = (ch >> 6) & 3;
#pragma unroll 1
      for (int half = 0; half < 4; ++half) {
          bf16 raw[32];
#pragma unroll
          for (int j = 0; j < 32; ++j) raw[j] = src[(size_t)(half * 32 + j) * 1024];
#pragma unroll
          for (int lq = 0; lq < 4; ++lq) { const int lg = half * 4 + lq;
#pragma unroll
              for (int j = 0; j < 8; ++j) xx[3 + j] = bf2f(raw[lq * 8 + j]);
              float s[8];
#pragma unroll
              for (int j = 0; j < 8; ++j) { const float y = bias + w0 * xx[j] + w1 * xx[j + 1] + w2 * xx[j + 2] + w3 * xx[j + 3]; s[j] = y / (1.f + __expf(-y)); }
              xx[0] = xx[8]; xx[1] = xx[9]; xx[2] = xx[10];
              if (ch < 256) {
                  *(GAS v4u*)(XTg + lg * 8) = pack8(s);
                  const f32x4 wa = *(const LAS f32x4*)(tab + 1024 + hh * 128 + lg * 8), wb = *(const LAS f32x4*)(tab + 1024 + hh * 128 + lg * 8 + 4);
                  float sw[8] = {s[0] * wa[0], s[1] * wa[1], s[2] * wa[2], s[3] * wa[3], s[4] * wb[0], s[5] * wb[1], s[6] * wb[2], s[7] * wb[3]};
                  *(LAS v4u*)(tile + k_off(ch, lg)) = pack8(sw);
              } else {
#pragma unroll
                  for (int j = 0; j < 8; ++j) BCg[(size_t)(lg * 8 + j) * 512] = (bf16)f2bf(s[j]);
                  if (ch < 384) *(LAS v4u*)(tile + k_off(ch, lg)) = pack8(s);
              }
          }
      } }
    __syncthreads();
    { const int hh = w >> 1, nh = w & 1;
      f32x16 acc[2][2];
#pragma unroll
      for (int i = 0; i < 2; ++i)
#pragma unroll
          for (int j = 0; j < 2; ++j)
#pragma unroll
              for (int r = 0; r < 16; ++r) acc[i][j][r] = 0.f;
#pragma unroll
      for (int ks = 0; ks < 8; ++ks) {
          const bf16x8 a0 = *(const LAS bf16x8*)(tile + k_off(hh * 64 + r32, 2 * ks + hi)), a1 = *(const LAS bf16x8*)(tile + k_off(hh * 64 + 32 + r32, 2 * ks + hi));
          const bf16x8 b0 = *(const LAS bf16x8*)(tile + k_off(256 + nh * 64 + r32, 2 * ks + hi)), b1 = *(const LAS bf16x8*)(tile + k_off(256 + nh * 64 + 32 + r32, 2 * ks + hi));
          acc[0][0] = __builtin_amdgcn_mfma_f32_32x32x16_bf16(a0, b0, acc[0][0], 0, 0, 0); acc[0][1] = __builtin_amdgcn_mfma_f32_32x32x16_bf16(a0, b1, acc[0][1], 0, 0, 0);
          acc[1][0] = __builtin_amdgcn_mfma_f32_32x32x16_bf16(a1, b0, acc[1][0], 0, 0, 0); acc[1][1] = __builtin_amdgcn_mfma_f32_32x32x16_bf16(a1, b1, acc[1][1], 0, 0, 0);
      }
      float* cs = (float*)(ws + WS_CS) + (size_t)((b * 16 + c) * 8 + g * 4 + hh) * 8192;
#pragma unroll
      for (int pb = 0; pb < 2; ++pb)
#pragma unroll
          for (int nb = 0; nb < 2; ++nb)
#pragma unroll
              for (int r = 0; r < 16; ++r) cs[(32 * pb + crow(r, hi)) * 128 + nh * 64 + 32 * nb + r32] = acc[pb][nb][r]; }
    __syncthreads();
}

__device__ __forceinline__ void scan_unit(Frame& F, int b, int h, int sl) {
    unsigned char* ws = F.ws; int tid_ = F.tid; asm volatile("" : "+v"(tid_)); const int e = sl * 1024 + 2 * tid_;
    typedef float f32x2 __attribute__((ext_vector_type(2)));
    const float* CSg = (const float*)(ws + WS_CS) + (size_t)(b * 16 * 8 + h) * 8192 + e; const float* ACSg = (const float*)(ws + WS_ACS);
    unsigned* PVg = (unsigned*)((bf16*)(ws + WS_PREV) + (size_t)(b * 16 * 8 + h) * 8192 + e);
    f32x2 v[15]; float dec[15];
#pragma unroll
    for (int c = 0; c < 15; ++c) { v[c] = *(const GAS f32x2*)(CSg + (size_t)c * 8 * 8192); dec[c] = __expf(ACSg[((size_t)b * SEQ + c * 128 + 127) * 8 + h]); }
    f32x2 s = {0.f, 0.f};
#pragma unroll
    for (int c = 0; c < 16; ++c) { PVg[(size_t)c * 8 * 4096] = att::cvtpk(s[0], s[1]); if (c < 15) s = s * dec[c] + v[c]; }
}
__device__ __forceinline__ void scan_publish(Frame& F, int b, int g) {
    asm volatile("s_waitcnt vmcnt(0)" ::: "memory");
    __syncthreads();
    if (F.tid == 0) { __builtin_amdgcn_fence(__ATOMIC_RELEASE, "agent"); asm volatile("s_waitcnt vmcnt(0)" ::: "memory");
        __hip_atomic_fetch_add((unsigned*)(F.ws + WS_CTL) + 8192 + (b * 2 + g) * 64, 1u, __ATOMIC_RELAXED, __HIP_MEMORY_SCOPE_AGENT); }
}
__device__ __forceinline__ void scan_wait(Frame& F, int b, int g) {
    if (F.tid == 0) { unsigned* p = (unsigned*)(F.ws + WS_CTL) + 8192 + (b * 2 + g) * 64; unsigned sp = 0;
        while (__hip_atomic_load(p, __ATOMIC_RELAXED, __HIP_MEMORY_SCOPE_AGENT) < 32u) { __builtin_amdgcn_s_sleep(2); if (++sp > (1u << 22)) break; }
        __builtin_amdgcn_fence(__ATOMIC_ACQUIRE, "agent"); asm volatile("s_waitcnt vmcnt(0)" ::: "memory"); }
    __syncthreads();
}

__device__ __forceinline__ void unitB(Frame& F, int b, int c, int g, int half) {
    unsigned char* ws = F.ws; int tid_ = F.tid; asm volatile("" : "+v"(tid_)); const int tid = tid_, lane = tid & 63, w = F.wave, r32 = lane & 31, hi = lane >> 5;
    const size_t t0 = (size_t)b * SEQ + c * 128;
#if PROF
    unsigned long long tlast; asm volatile("s_memtime %0\n\ts_waitcnt lgkmcnt(0)" : "=s"(tlast) :: "memory");
#endif
    LAS unsigned char* btile = F.lds;
    LAS unsigned char* xtile = F.lds + 32768;
    LAS float* tab = (LAS float*)(F.lds + 98304);
    const float* DTg = (const float*)(ws + WS_DT); const float* ACSg = (const float*)(ws + WS_ACS);
    const bf16* BCg = (const bf16*)(ws + WS_BC) + t0 * 512;
    const bf16* XTg = (const bf16*)(ws + WS_XT) + ((size_t)(b * 16 + c) * 512 + g * 256) * 128;
    if (c > 0) scan_wait(F, b, g);
#pragma unroll
    for (int i = 0; i < 12; ++i) { const int pc = w * 12 + i;
        const int row = 4 * (pc < 32 ? pc : pc - 32) + (lane >> 4), ch = (lane & 15) ^ (row & 15);
        const bf16* src = (pc < 32) ? BCg + (size_t)row * 512 + g * 128 + ch * 8 : XTg + (size_t)row * 128 + ch * 8;
        __builtin_amdgcn_global_load_lds((const unsigned*)src, (LAS unsigned*)(F.lds + pc * 1024), 16, 0, 0); }
    { const int hq = tid >> 7, l = tid & 127; tab[hq * 128 + l] = DTg[(t0 + l) * 8 + g * 4 + hq]; tab[512 + hq * 128 + l] = ACSg[(t0 + l) * 8 + g * 4 + hq]; }
    BSTAMP(0);
    const int lbi = w >> 2, hh = w & 3, lb = half ? (lbi ? 2 : 1) : (lbi ? 3 : 0), l_loc = 32 * lb + r32;
    const bf16* PVg = (const bf16*)(ws + WS_PREV) + (size_t)((b * 16 + c) * 8 + g * 4 + hh) * 8192;
    bf16x8 cf[8];
#pragma unroll
    for (int ks = 0; ks < 8; ++ks) cf[ks] = *(const GAS bf16x8*)(BCg + (size_t)l_loc * 512 + 256 + g * 128 + 16 * ks + 8 * hi);
    const size_t t = t0 + l_loc; const bf16* Zg = (const bf16*)(ws + WS_Z) + t * 512 + g * 256 + hh * 64;
    v2u zq[2][4];
#pragma unroll
    for (int pb = 0; pb < 2; ++pb)
#pragma unroll
        for (int rg = 0; rg < 4; ++rg) zq[pb][rg] = *(const GAS v2u*)(Zg + 32 * pb + 8 * rg + 4 * hi);
    f32x16 acc[2];
    { bf16x8 pf[2][8];
      if (c > 0) {
#pragma unroll
          for (int pb = 0; pb < 2; ++pb)
#pragma unroll
              for (int ks = 0; ks < 8; ++ks) pf[pb][ks] = *(const GAS bf16x8*)(PVg + (32 * pb + r32) * 128 + 16 * ks + 8 * hi);
      }
#pragma unroll
      for (int pb = 0; pb < 2; ++pb) {
#pragma unroll
          for (int r = 0; r < 16; ++r) acc[pb][r] = 0.f;
          if (c > 0) {
#pragma unroll
              for (int ks = 0; ks < 8; ++ks) acc[pb] = __builtin_amdgcn_mfma_f32_32x32x16_bf16(pf[pb][ks], cf[ks], acc[pb], 0, 0, 0);
              const float e = __expf(ACSg[(t0 + l_loc) * 8 + g * 4 + hh]);
#pragma unroll
              for (int r = 0; r < 16; ++r) acc[pb][r] *= e;
          }
      } }
    BSTAMP(1);
    asm volatile("s_waitcnt vmcnt(0)" ::: "memory"); __syncthreads();
    BSTAMP(2);
    const float acs_l = tab[512 + hh * 128 + l_loc], Dh = F.in[14][g * 4 + hh];
#pragma unroll 1
    for (int sb = 0; sb <= lb; ++sb) {
        f32x16 gt;
#pragma unroll
        for (int r = 0; r < 16; ++r) gt[r] = 0.f;
#pragma unroll
        for (int ks = 0; ks < 8; ++ks) { const bf16x8 bfr = *(const LAS bf16x8*)(btile + k_off(32 * sb + pi32(r32), 2 * ks + hi)); gt = __builtin_amdgcn_mfma_f32_32x32x16_bf16(bfr, cf[ks], gt, 0, 0, 0); }
        float sc[16];
#pragma unroll
        for (int q4 = 0; q4 < 4; ++q4) { const int sbase = 32 * sb + 16 * (q4 >> 1) + 8 * hi + 4 * (q4 & 1);
            const f32x4 as = *(const LAS f32x4*)(tab + 512 + hh * 128 + sbase), ds = *(const LAS f32x4*)(tab + hh * 128 + sbase);
#pragma unroll
            for (int e = 0; e < 4; ++e) { const int r = 4 * q4 + e; float v = gt[r] * __builtin_amdgcn_exp2f(fminf(acs_l - as[e], 0.f) * LOG2E) * ds[e];
                if (sb == lb) { const int sl = 16 * (r >> 3) + 8 * hi + (r & 7); if (sl > r32) v = 0.f; if (sl == r32) v += Dh; }
                sc[r] = v; } }
        v4u scb[2];
        scb[0] = (v4u){att::cvtpk(sc[0], sc[1]), att::cvtpk(sc[2], sc[3]), att::cvtpk(sc[4], sc[5]), att::cvtpk(sc[6], sc[7])};
        scb[1] = (v4u){att::cvtpk(sc[8], sc[9]), att::cvtpk(sc[10], sc[11]), att::cvtpk(sc[12], sc[13]), att::cvtpk(sc[14], sc[15])};
#pragma unroll
        for (int pb = 0; pb < 2; ++pb)
#pragma unroll
            for (int k2 = 0; k2 < 2; ++k2) { const bf16x8 xf = *(const LAS bf16x8*)(xtile + k_off(hh * 64 + 32 * pb + r32, 4 * sb + 2 * k2 + hi));
                acc[pb] = __builtin_amdgcn_mfma_f32_32x32x16_bf16(xf, __builtin_bit_cast(bf16x8, scb[k2]), acc[pb], 0, 0, 0); }
    }
    BSTAMP(3);
    const float* nw = F.in[15] + g * 256 + hh * 64;
    f32x4 wv[2][4];
#pragma unroll
    for (int pb = 0; pb < 2; ++pb)
#pragma unroll
        for (int rg = 0; rg < 4; ++rg) wv[pb][rg] = *(const GAS f32x4*)(nw + 32 * pb + 8 * rg + 4 * hi);
    float ss = 0.f;
#pragma unroll
    for (int pb = 0; pb < 2; ++pb)
#pragma unroll
        for (int rg = 0; rg < 4; ++rg) { const v2u z = zq[pb][rg];
            const float y0 = acc[pb][4 * rg] * bflo(z.x), y1 = acc[pb][4 * rg + 1] * bfhi(z.x), y2 = acc[pb][4 * rg + 2] * bflo(z.y), y3 = acc[pb][4 * rg + 3] * bfhi(z.y);
            acc[pb][4 * rg] = y0; acc[pb][4 * rg + 1] = y1; acc[pb][4 * rg + 2] = y2; acc[pb][4 * rg + 3] = y3;
            ss += (y0 * y0 + y1 * y1) + (y2 * y2 + y3 * y3); }
    ss = att::swap_sum(ss);
    if (hi == 0) tab[1024 + hh * 128 + l_loc] = ss;
    __syncthreads();
    const float rs = rsqrtf(((tab[1024 + l_loc] + tab[1024 + 128 + l_loc]) + (tab[1024 + 256 + l_loc] + tab[1024 + 384 + l_loc])) * (1.f / 256.f) + EPS);
    bf16* Og = (bf16*)(ws + WS_MIXED) + t * 2048 + 1024 + g * 256 + hh * 64;
#pragma unroll
    for (int pb = 0; pb < 2; ++pb)
#pragma unroll
        for (int rg = 0; rg < 4; ++rg) { const f32x4 wq = wv[pb][rg];
            v2u o; o.x = pk2(acc[pb][4 * rg] * rs * wq[0], acc[pb][4 * rg + 1] * rs * wq[1]); o.y = pk2(acc[pb][4 * rg + 2] * rs * wq[2], acc[pb][4 * rg + 3] * rs * wq[3]);
            *(GAS v2u*)(Og + 32 * pb + 8 * rg + 4 * hi) = o; }
    asm volatile("s_waitcnt lgkmcnt(0)\n\ts_barrier" ::: "memory");
    BSTAMP(4);
}
}
struct Sched2 {
    int G, c; const char *A, *B;
    __device__ __forceinline__ bool next(int i, pg8::Unit& u) const {
        const long L = (long)i * G + c; if (L >= 256) return false;
        int wgid = (int)L; { const int xcd = wgid % 8, off = wgid / 8; wgid = xcd * 32 + off; }
        u.pm = (wgid / 64) * 8 + ((wgid % 64) % 8); u.pn = (wgid % 64) / 8; u.kind = 0;
        u.a = A + (size_t)u.pm * TSTEP; u.b = B + (size_t)u.pn * TSTEP; return true;
    }
    __device__ __forceinline__ void a_ready(const pg8::Unit&) const {}
    __device__ __forceinline__ void done(const pg8::Unit&) const {}
};
struct EpiF32 {
    static constexpr bool PERM = false, AFTER_DRAIN = false;
    float* O; int ldc;
    __device__ __forceinline__ void operator()(const pg8::f32x4 (&acc)[2][2][4][2], const pg8::Unit& u, int wr, int wc, int fr, int fq) const {
        const int row0 = u.pm * 256 + wr * 64 + fr, col0 = u.pn * 256 + wc * 32 + 4 * fq;
#pragma unroll
        for (int ai = 0; ai < 2; ++ai)
#pragma unroll
            for (int m = 0; m < 4; ++m) { float* rowp = O + (size_t)(row0 + ai * 128 + m * 16) * ldc + col0;
#pragma unroll
                for (int bj = 0; bj < 2; ++bj)
#pragma unroll
                    for (int n = 0; n < 2; ++n) *(pg8::f32x4*)(rowp + bj * 128 + n * 16) = acc[ai][bj][m][n]; }
    }
};

struct EpiRmsRes {
    static constexpr bool PERM = false, AFTER_DRAIN = true;
    const float* x; const float* w; float* out; float* slots; unsigned* cnt;
    __device__ __forceinline__ void fused(pg8::f32x4 (&acc)[2][2][4][2], const pg8::Unit& u, int wr, int wc, int fr, int fq, PG8_LAS unsigned char* lds, int wid, int lane) const {
        PG8_LAS float* P = (PG8_LAS float*)lds;
        PG8_LAS float* S = (PG8_LAS float*)(lds + 4096);
#pragma unroll
        for (int ai = 0; ai < 2; ++ai)
#pragma unroll
            for (int m = 0; m < 4; ++m) { float s = 0.f;
#pragma unroll
                for (int bj = 0; bj < 2; ++bj)
#pragma unroll
                    for (int n = 0; n < 2; ++n) { const pg8::f32x4 v = acc[ai][bj][m][n]; s += (v[0] * v[0] + v[1] * v[1]) + (v[2] * v[2] + v[3] * v[3]); }
                s += __shfl_xor(s, 16); s += __shfl_xor(s, 32);
                if (fq == 0) P[(ai * 128 + wr * 64 + m * 16 + fr) * 4 + wc] = s; }
        asm volatile("s_waitcnt lgkmcnt(0)" ::: "memory"); __builtin_amdgcn_s_barrier(); asm volatile("" ::: "memory");
        const int row = wid * 32 + (lane & 31);
        if (lane < 32) { const float t = (P[row * 4] + P[row * 4 + 1]) + (P[row * 4 + 2] + P[row * 4 + 3]);
            __hip_atomic_store(slots + (size_t)(u.pm * 256 + row) * 8 + u.pn, t, __ATOMIC_RELAXED, __HIP_MEMORY_SCOPE_AGENT); }
        asm volatile("s_waitcnt vmcnt(0)" ::: "memory");
        if (lane == 0) __hip_atomic_fetch_add(cnt + 64 * u.pm, 1u, __ATOMIC_RELAXED, __HIP_MEMORY_SCOPE_AGENT);
        if (wid == 0) { unsigned sp = 0;
            while ((unsigned)__builtin_amdgcn_readfirstlane(__hip_atomic_load(cnt + 64 * u.pm, __ATOMIC_RELAXED, __HIP_MEMORY_SCOPE_AGENT)) < 64u) { __builtin_amdgcn_s_sleep(2); if (++sp > (1u << 22)) break; }
            __builtin_amdgcn_fence(__ATOMIC_ACQUIRE, "agent"); }
        asm volatile("s_waitcnt vmcnt(0) lgkmcnt(0)" ::: "memory"); __builtin_amdgcn_s_barrier(); asm volatile("" ::: "memory");
        if (lane < 32) { const float* sl = slots + (size_t)(u.pm * 256 + row) * 8; float t = 0.f;
#pragma unroll
            for (int k = 0; k < 8; ++k) t += __hip_atomic_load(sl + k, __ATOMIC_RELAXED, __HIP_MEMORY_SCOPE_AGENT);
            S[row] = rsqrtf(t * (1.f / DM) + EPS); }
        asm volatile("s_waitcnt lgkmcnt(0)" ::: "memory"); __builtin_amdgcn_s_barrier(); asm volatile("" ::: "memory");
        const int col0 = u.pn * 256 + wc * 32 + 4 * fq;
        pg8::f32x4 wv[2][2];
#pragma unroll
        for (int bj = 0; bj < 2; ++bj)
#pragma unroll
            for (int n = 0; n < 2; ++n) wv[bj][n] = *(const pg8::f32x4*)(w + col0 + bj * 128 + n * 16);
#pragma unroll
        for (int ai = 0; ai < 2; ++ai)
#pragma unroll
            for (int m = 0; m < 4; ++m) { const int r = ai * 128 + wr * 64 + m * 16 + fr; const float rs = S[r]; const size_t off = (size_t)(u.pm * 256 + r) * DM + col0;
#pragma unroll
                for (int bj = 0; bj < 2; ++bj)
#pragma unroll
                    for (int n = 0; n < 2; ++n) { const pg8::f32x4 xv = *(const pg8::f32x4*)(x + off + bj * 128 + n * 16);
                        *(pg8::f32x4*)(out + off + bj * 128 + n * 16) = xv + acc[ai][bj][m][n] * rs * wv[bj][n]; }
                if (m & 1) asm volatile("" ::: "memory"); }
    }
};
__device__ __forceinline__ void p5_final(Frame& F) {
    const int gw = F.vcu * NWAVES + F.wave, NGW = F.G * NWAVES;
    const float* o2 = (const float*)(F.ws + WS_O2); const GAS f32x4* wr = (const GAS f32x4*)F.in[19] + F.lane;
    for (int mrow = gw; mrow < M; mrow += NGW) {
        const GAS f32x4* orow = (const GAS f32x4*)(o2 + (size_t)mrow * DM) + F.lane; const GAS f32x4* xr = (const GAS f32x4*)(F.in[0] + (size_t)mrow * DM) + F.lane;
        GAS f32x4* outr = (GAS f32x4*)(F.out + (size_t)mrow * DM) + F.lane;
        f32x4 v[8]; float s = 0.f;
#pragma unroll
        for (int j = 0; j < 8; ++j) { v[j] = orow[64 * j]; s += (v[j].x * v[j].x + v[j].y * v[j].y) + (v[j].z * v[j].z + v[j].w * v[j].w); }
        const float rstd = rsqrtf(wave_sum(s) * (1.f / DM) + EPS);
#pragma unroll
        for (int j = 0; j < 8; ++j) outr[64 * j] = xr[64 * j] + v[j] * rstd * wr[64 * j];
    }
}
constexpr int LDS_BYTES = 147456;
struct Args { const float* in[20]; float* out; unsigned char* ws; int ph_lo, ph_hi; int rep[10]; };
__global__ void __launch_bounds__(NTHR, 2) mega(Args args) {
    extern __shared__ __attribute__((aligned(16))) unsigned char lds[];
    Frame F;
    F.lds = (LAS unsigned char*)lds;
    F.tid = threadIdx.x; F.lane = F.tid & 63; F.wave = __builtin_amdgcn_readfirstlane(F.tid >> 6);
    F.G = gridDim.x; { const int bx = blockIdx.x; F.vcu = (F.G % 8 == 0) ? (bx % 8) * (F.G / 8) + bx / 8 : bx; }
#pragma unroll
    for (int i = 0; i < 20; ++i) F.in[i] = args.in[i];
    F.out = args.out; F.ws = args.ws;
#pragma unroll
    for (int i = 0; i < 8; ++i) F.tacc[i] = 0;
    const int lo = args.ph_lo, hi = args.ph_hi;
#define IN(k) (lo <= (k) && (k) < hi)
    volatile LAS unsigned* MISC = (volatile LAS unsigned*)(F.lds + LDS_BYTES - 64);
    if (F.tid < 16) MISC[F.tid] = 0u;
    __syncthreads();
    const XcdBarrier bar = xcd_barrier_post((unsigned*)(F.ws + WS_CTL) + 4096, MISC + 8);
#define SEAM(k) do { if (IN(k) && IN((k) + 1)) xcd_barrier(bar); } while (0)
#define REPS(k) (args.rep[k])
#define RETID() do { int t_ = threadIdx.x; asm volatile("" : "+v"(t_)); F.tid = t_; F.lane = t_ & 63; } while (0)
    for (int rp = 0; rp < REPS(0); ++rp) { if (rp) xcd_barrier(bar);
    if (IN(0)) { RETID(); p0_prologue(F); }
#if PROF
    if (args.rep[9] > 20) { const int sel = args.rep[9] - 20; unsigned long long acc = sel == 1 ? F.tacc[0] : sel == 2 ? F.tacc[1] : sel == 3 ? F.tacc[2] : sel == 4 ? F.tacc[3] : F.tacc[4];
        const unsigned long long t0 = __builtin_amdgcn_s_memtime(); while (__builtin_amdgcn_s_memtime() - t0 < acc) __builtin_amdgcn_s_sleep(4); }
#pragma unroll
    for (int i = 0; i < 8; ++i) F.tacc[i] = 0;
#endif
    }
    SEAM(0);
    for (int rp = 0; rp < REPS(1); ++rp) { if (rp) xcd_barrier(bar);
    if (IN(1)) {
        pg8::Gemm g{DM}; Sched1 S{F.G, (int)blockIdx.x, (const char*)(F.ws + WS_HN), (const char*)(F.ws + WS_W1T), (const char*)(F.ws + WS_MEMN), (const char*)(F.ws + WS_WKVT), (unsigned*)(F.ws + WS_CTL) + CW_P1DONE};
        EpiP1 E{F.ws};
        pg8::gemm_phase<EpiP1, Sched1, true, true>(F.lds, g, S, E);
    }
    }
    const bool overlap = (F.G == 256);
    if (!overlap) SEAM(1);
    for (int rp = 0; rp < REPS(2); ++rp) { if (rp) xcd_barrier(bar);
    if (IN(2)) {
        if (overlap) {
            const int bx = (int)blockIdx.x;
            if (bx >= 80) {
                if (F.tid == 0) { unsigned* p = (unsigned*)(F.ws + WS_CTL) + CW_P1DONE; unsigned sp = 0;
                    while (__hip_atomic_load(p, __ATOMIC_RELAXED, __HIP_MEMORY_SCOPE_AGENT) < (unsigned)P1_EARLY_UNITS * (unsigned)args.rep[1]) { __builtin_amdgcn_s_sleep(4); if (++sp > (1u << 22)) break; }
                    __builtin_amdgcn_fence(__ATOMIC_ACQUIRE, "agent"); asm volatile("s_waitcnt vmcnt(0)" ::: "memory"); }
                __syncthreads();
                for (int u = bx - 80; u < 256; u += 176) { if (u < 128) att::xattn_unit(F, u >> 5, (u >> 3) & 3, u & 7); else { const int v = u - 128; ssd::unitA(F, v >> 5, (v >> 1) & 15, v & 1); } }
            }
        } else
        for (int u = F.vcu; u < 256; u += F.G) { if (u < 128) att::xattn_unit(F, u >> 5, (u >> 3) & 3, u & 7); else { const int v = u - 128; ssd::unitA(F, v >> 5, (v >> 1) & 15, v & 1); } }
    }
    }
    SEAM(2);
    for (int rp = 0; rp < REPS(3); ++rp) { if (rp) xcd_barrier(bar);
    if (IN(3)) {
        const float d1 = wave_sum(F.lane < 64 ? F.in[5][F.lane] * F.in[6][F.lane] : 0.f), d2 = wave_sum(F.in[7][F.lane] * F.in[8][F.lane]);
        const float lam = __expf(d1) - __expf(d2) + LAMBDA_INIT;
        for (int r6 = 0; r6 < args.rep[6]; ++r6)
        for (int v = F.vcu; v < 256; v += F.G) { ssd::scan_unit(F, v >> 6, (v >> 3) & 7, v & 7); ssd::scan_publish(F, v >> 6, (v >> 5) & 1); }
        for (int r7 = 0; r7 < args.rep[7]; ++r7)
        for (int v = F.vcu; v < 256; v += F.G) { const int x = v >> 5, j = v & 31, bh1 = 4 * x + (j >> 4), bh2 = bh1 + 2, s = j & 15;
            att::diff_unit(F, bh1 >> 3, bh1 & 7, s, lam); att::diff_unit(F, bh2 >> 3, bh2 & 7, 15 - s, lam); }
#if PROF
        if (args.rep[9] > 0 && args.rep[9] < 10) { const int sel = args.rep[9]; unsigned long long acc = 0;
            acc = sel == 1 ? F.tacc[0] : sel == 2 ? F.tacc[1] : sel == 3 ? F.tacc[2] : sel == 4 ? F.tacc[3] : sel == 5 ? F.tacc[4] : sel == 6 ? F.tacc[5] : F.tacc[6];
            const unsigned long long t0 = __builtin_amdgcn_s_memtime(); while (__builtin_amdgcn_s_memtime() - t0 < acc) __builtin_amdgcn_s_sleep(4); }
#endif
#if PROF
#pragma unroll
        for (int i = 0; i < 8; ++i) F.tacc[i] = 0;
#endif
        for (int r8 = 0; r8 < args.rep[8]; ++r8)
        for (int v = F.vcu; v < 256; v += F.G) ssd::unitB(F, v >> 6, (v >> 2) & 15, (v >> 1) & 1, v & 1);
#if PROF
        if (args.rep[9] > 10 && args.rep[9] < 20) { const int sel = args.rep[9] - 10; unsigned long long acc = 0;
            acc = sel == 1 ? F.tacc[0] : sel == 2 ? F.tacc[1] : sel == 3 ? F.tacc[2] : sel == 4 ? F.tacc[3] : F.tacc[4];
            const unsigned long long t0 = __builtin_amdgcn_s_memtime(); while (__builtin_amdgcn_s_memtime() - t0 < acc) __builtin_amdgcn_s_sleep(4); }
#endif
    }
    }
    SEAM(3);
    for (int rp = 0; rp < REPS(4); ++rp) { if (rp) xcd_barrier(bar);
    if (IN(4)) {
        pg8::Gemm g{DM}; Sched2 S{F.G, (int)blockIdx.x, (const char*)(F.ws + WS_MIXED), (const char*)(F.ws + WS_WOT)};
        if (F.G == 256) {
            EpiRmsRes E{F.in[0], F.in[19], F.out, (float*)(F.ws + WS_SLOTS), (unsigned*)(F.ws + WS_CTL) + 12288};
            pg8::gemm_phase<EpiRmsRes, Sched2, false, true>(F.lds, g, S, E);
        } else {
            EpiF32 E{(float*)(F.ws + WS_O2), DM};
            pg8::gemm_phase<EpiF32, Sched2, false, true>(F.lds, g, S, E);
        }
    }
    }
    if (F.G != 256) SEAM(4);
    for (int rp = 0; rp < REPS(5); ++rp) { if (rp) xcd_barrier(bar);
    if (IN(5) && F.G != 256) { RETID(); p5_final(F); }
    }
#undef SEAM
#undef IN
}
extern "C" void kernel_launch(void* const* d_in, const int* in_sizes, int n_in, void* d_out, int out_size, void* d_ws, size_t ws_size, hipStream_t stream) {
    static int grid = 0;
    if (grid == 0) {
        if (n_in != 20 || in_sizes[0] != M * DM || out_size != M * DM || ws_size < WS_END) { fprintf(stderr, "kernel_launch: unexpected shapes (n_in %d, ws %zu)\n", n_in, ws_size); grid = -1; return; }
        int dev = 0, cus = 0, per_cu = 0;
        (void)hipGetDevice(&dev); (void)hipDeviceGetAttribute(&cus, hipDeviceAttributeMultiprocessorCount, dev);
        (void)hipFuncSetAttribute((const void*)mega, hipFuncAttributeMaxDynamicSharedMemorySize, LDS_BYTES);
        (void)hipOccupancyMaxActiveBlocksPerMultiprocessor(&per_cu, (const void*)mega, NTHR, LDS_BYTES);
        if (per_cu < 1) { fprintf(stderr, "kernel_launch: occupancy query says %d\n", per_cu); per_cu = 1; }
        (void)hipGetLastError();
        grid = cus * (per_cu < 1 ? 1 : 1);
    }
    if (grid < 0) return;
    unsigned char* ws = (unsigned char*)d_ws;
    Args a{};
    for (int i = 0; i < 20; ++i) a.in[i] = (const float*)d_in[i];
    a.out = (float*)d_out; a.ws = ws;
    if (hipMemsetAsync(ws + WS_CTL, 0, 65536, stream) != hipSuccess) { fprintf(stderr, "kernel_launch: memset failed\n"); return; }
    a.ph_lo = 0; a.ph_hi = 6;
    for (int k = 0; k < 10; ++k) a.rep[k] = 1;
    void* kargs[] = {&a};
    hipError_t e = hipLaunchCooperativeKernel((const void*)mega, dim3(grid), dim3(NTHR), kargs, LDS_BYTES, stream);
    if (e != hipSuccess) fprintf(stderr, "kernel_launch: cooperative launch failed: %s (grid %d)\n", hipGetErrorString(e), grid);
}
```

```cpp
#include <hip/hip_runtime.h>
#include <hip/hip_cooperative_groups.h>
#include <cstdio>
#include <cstdint>
#include <cmath>
namespace pg8 {
#define PG8_LAS __attribute__((address_space(3)))
typedef unsigned short bf16_t;
typedef short bf16x8 __attribute__((ext_vector_type(8)));
typedef float f32x4 __attribute__((ext_vector_type(4)));
typedef unsigned u32x4 __attribute__((ext_vector_type(4)));
constexpr int BM = 256, BK = 64, HALF = 128, HTB = HALF * BK * 2  , STAGE_BYTES = 8 * HTB, NXCD = 8, WGM = 8;

__host__ __device__ __forceinline__ int lds_byte(int r, int c) { const int st = (r >> 4) * 2 + (c >> 5), rr = r & 15, cc = c & 31, ob = rr * 64 + cc * 2; return st * 1024 + (ob ^ (((ob >> 9) & 1) << 5)); }
__host__ __device__ __forceinline__ void stage_rc(int b, int& R, int& C) { const int st = b / 1024, sb = b % 1024, swz = sb ^ (((sb >> 9) & 1) << 5); R = (st >> 1) * 16 + swz / 64; C = (st & 1) * 32 + (swz % 64) / 2; }
__host__ __device__ __forceinline__ int perm32(int rho) { const int n = rho >> 4, i = rho & 15; return 8 * (i >> 2) + 4 * n + (i & 3); }

struct Unit { const char* a; const char* b; int pm, pn, kind; };
struct Gemm { int K; };

__device__ __forceinline__ unsigned cvt_pk_bf16(float lo, float hi) { unsigned r; asm volatile("v_cvt_pk_bf16_f32 %0, %1, %2" : "=v"(r) : "v"(lo), "v"(hi)); return r; }
template <class Epi, class Sched, bool ALIGN_EPI = false, bool SP2 = false>
__device__ __forceinline__ void gemm_phase(PG8_LAS unsigned char* lds, const Gemm g, const Sched& S, const Epi& E) {
    int tid_ = threadIdx.x; asm volatile("" : "+v"(tid_));
    const int tid = tid_, wid = __builtin_amdgcn_readfirstlane(tid >> 6), lane = tid & 63, wr = wid >> 2, wc = wid & 3, fr = lane & 15, fq = lane >> 4;
    const int K = g.K, nt = K / BK;
    unsigned voffA[2], voffB[2];
#pragma unroll
    for (int i = 0; i < 2; ++i) { int R, C; stage_rc(tid * 16 + i * 8192, R, C); const int Rb = Epi::PERM ? ((R & ~31) + perm32(R & 31)) : R;
        voffA[i] = (unsigned)(R * K + C) * 2u; voffB[i] = (unsigned)(Rb * K + C) * 2u; }
    const size_t kstep = (size_t)(BK * 2);
    const size_t hstep = (size_t)HALF * K * 2;
        const unsigned ldsw = (unsigned)wid * 1024u;
    const int aoff = lds_byte(wr * 64 + fr, fq * 8), boff = lds_byte(wc * 32 + fr, fq * 8);
#define PG8_SA(b, h) (((b) * 2 + (h)) * HTB)
#define PG8_SB(b, h) ((4 + (b) * 2 + (h)) * HTB)
#define PG8_STAGE(bufoff, gbase, voff) do { _Pragma("unroll") for (int _i = 0; _i < 2; ++_i) \
        __builtin_amdgcn_global_load_lds((const unsigned*)((const char*)(gbase) + (voff)[_i]), (PG8_LAS unsigned*)(lds + (bufoff) + ldsw + _i * 8192), 16, 0, 0); } while (0)
#define PG8_LDA(dst, b, h) do { _Pragma("unroll") for (int m = 0; m < 4; ++m) _Pragma("unroll") for (int k = 0; k < 2; ++k) dst[m][k] = *(const PG8_LAS bf16x8*)(lds + PG8_SA(b, h) + aoff + m * 2048 + k * 1024); } while (0)
#define PG8_LDB(dst, b, h) do { _Pragma("unroll") for (int n = 0; n < 2; ++n) _Pragma("unroll") for (int k = 0; k < 2; ++k) dst[n][k] = *(const PG8_LAS bf16x8*)(lds + PG8_SB(b, h) + boff + n * 2048 + k * 1024); } while (0)
#define PG8_MMA(ai, bj, At, Bt) do { __builtin_amdgcn_s_setprio(1); _Pragma("unroll") for (int m = 0; m < 4; ++m) _Pragma("unroll") for (int n = 0; n < 2; ++n) _Pragma("unroll") for (int k = 0; k < 2; ++k) \
        acc[ai][bj][m][n] = __builtin_amdgcn_mfma_f32_16x16x32_bf16(Bt[n][k], At[m][k], acc[ai][bj][m][n], 0, 0, 0); __builtin_amdgcn_s_setprio(0); } while (0)
#define PG8_WAIT_V(n) asm volatile("s_waitcnt vmcnt(" #n ")" ::: "memory")
#define PG8_WAIT_L(n) asm volatile("s_waitcnt lgkmcnt(" #n ")" ::: "memory")
#define PG8_BAR __builtin_amdgcn_s_barrier()
#define PG8_SCHED __builtin_amdgcn_sched_barrier(0)
    Unit cur, nxt; int ui = 0;
    if (!S.next(0, cur)) return;
    f32x4 acc[2][2][4][2];
#pragma unroll
    for (int a = 0; a < 2; ++a)
#pragma unroll
        for (int b = 0; b < 2; ++b)
#pragma unroll
            for (int m = 0; m < 4; ++m)
#pragma unroll
                for (int n = 0; n < 2; ++n) acc[a][b][m][n] = (f32x4){0.f, 0.f, 0.f, 0.f};
    bf16x8 At[4][2], B0[2][2], B1[2][2];
    const char* cA = cur.a; const char* cB = cur.b;
    S.a_ready(cur);
    if constexpr (SP2) {
        PG8_STAGE(PG8_SB(0, 0), cB, voffB); PG8_STAGE(PG8_SB(0, 1), cB + hstep, voffB); PG8_STAGE(PG8_SA(0, 0), cA, voffA); PG8_STAGE(PG8_SA(0, 1), cA + hstep, voffA);
        if (wr == 1) PG8_BAR;
        PG8_WAIT_V(2); PG8_BAR;
        PG8_STAGE(PG8_SB(1, 0), cB + kstep, voffB); PG8_STAGE(PG8_SA(1, 0), cA + kstep, voffA); PG8_STAGE(PG8_SB(1, 1), cB + hstep + kstep, voffB);
        PG8_WAIT_V(6); PG8_BAR;
    } else {
        PG8_STAGE(PG8_SB(0, 0), cB, voffB); PG8_STAGE(PG8_SA(0, 0), cA, voffA); PG8_STAGE(PG8_SB(0, 1), cB + hstep, voffB); PG8_STAGE(PG8_SA(0, 1), cA + hstep, voffA);
        if (wr == 1) PG8_BAR;
        PG8_WAIT_V(4); PG8_BAR;
        PG8_STAGE(PG8_SB(1, 0), cB + kstep, voffB); PG8_STAGE(PG8_SA(1, 0), cA + kstep, voffA); PG8_STAGE(PG8_SB(1, 1), cB + hstep + kstep, voffB);
        PG8_WAIT_V(6); PG8_BAR;
    }
    for (;;) {
        const bool has_next = S.next(ui + 1, nxt);
        const char* nA = has_next ? nxt.a : cA; const char* nB = has_next ? nxt.b : cB;
        for (int t = 0; t < nt; t += 2) {
            const bool last = (t == nt - 2);
            const char* a1 = cA + (size_t)(t + 1) * kstep;
            const char* a2 = last ? nA : cA + (size_t)(t + 2) * kstep; const char* b2 = last ? nB : cB + (size_t)(t + 2) * kstep;
            const char* a3 = a2 + kstep; const char* b3 = b2 + kstep;
            if (last && has_next) S.a_ready(nxt);
            if constexpr (SP2) {
            PG8_LDB(B0, 0, 0); PG8_LDB(B1, 0, 1); PG8_SCHED; PG8_LDA(At, 0, 0); PG8_STAGE(PG8_SA(1, 1), a1 + hstep, voffA);
            PG8_WAIT_V(8); PG8_WAIT_L(0); PG8_BAR; PG8_MMA(0, 0, At, B0); PG8_MMA(0, 1, At, B1); PG8_BAR; PG8_SCHED;
            PG8_LDA(At, 0, 1); PG8_STAGE(PG8_SB(0, 0), b2, voffB); PG8_STAGE(PG8_SB(0, 1), b2 + hstep, voffB); PG8_STAGE(PG8_SA(0, 0), a2, voffA);
            PG8_WAIT_V(8); PG8_WAIT_L(0); PG8_BAR; PG8_MMA(1, 0, At, B0); PG8_MMA(1, 1, At, B1); PG8_BAR; PG8_SCHED;
            PG8_LDB(B0, 1, 0); PG8_LDB(B1, 1, 1); PG8_SCHED; PG8_LDA(At, 1, 0); PG8_STAGE(PG8_SA(0, 1), a2 + hstep, voffA);
            PG8_WAIT_V(8); PG8_WAIT_L(0); PG8_BAR; PG8_MMA(0, 0, At, B0); PG8_MMA(0, 1, At, B1); PG8_BAR; PG8_SCHED;
            PG8_LDA(At, 1, 1); PG8_STAGE(PG8_SB(1, 0), b3, voffB); PG8_STAGE(PG8_SB(1, 1), b3 + hstep, voffB); PG8_STAGE(PG8_SA(1, 0), a3, voffA);
            PG8_WAIT_V(8); PG8_WAIT_L(0); PG8_BAR; PG8_MMA(1, 0, At, B0); PG8_MMA(1, 1, At, B1); PG8_BAR; PG8_SCHED;
            } else {
            PG8_LDB(B0, 0, 0); PG8_SCHED; PG8_LDA(At, 0, 0); PG8_STAGE(PG8_SA(1, 1), a1 + hstep, voffA);
            PG8_WAIT_L(8); PG8_BAR; PG8_WAIT_L(0); PG8_MMA(0, 0, At, B0); PG8_BAR; PG8_SCHED;
            PG8_LDB(B1, 0, 1); PG8_STAGE(PG8_SB(0, 0), b2, voffB);
            PG8_BAR; PG8_WAIT_L(0); PG8_MMA(0, 1, At, B1); PG8_BAR;
            PG8_LDA(At, 0, 1); PG8_STAGE(PG8_SA(0, 0), a2, voffA);
            PG8_BAR; PG8_WAIT_L(0); PG8_MMA(1, 0, At, B0); PG8_BAR; PG8_SCHED;
            PG8_STAGE(PG8_SB(0, 1), b2 + hstep, voffB);
            PG8_WAIT_V(6); PG8_BAR; PG8_MMA(1, 1, At, B1); PG8_BAR;
            PG8_LDB(B0, 1, 0); PG8_SCHED; PG8_LDA(At, 1, 0); PG8_STAGE(PG8_SA(0, 1), a2 + hstep, voffA);
            PG8_WAIT_L(8); PG8_BAR; PG8_WAIT_L(0); PG8_MMA(0, 0, At, B0); PG8_BAR; PG8_SCHED;
            PG8_LDB(B1, 1, 1); PG8_STAGE(PG8_SB(1, 0), b3, voffB);
            PG8_BAR; PG8_WAIT_L(0); PG8_MMA(0, 1, At, B1); PG8_BAR;
            PG8_LDA(At, 1, 1); PG8_STAGE(PG8_SA(1, 0), a3, voffA);
            PG8_BAR; PG8_WAIT_L(0); PG8_MMA(1, 0, At, B0); PG8_BAR; PG8_SCHED;
            PG8_STAGE(PG8_SB(1, 1), b3 + hstep, voffB);
            PG8_WAIT_V(6); PG8_BAR; PG8_MMA(1, 1, At, B1); PG8_BAR;
            }
        }
        if constexpr (ALIGN_EPI) { if (wr == 0) PG8_BAR; }
        if constexpr (!Epi::AFTER_DRAIN) { E(acc, cur, wr, wc, fr, fq); S.done(cur); }
        if (!has_next) break;
#pragma unroll
        for (int a = 0; a < 2; ++a)
#pragma unroll
            for (int b = 0; b < 2; ++b)
#pragma unroll
                for (int m = 0; m < 4; ++m)
#pragma unroll
                    for (int n = 0; n < 2; ++n) acc[a][b][m][n] = (f32x4){0.f, 0.f, 0.f, 0.f};
        cur = nxt; cA = nA; cB = nB; ++ui;
        if constexpr (ALIGN_EPI) { if (wr == 1) PG8_BAR; }
    }
    PG8_WAIT_V(0);
    if constexpr (!ALIGN_EPI) { if (wr == 0) PG8_BAR; }
    PG8_BAR;
    if constexpr (Epi::AFTER_DRAIN) { E.fused(acc, cur, wr, wc, fr, fq, lds, wid, lane); S.done(cur); }
#undef PG8_SA
#undef PG8_SB
#undef PG8_STAGE
#undef PG8_LDA
#undef PG8_LDB
#undef PG8_MMA
#undef PG8_WAIT_V
#undef PG8_WAIT_L
#undef PG8_BAR
#undef PG8_SCHED
}
}
constexpr int NWAVES = 8, NTHR = NWAVES * 64;
constexpr int BATCH = 4, SEQ = 2048, DM = 2048, M = BATCH * SEQ, DIN = 6664, MEMLEN = 256, MM = BATCH * MEMLEN;
constexpr int NW1 = 6656;
constexpr float EPS = 1e-6f, LOG2E = 1.4426950408889634f;
constexpr float C2Q = 0.125f * LOG2E;
constexpr float C2X = 0.08838834764831845f * LOG2E;
constexpr float LAMBDA_INIT = 0.2f;
constexpr size_t MiB = 1u << 20;
constexpr size_t WS_CTL = 0, CTL_ZERO_BYTES = 1 * MiB;
constexpr size_t WS_W1T = 1 * MiB, WS_WOT = 27 * MiB, WS_WKVT = 35 * MiB, WS_HN = 39 * MiB, WS_MEMN = 71 * MiB;
constexpr size_t WS_DT = 75 * MiB, WS_ACS = 75 * MiB + 256 * 1024, WS_ROPE = 76 * MiB;
constexpr size_t WS_Q = 78 * MiB, WS_K = 94 * MiB, WS_VT = 110 * MiB, WS_G = 126 * MiB, WS_Z = 142 * MiB, WS_XBC = 150 * MiB, WS_XQ = 166 * MiB, WS_XG = 174 * MiB;
constexpr size_t WS_MK = 182 * MiB, WS_MVT = 183 * MiB, WS_XT = 184 * MiB, WS_BC = 192 * MiB, WS_CS = 200 * MiB, WS_MIXED = 216 * MiB, WS_PREV = 248 * MiB, WS_END = 256 * MiB;
constexpr size_t WS_SLOTS = 75 * MiB + 512 * 1024;
constexpr size_t WS_O2 = 39 * MiB;
constexpr size_t TSTEP = (size_t)256 * DM * 2;

#define GAS __attribute__((address_space(1)))
#define LAS __attribute__((address_space(3)))
typedef unsigned short bf16;
typedef unsigned v4u __attribute__((ext_vector_type(4)));
typedef unsigned v2u __attribute__((ext_vector_type(2)));
typedef float f32x4 __attribute__((ext_vector_type(4)));
typedef float f32x16 __attribute__((ext_vector_type(16)));
typedef short bf16x8 __attribute__((ext_vector_type(8)));
#define LDS_WAIT() asm volatile("s_waitcnt lgkmcnt(0)" ::: "memory")
#define VM_WAIT() asm volatile("s_waitcnt vmcnt(0)" ::: "memory")
__device__ __forceinline__ unsigned f2bf(float f) { unsigned u = __builtin_bit_cast(unsigned, f); return (u + 0x7fffu + ((u >> 16) & 1u)) >> 16; }
__device__ __forceinline__ unsigned pk2(float lo, float hi) { return f2bf(lo) | (f2bf(hi) << 16); }
__device__ __forceinline__ float bf2f(bf16 v) { return __builtin_bit_cast(float, (unsigned)v << 16); }
__device__ __forceinline__ float bflo(unsigned w) { return __builtin_bit_cast(float, w << 16); }
__device__ __forceinline__ float bfhi(unsigned w) { return __builtin_bit_cast(float, w & 0xffff0000u); }
__device__ __forceinline__ float silu_f(float v) { return v / (1.f + __expf(-v)); }
__device__ __forceinline__ float wave_sum(float v) {
#pragma unroll
    for (int o = 1; o < 64; o <<= 1) v += __shfl_xor(v, o);
    return v;
}

struct Frame {
    LAS unsigned char* lds;
    int tid, lane, wave, vcu, G;
    const float* in[20]; float* out; unsigned char* ws;
    unsigned long long tacc[8];
};

__device__ __forceinline__ int w1_src_col(int r) {
    if (r < 2048) { const int p = r & 63, i = p >> 2, j = p & 3; return (r & ~63) + 2 * i + (j & 1) + 32 * (j >> 1); }
    if (r < 3072) return 3072 + (r - 2048);
    if (r < 3584) return 4096 + (r - 3072);
    if (r < 4608) return 4608 + (r - 3584);
    if (r < 5120) return 5640 + (r - 4608);
    if (r < 5632) return 6152 + (r - 5120);
    return 2048 + (r - 5632);
}
struct TItem { const float* src; bf16* dst; int N; };
__device__ __forceinline__ TItem p0_item(const Frame& F, int it, int lane) {
    constexpr int I_1 = (NW1 / 32) * (DM / 64), I_KV = (1024 / 32) * (DM / 64);
    const float* W; bf16* WT; int N, r = it; bool map = false;
    int nblk;
    if (r < I_1) { W = F.in[4]; N = DIN; WT = (bf16*)(F.ws + WS_W1T); map = true; nblk = NW1 / 32; }
    else if (r < I_1 + I_KV) { r -= I_1; W = F.in[17]; N = 1024; WT = (bf16*)(F.ws + WS_WKVT); nblk = 32; }
    else { r -= I_1 + I_KV; W = F.in[18]; N = DM; WT = (bf16*)(F.ws + WS_WOT); nblk = 64; }
    const int kb = r / nblk, nb = r - kb * nblk, k0 = 64 * kb, n0 = 32 * nb;
    const int sc = map ? w1_src_col(n0 + (lane & 31)) : n0 + (lane & 31);
    TItem t; t.src = W + (size_t)(k0 + (lane >> 5)) * N + sc; t.dst = WT + (size_t)n0 * DM + k0; t.N = N; return t;
}
__device__ __forceinline__ void p0_item_load(float (&tv)[32], const TItem& t) {
#pragma unroll
    for (int i = 0; i < 32; ++i) tv[i] = t.src[(size_t)(2 * i) * t.N];
}
__device__ __forceinline__ void p0_item_store(const float (&tv)[32], const TItem& t, LAS float* scr, int lane) {
#pragma unroll
    for (int i = 0; i < 32; ++i) scr[(2 * i + (lane >> 5)) * 33 + (lane & 31)] = tv[i];
    LDS_WAIT(); asm volatile("" ::: "memory");
    const int c = lane & 7;
#pragma unroll
    for (int j = 0; j < 4; ++j) { const int n = (lane >> 3) + 8 * j; const LAS float* s = scr + (8 * c) * 33 + n;
        v4u o; o.x = pk2(s[0 * 33], s[1 * 33]); o.y = pk2(s[2 * 33], s[3 * 33]); o.z = pk2(s[4 * 33], s[5 * 33]); o.w = pk2(s[6 * 33], s[7 * 33]);
        *(GAS v4u*)(t.dst + (size_t)n * DM + 8 * c) = o; }
    LDS_WAIT(); asm volatile("" ::: "memory");
}
__device__ __forceinline__ void p0_row_load(f32x4 (&v)[8], const Frame& F, int m, int lane) {
    const GAS f32x4* xr = (const GAS f32x4*)((m < M) ? F.in[0] + (size_t)m * DM : F.in[1] + (size_t)(m - M) * DM) + lane;
#pragma unroll
    for (int j = 0; j < 8; ++j) v[j] = xr[64 * j];
}
__device__ __forceinline__ void p0_row_finish(f32x4 (&v)[8], const Frame& F, int m, const LAS float* wdt, int lane) {
    const bool isx = m < M;
    const GAS f32x4* wr = (const GAS f32x4*)(isx ? F.in[3] : F.in[16]) + lane;
    bf16* orow = isx ? (bf16*)(F.ws + WS_HN) + (size_t)m * DM : (bf16*)(F.ws + WS_MEMN) + (size_t)(m - M) * DM;
    float s = 0.f;
#pragma unroll
    for (int j = 0; j < 8; ++j) s += (v[j].x * v[j].x + v[j].y * v[j].y) + (v[j].z * v[j].z + v[j].w * v[j].w);
    const float rstd = rsqrtf(wave_sum(s) * (1.f / DM) + EPS);
    GAS v2u* o8 = (GAS v2u*)orow + lane;
#pragma unroll
    for (int j = 0; j < 8; ++j) { v[j] = v[j] * rstd * wr[64 * j]; v2u o; o.x = pk2(v[j].x, v[j].y); o.y = pk2(v[j].z, v[j].w); o8[64 * j] = o; }
    if (isx) {
        float d[8];
#pragma unroll
        for (int h = 0; h < 8; ++h) { float a = 0.f;
#pragma unroll
            for (int j = 0; j < 8; ++j) { const f32x4 ww = *(const LAS f32x4*)(wdt + h * DM + 4 * (lane + 64 * j)); a += (v[j].x * ww.x + v[j].y * ww.y) + (v[j].z * ww.z + v[j].w * ww.w); }
            d[h] = wave_sum(a); }
        float mine = 0.f;
#pragma unroll
        for (int h = 0; h < 8; ++h) mine = (lane == h) ? d[h] : mine;
        if (lane < 8) { const float r = mine + F.in[12][lane]; ((float*)(F.ws + WS_DT))[(size_t)m * 8 + lane] = (r > 20.f) ? r : log1pf(__expf(r)); }
    }
}
constexpr int P0_NT = (NW1 / 32) * (DM / 64) + (1024 / 32) * (DM / 64), P0_NT_ALL = P0_NT + (DM / 32) * (DM / 64);
__device__ __forceinline__ void p0_wot(Frame& F, int wi, int nw_total) {
    LAS float* scr = (LAS float*)(F.lds + F.wave * 8448); float ta[32]; const int lane = F.lane;
    for (int it = P0_NT + wi; it < P0_NT_ALL; it += nw_total) { const TItem ia = p0_item(F, it, lane); p0_item_load(ta, ia); p0_item_store(ta, ia, scr, lane); }
}
__device__ __forceinline__ void p0_wot_chunk(Frame& F, int ci) {
    LAS float* scr = (LAS float*)(F.lds + F.wave * 8448); float ta[32]; const int lane = F.lane;
#pragma unroll 1
    for (int k = 0; k < 2; ++k) { const TItem ia = p0_item(F, P0_NT + ci * 16 + F.wave * 2 + k, lane); p0_item_load(ta, ia); p0_item_store(ta, ia, scr, lane); }
}
__device__ __forceinline__ void p0_prologue(Frame& F) {
#if PROF
    unsigned long long tlast; asm volatile("s_memtime %0\n\ts_waitcnt lgkmcnt(0)" : "=s"(tlast) :: "memory");
#define PSTAMP(k) do { unsigned long long t_; asm volatile("s_memtime %0\n\ts_waitcnt lgkmcnt(0)" : "=s"(t_) :: "memory"); F.tacc[k] += t_ - tlast; tlast = t_; } while (0)
#else
#define PSTAMP(k) do { } while (0)
#endif
    const int lane = F.lane;
    LAS float* scr = (LAS float*)(F.lds + F.wave * 8448);
    LAS float* wdt = (LAS float*)(F.lds + 69632);
    const int gw = F.vcu * NWAVES + F.wave, NGW = F.G * NWAVES;
    for (int idx = F.tid; idx < DM * 8; idx += NTHR) { const int k = idx >> 3, h = idx & 7; wdt[h * DM + k] = F.in[4][(size_t)k * DIN + 5632 + h]; }
    __syncthreads();
    PSTAMP(0);
    constexpr int NT = P0_NT;
    { float ta[32], tb[32]; TItem ia, ib; int it = gw;
      if (it < NT) { ia = p0_item(F, it, lane); p0_item_load(ta, ia); }
      for (; it < NT; it += 2 * NGW) {
          const int n1 = it + NGW, n2 = n1 + NGW;
          if (n1 < NT) { ib = p0_item(F, n1, lane); p0_item_load(tb, ib); }
          p0_item_store(ta, ia, scr, lane);
          if (n2 < NT) { ia = p0_item(F, n2, lane); p0_item_load(ta, ia); }
          if (n1 < NT) p0_item_store(tb, ib, scr, lane);
      } }
    PSTAMP(1);
    { f32x4 va[8], vb[8]; int m = gw; constexpr int NR = M + MM;
      if (m < NR) p0_row_load(va, F, m, lane);
      for (; m < NR; m += 2 * NGW) {
          const int m1 = m + NGW, m2 = m1 + NGW;
          if (m1 < NR) p0_row_load(vb, F, m1, lane);
          p0_row_finish(va, F, m, wdt, lane);
          if (m2 < NR) p0_row_load(va, F, m2, lane);
          if (m1 < NR) p0_row_finish(vb, F, m1, wdt, lane);
      } }
    PSTAMP(2);
    { const int* pos = (const int*)F.in[2]; float* rope = (float*)(F.ws + WS_ROPE);
      for (int idx = (F.vcu * NTHR + F.tid); idx < M * 32; idx += F.G * NTHR) { const int t = idx >> 5, f = idx & 31;
          const float inv = 1.0f / powf(10000.f, (float)(2 * f) / 64.f); const float ang = (float)pos[t] * inv;
          rope[2 * idx] = cosf(ang); rope[2 * idx + 1] = sinf(ang); } }
    PSTAMP(3);
    __syncthreads();
    PSTAMP(4);
}

constexpr int CW_P1DONE = 10240, CW_P2AQ = 10304, CW_P2BQ = 10368  , P1_EARLY_UNITS = 272;
struct Sched1 {
    int G, c; const char *HN, *W1T, *MEMN, *WKVT; unsigned* cnt;
    __device__ __forceinline__ bool next(int i, pg8::Unit& u) const {
        const long L = (long)i * G + c; if (L >= 848) return false;
        if (L < 256) {
            int wgid = (int)L; { const int xcd = wgid % 8, off = wgid / 8; wgid = xcd * 32 + off; }
            const int pm = (wgid / 64) * 8 + ((wgid % 64) % 8), pn = 14 + (wgid % 64) / 8;
            u.kind = 0; u.pm = pm; u.pn = pn; u.a = HN + (size_t)pm * TSTEP; u.b = W1T + (size_t)pn * TSTEP;
        } else if (L < 264) { const int r = (int)L - 256;
            u.kind = 2; u.pm = r & 3; u.pn = r >> 2; u.a = MEMN + (size_t)u.pm * TSTEP; u.b = WKVT + (size_t)u.pn * TSTEP;
        } else if (L < 272) { const int r = (int)L - 264;
            u.kind = 3; u.pm = r & 1; u.pn = r >> 1; u.a = WKVT + (size_t)(2 + u.pm) * TSTEP; u.b = MEMN + (size_t)u.pn * TSTEP;
        } else if (L < 720) {
            int wgid = (int)L - 272; { const int xcd = wgid % 8, off = wgid / 8; wgid = xcd * 56 + off; }
            const int pm = (wgid / 112) * 8 + ((wgid % 112) % 8), pn = (wgid % 112) / 8;
            u.kind = 0; u.pm = pm; u.pn = pn; u.a = HN + (size_t)pm * TSTEP; u.b = W1T + (size_t)pn * TSTEP;
        } else { const int r = (int)L - 720;
            u.kind = 1; u.pm = r & 3; u.pn = r >> 2; u.a = W1T + (size_t)(22 + u.pm) * TSTEP; u.b = HN + (size_t)u.pn * TSTEP; }
        return true;
    }
    __device__ __forceinline__ void a_ready(const pg8::Unit&) const {}
    __device__ __forceinline__ void done(const pg8::Unit& u) const {
        if (u.kind == 2 || u.kind == 3 || (u.kind == 0 && u.pn >= 14)) {
            asm volatile("s_waitcnt vmcnt(0)\n\ts_barrier" ::: "memory");
            if (threadIdx.x == 0) { __builtin_amdgcn_fence(__ATOMIC_RELEASE, "agent"); asm volatile("s_waitcnt vmcnt(0)" ::: "memory");
                __hip_atomic_fetch_add(cnt, 1u, __ATOMIC_RELAXED, __HIP_MEMORY_SCOPE_AGENT); }
        }
    }
};
struct EpiP1 {
    static constexpr bool PERM = true, AFTER_DRAIN = false;
    unsigned char* ws;
    __device__ __forceinline__ void operator()(const pg8::f32x4 (&acc)[2][2][4][2], const pg8::Unit& u, int wr, int wc, int fr, int fq) const {
        bf16* base; int ldc, op = 0, colt; float sc = 1.f;
        if (u.kind == 0) { const int pn = u.pn;
            if (pn < 4) { base = (bf16*)(ws + WS_Q); ldc = 1024; colt = pn * 256; op = 2; sc = C2Q; }
            else if (pn < 8) { base = (bf16*)(ws + WS_K); ldc = 1024; colt = (pn - 4) * 256; op = 2; }
            else if (pn < 12) { base = (bf16*)(ws + WS_G); ldc = 1024; colt = (pn - 8) * 256; op = 1; }
            else if (pn < 14) { base = (bf16*)(ws + WS_Z); ldc = 512; colt = (pn - 12) * 256; op = 1; }
            else if (pn < 18) { base = (bf16*)(ws + WS_XBC); ldc = 1024; colt = (pn - 14) * 256; }
            else if (pn < 20) { base = (bf16*)(ws + WS_XQ); ldc = 512; colt = (pn - 18) * 256; sc = C2X; }
            else { base = (bf16*)(ws + WS_XG); ldc = 512; colt = (pn - 20) * 256; op = 1; }
        } else if (u.kind == 1) { base = (bf16*)(ws + WS_VT); ldc = M; colt = u.pn * 256; }
        else if (u.kind == 2) { base = (bf16*)(ws + WS_MK); ldc = 512; colt = u.pn * 256; }
        else { base = (bf16*)(ws + WS_MVT); ldc = MM; colt = u.pn * 256; }
        const int row0 = u.pm * 256 + wr * 64 + fr, col0 = colt + wc * 32 + 8 * fq;
        const float* rope = (const float*)(ws + WS_ROPE); const int i0 = 8 * (wc & 1) + 2 * fq;
#pragma unroll
        for (int ai = 0; ai < 2; ++ai)
#pragma unroll
            for (int m = 0; m < 4; ++m) { const int row = row0 + ai * 128 + m * 16; bf16* rowp = base + (size_t)row * ldc + col0;
                f32x4 cs0 = {1.f, 0.f, 1.f, 0.f}, cs1 = {1.f, 0.f, 1.f, 0.f};
                if (op == 2) { cs0 = *(const f32x4*)(rope + ((size_t)row * 32 + 2 * i0) * 2); cs1 = *(const f32x4*)(rope + ((size_t)row * 32 + 2 * i0 + 2) * 2); }
#pragma unroll
                for (int bj = 0; bj < 2; ++bj) { f32x4 v0 = acc[ai][bj][m][0], v1 = acc[ai][bj][m][1];
                    if (op == 1) { v0 = (f32x4){silu_f(v0[0]), silu_f(v0[1]), silu_f(v0[2]), silu_f(v0[3])}; v1 = (f32x4){silu_f(v1[0]), silu_f(v1[1]), silu_f(v1[2]), silu_f(v1[3])}; }
                    if (op == 2) {
                        v0 = (f32x4){v0[0] * cs0[0] - v0[2] * cs0[1], v0[1] * cs0[2] - v0[3] * cs0[3], v0[2] * cs0[0] + v0[0] * cs0[1], v0[3] * cs0[2] + v0[1] * cs0[3]};
                        v1 = (f32x4){v1[0] * cs1[0] - v1[2] * cs1[1], v1[1] * cs1[2] - v1[3] * cs1[3], v1[2] * cs1[0] + v1[0] * cs1[1], v1[3] * cs1[2] + v1[1] * cs1[3]}; }
                    v0 = v0 * sc; v1 = v1 * sc;
                    v4u w; w.x = pg8::cvt_pk_bf16(v0[0], v0[1]); w.y = pg8::cvt_pk_bf16(v0[2], v0[3]); w.z = pg8::cvt_pk_bf16(v1[0], v1[1]); w.w = pg8::cvt_pk_bf16(v1[2], v1[3]);
                    *(v4u*)(rowp + bj * 128) = w; } }
    }
};
#define XB_TMO      128
#define XB_XCNT(j)  (256  + 64 * (j))
#define XB_XSUB(j)  (1280 + 64 * (j))
#define XB_XGEN(j)  (2304 + 64 * (j))
#define XB_TOP      3328
#define XB_TOPGEN   3392
#define XCD_BAR_WORDS 3456
#define XB_SPIN_CAP (1u << 18)

__device__ __forceinline__ unsigned xb_ld(unsigned* p)              { return __hip_atomic_load(p, __ATOMIC_RELAXED, __HIP_MEMORY_SCOPE_AGENT); }
__device__ __forceinline__ unsigned xb_add(unsigned* p, unsigned v) { return __hip_atomic_fetch_add(p, v, __ATOMIC_RELAXED, __HIP_MEMORY_SCOPE_AGENT); }
__device__ __forceinline__ unsigned xb_xcc_id() { return (unsigned)__builtin_amdgcn_s_getreg((3 << 11) | 20) & 0xFu; }
#define XB_SPIN(cond, bar) do { unsigned _sp = 0; while (cond) { __builtin_amdgcn_s_sleep(1); \
    if ((++_sp & 255u) == 0u) { if (xb_ld(&(bar)[XB_TMO])) break; if (_sp > XB_SPIN_CAP) { atomicAdd(&(bar)[XB_TMO], 1u); break; } } } } while (0)

struct XcdBarrier {
    unsigned* bar; unsigned x;
    volatile LAS unsigned* st;
};

__device__ __forceinline__ XcdBarrier xcd_barrier_post(unsigned* bar, volatile LAS unsigned* st) {
    XcdBarrier b; b.bar = bar; b.x = xb_xcc_id(); b.st = st;
    if (threadIdx.x == 0) (void)xb_add(&bar[XB_XCNT(b.x)], 1u);
    return b;
}
__device__ __forceinline__ void xcd_barrier_complete(unsigned* bar, unsigned x, unsigned& nloc, unsigned& nx) {
    const unsigned G = gridDim.x * gridDim.y * gridDim.z;
    unsigned sum, cnt, mine, sp = 0u;
    for (;;) {
        sum = 0u; cnt = 0u; mine = 0u;
#pragma unroll
        for (unsigned j = 0; j < 16; ++j) { const unsigned c = xb_ld(&bar[XB_XCNT(j)]); sum += c; cnt += (c > 0u) ? 1u : 0u; mine = (j == x) ? c : mine; }
        if (sum == G) break;
        __builtin_amdgcn_s_sleep(1);
        if ((++sp & 255u) == 0u) { if (xb_ld(&bar[XB_TMO])) break; if (sp > XB_SPIN_CAP) { atomicAdd(&bar[XB_TMO], 1u); break; } }
    }
    nloc = mine > 0u ? mine : 1u; nx = cnt > 0u ? cnt : 1u;
}

__device__ __forceinline__ void xcd_barrier(const XcdBarrier& b) {
    asm volatile("s_waitcnt vmcnt(0)" ::: "memory");
    __syncthreads();
    if (threadIdx.x == 0) {
        unsigned* bar = b.bar;
        __builtin_amdgcn_s_waitcnt(0);
        unsigned nloc = b.st[0], nx = b.st[1];
        if (nloc == 0u) { xcd_barrier_complete(bar, b.x, nloc, nx); b.st[0] = nloc; b.st[1] = nx; }
        const unsigned old = xb_add(&bar[XB_XSUB(b.x)], 1u);
        const unsigned gen = old / nloc;
        if (old + 1u == (gen + 1u) * nloc) {
            __builtin_amdgcn_fence(__ATOMIC_RELEASE, "agent");
            asm volatile("s_waitcnt vmcnt(0)" ::: "memory");
            const unsigned og = xb_add(&bar[XB_TOP], 1u);
            const unsigned tg = og / nx;
            if (og + 1u == (tg + 1u) * nx) xb_add(&bar[XB_TOPGEN], 1u);
            else XB_SPIN(xb_ld(&bar[XB_TOPGEN]) == tg, bar);
            __builtin_amdgcn_fence(__ATOMIC_ACQUIRE, "agent");
            xb_add(&bar[XB_XGEN(b.x)], 1u);
            asm volatile("s_waitcnt vmcnt(0)" ::: "memory");
        } else {
            XB_SPIN(xb_ld(&bar[XB_XGEN(b.x)]) == gen, bar);
            __builtin_amdgcn_fence(__ATOMIC_ACQUIRE, "agent");
            asm volatile("s_waitcnt vmcnt(0)" ::: "memory");
        }
    }
    __syncthreads();
}
namespace att {
#ifndef PROF
#define PROF 0
#endif
#if PROF
#define STAMP(k) do { unsigned long long t_; asm volatile("s_memtime %0\n\ts_waitcnt lgkmcnt(0)" : "=s"(t_) :: "memory"); F_tacc[k] += t_ - tlast; tlast = t_; } while (0)
#else
#define STAMP(k) do { } while (0)
#endif
constexpr int STAGE = 32768;
__device__ __forceinline__ int k_off(int row, int ch) { return row * 256 + ((ch ^ (row & 15)) << 4); }
__device__ __forceinline__ int v_off(int row, int ch) { return 16384 + (row >> 1) * 256 + ((((row & 1) << 3) | (ch ^ ((row >> 1) & 7))) << 4); }
__device__ __forceinline__ int pi32(int i) { return (i & 0x13) | ((i & 4) << 1) | ((i & 8) >> 1); }
__device__ __forceinline__ float other_half(float v) {
    return __shfl_xor(v, 32);
}
__device__ __forceinline__ unsigned cvtpk(float lo, float hi) { typedef float f2 __attribute__((ext_vector_type(2))); typedef __bf16 b2 __attribute__((ext_vector_type(2))); f2 v = {lo, hi}; b2 b = __builtin_convertvector(v, b2); return __builtin_bit_cast(unsigned, b); }
constexpr int NST = 4;
struct Stager {
    const bf16* ks[2]; const bf16* vs[2]; size_t kstep; unsigned kd[2], vd[2];
    __device__ __forceinline__ void init(const bf16* Kp, int ldk, const bf16* VTp, int ldv, int wave, int lane) {
#pragma unroll
        for (int i = 0; i < 2; ++i) { const int pc = wave * 2 + i;
            const int row = 4 * pc + (lane >> 4), ch = (lane & 15) ^ (row & 15);
            ks[i] = Kp + (size_t)row * ldk + ch * 8; kd[i] = pc * 1024;
            const int line = 4 * pc + (lane >> 4), slot = lane & 15, vrow = 2 * line + (slot >> 3), vch = (slot & 7) ^ (line & 7);
            vs[i] = VTp + (size_t)vrow * ldv + vch * 8; vd[i] = 16384 + pc * 1024; }
        kstep = (size_t)64 * ldk;
    }
    __device__ __forceinline__ void issue(LAS unsigned char* lds, int t) const {
        LAS unsigned char* buf = lds + (t & (NST - 1)) * STAGE;
#pragma unroll
        for (int i = 0; i < 2; ++i) {
            __builtin_amdgcn_global_load_lds((const unsigned*)(ks[i] + (size_t)t * kstep), (LAS unsigned*)(buf + kd[i]), 16, 0, 0);
            __builtin_amdgcn_global_load_lds((const unsigned*)(vs[i] + (size_t)t * 64), (LAS unsigned*)(buf + vd[i]), 16, 0, 0); }
    }
};
__device__ __forceinline__ void wait_bar(int ahead) {
    if (ahead >= 2) asm volatile("s_waitcnt vmcnt(8)\n\ts_barrier" ::: "memory");
    else if (ahead == 1) asm volatile("s_waitcnt vmcnt(4)\n\ts_barrier" ::: "memory");
    else asm volatile("s_waitcnt vmcnt(0)\n\ts_barrier" ::: "memory");
}
__device__ __forceinline__ float swap_max(float v) { auto r = __builtin_amdgcn_permlane32_swap(__float_as_uint(v), __float_as_uint(v), false, false); return fmaxf(__uint_as_float(r[0]), __uint_as_float(r[1])); }
__device__ __forceinline__ float swap_sum(float v) { auto r = __builtin_amdgcn_permlane32_swap(__float_as_uint(v), __float_as_uint(v), false, false); return __uint_as_float(r[0]) + __uint_as_float(r[1]); }
template <int KSTEPS, bool CAUSAL>
__device__ __forceinline__ void attn_core(LAS unsigned char* lds, const bf16* Qw, int ldq, const bf16* Kp, int ldk, const bf16* VTp, int ldv, int ntiles, int q0rel, int coff,
                                          f32x16 (&o)[4], float& l_out, int wave, int lane, unsigned long long* F_tacc) {
    const int r32 = lane & 31, hi = lane >> 5; const bool trail = wave >= 4;
#if PROF
    unsigned long long tlast; asm volatile("s_memtime %0\n\ts_waitcnt lgkmcnt(0)" : "=s"(tlast) :: "memory");
#endif
    bf16x8 qf[KSTEPS];
#pragma unroll
    for (int ks = 0; ks < KSTEPS; ++ks) qf[ks] = *(const GAS bf16x8*)(Qw + (size_t)r32 * ldq + ks * 16 + hi * 8);
    Stager sg; sg.init(Kp, ldk, VTp, ldv, wave, lane);
    asm volatile("s_waitcnt vmcnt(0)" ::: "memory");
#pragma unroll
    for (int t = 0; t < NST - 1; ++t) if (t < ntiles) sg.issue(lds, t);
#pragma unroll
    for (int d = 0; d < 4; ++d)
#pragma unroll
        for (int r = 0; r < 16; ++r) o[d][r] = 0.f;
    float mref = 0.f, l = 0.f;
    f32x16 negm;
#pragma unroll
    for (int r = 0; r < 16; ++r) negm[r] = 0.f;
    const int krow = pi32(r32), kch0 = (coff >> 3) + hi;
    STAMP(0);
    if (trail) wait_bar(ntiles - 1);
    for (int t = 0; t < ntiles; ++t) {
        if (!trail) wait_bar(ntiles - 1 - t); else asm volatile("s_barrier" ::: "memory");
        STAMP(1);
        if (trail && t + NST - 1 < ntiles) sg.issue(lds, t + NST - 1);
        LAS unsigned char* buf = lds + (t & (NST - 1)) * STAGE;
        const int kv0 = t * 64;
        const bool active = !CAUSAL || (kv0 <= q0rel + 31);
        v4u pw[4]; f32x16 pa, pb;
        if (active) {
            f32x16 p0 = negm, p1 = negm;
#pragma unroll
            for (int kb = 0; kb < KSTEPS; kb += 4) {
                bf16x8 kf[8];
#pragma unroll
                for (int ks = 0; ks < 4; ++ks) { kf[2 * ks] = *(const LAS bf16x8*)(buf + k_off(krow, kch0 + 2 * (kb + ks))); kf[2 * ks + 1] = *(const LAS bf16x8*)(buf + k_off(32 + krow, kch0 + 2 * (kb + ks))); }
                __builtin_amdgcn_sched_barrier(0);
#pragma unroll
                for (int ks = 0; ks < 4; ++ks) {
                    p0 = __builtin_amdgcn_mfma_f32_32x32x16_bf16(kf[2 * ks], qf[kb + ks], p0, 0, 0, 0);
                    p1 = __builtin_amdgcn_mfma_f32_32x32x16_bf16(kf[2 * ks + 1], qf[kb + ks], p1, 0, 0, 0);
                }
            }
            if (CAUSAL && (kv0 + 63 > q0rel)) {
                const int qg = q0rel + r32;
#pragma unroll
                for (int r = 0; r < 16; ++r) { const int kv = kv0 + 16 * (r >> 3) + 8 * hi + (r & 7); if (kv > qg) p0[r] = -INFINITY; if (kv + 32 > qg) p1[r] = -INFINITY; }
            }
            float ra = fmaxf(fmaxf(p0[0], p0[1]), p1[0]), rb = fmaxf(fmaxf(p0[2], p0[3]), p1[1]);
            ra = fmaxf(fmaxf(ra, p1[2]), p1[3]);
#pragma unroll
            for (int r = 4; r < 16; r += 4) { ra = fmaxf(fmaxf(ra, p0[r]), p0[r + 1]); rb = fmaxf(fmaxf(rb, p0[r + 2]), p0[r + 3]); ra = fmaxf(fmaxf(ra, p1[r]), p1[r + 1]); rb = fmaxf(fmaxf(rb, p1[r + 2]), p1[r + 3]); }
            const float rm = swap_max(fmaxf(ra, rb));
            if (t == 0) {
                mref = rm;
#pragma unroll
                for (int r = 0; r < 16; ++r) { p0[r] -= rm; p1[r] -= rm; negm[r] = -rm; }
            } else if (__any(rm > 8.f)) {
                const float dl = fmaxf(rm, 0.f), al = __builtin_amdgcn_exp2f(-dl);
                mref += dl; l *= al;
#pragma unroll
                for (int r = 0; r < 16; ++r) { p0[r] -= dl; p1[r] -= dl; negm[r] = -mref; }
#pragma unroll
                for (int d = 0; d < 4; ++d)
#pragma unroll
                    for (int r = 0; r < 16; ++r) o[d][r] *= al;
            }
#pragma unroll
            for (int r = 0; r < 16; ++r) p0[r] = __builtin_amdgcn_exp2f(p0[r]);
#pragma unroll
            for (int s = 0; s < 2; ++s)
                pw[s] = (v4u){cvtpk(p0[8 * s], p0[8 * s + 1]), cvtpk(p0[8 * s + 2], p0[8 * s + 3]), cvtpk(p0[8 * s + 4], p0[8 * s + 5]), cvtpk(p0[8 * s + 6], p0[8 * s + 7])};
            pa = p0; pb = p1;
        }
        STAMP(2);
        if (!trail) asm volatile("s_barrier" ::: "memory"); else if (t + 1 < ntiles) wait_bar(ntiles - 2 - t); else asm volatile("s_barrier" ::: "memory");
        STAMP(3);
        if (!trail && t + NST - 1 < ntiles) sg.issue(lds, t + NST - 1);
        if (active) {
            bf16x8 vf[8];
#pragma unroll
            for (int ks = 0; ks < 2; ++ks)
#pragma unroll
                for (int d = 0; d < 4; ++d) vf[4 * ks + d] = *(const LAS bf16x8*)(buf + v_off(32 * d + r32, 2 * ks + hi));
            float ls = 0.f;
#pragma unroll
            for (int r = 0; r < 16; ++r) { pb[r] = __builtin_amdgcn_exp2f(pb[r]); ls += pa[r]; }
#pragma unroll
            for (int ks = 0; ks < 2; ++ks)
#pragma unroll
                for (int d = 0; d < 4; ++d) o[d] = __builtin_amdgcn_mfma_f32_32x32x16_bf16(vf[4 * ks + d], __builtin_bit_cast(bf16x8, pw[ks]), o[d], 0, 0, 0);
#pragma unroll
            for (int ks = 2; ks < 4; ++ks)
#pragma unroll
                for (int d = 0; d < 4; ++d) vf[4 * (ks - 2) + d] = *(const LAS bf16x8*)(buf + v_off(32 * d + r32, 2 * ks + hi));
#pragma unroll
            for (int s = 0; s < 2; ++s)
                pw[2 + s] = (v4u){cvtpk(pb[8 * s], pb[8 * s + 1]), cvtpk(pb[8 * s + 2], pb[8 * s + 3]), cvtpk(pb[8 * s + 4], pb[8 * s + 5]), cvtpk(pb[8 * s + 6], pb[8 * s + 7])};
#pragma unroll
            for (int r = 0; r < 16; ++r) ls += pb[r];
            l += ls;
#pragma unroll
            for (int ks = 2; ks < 4; ++ks)
#pragma unroll
                for (int d = 0; d < 4; ++d) o[d] = __builtin_amdgcn_mfma_f32_32x32x16_bf16(vf[4 * (ks - 2) + d], __builtin_bit_cast(bf16x8, pw[ks]), o[d], 0, 0, 0);
        }
        STAMP(4);
    }
    if (!trail) asm volatile("s_barrier" ::: "memory");
    asm volatile("s_waitcnt lgkmcnt(0)\n\ts_barrier" ::: "memory");
    l_out = swap_sum(l);
    STAMP(5);
}
__device__ __forceinline__ int crow(int r, int hi) { return (r & 3) + 8 * (r >> 2) + 4 * hi; }

__device__ __forceinline__ void diff_unit(Frame& F, int b, int h, int qb, float lam) {
    unsigned char* ws = F.ws; int tid_ = F.tid; asm volatile("" : "+v"(tid_)); const int w = F.wave, c = w >> 2, sb = w & 3, lane = tid_ & 63, r32 = lane & 31, hi = lane >> 5;
    const int q0 = qb * 128, q0w = q0 + 32 * sb; const size_t trow0 = (size_t)b * SEQ;
    const bf16* Qw = (const bf16*)(ws + WS_Q) + (trow0 + q0w) * 1024 + h * 128 + c * 64;
    const bf16* Kp = (const bf16*)(ws + WS_K) + trow0 * 1024 + h * 128;
    const bf16* VTp = (const bf16*)(ws + WS_VT) + (size_t)(h * 128) * M + trow0;
    f32x16 o[4]; float l;
#if PROF
    { unsigned long long t_; asm volatile("s_memtime %0\n\ts_waitcnt lgkmcnt(0)" : "=s"(t_) :: "memory"); F.tacc[7] = t_; }
#endif
    attn_core<4, true>(F.lds, Qw, 1024, Kp, 1024, VTp, M, (q0 + 128) / 64, q0w, c * 64, o, l, w, lane, F.tacc);
    const float inv = 1.f / l;
    LAS float* xch = (LAS float*)F.lds + sb * 4096 + lane;
    if (c == 1) {
        const float f = lam * inv;
#pragma unroll
        for (int d = 0; d < 4; ++d)
#pragma unroll
            for (int r = 0; r < 16; ++r) xch[(d * 16 + r) * 64] = o[d][r] * f;
    }
    __syncthreads();
    if (c == 0) {
        float ss = 0.f;
#pragma unroll
        for (int d = 0; d < 4; ++d)
#pragma unroll
            for (int r = 0; r < 16; ++r) { const float v = o[d][r] * inv - xch[(d * 16 + r) * 64]; o[d][r] = v; ss += v * v; }
        ss = swap_sum(ss);
        const float rs = rsqrtf(ss * (1.f / 128.f) + EPS) * (1.f - LAMBDA_INIT);
        const size_t t = trow0 + q0w + r32;
        const bf16* Gp = (const bf16*)(ws + WS_G) + t * 1024 + h * 128; bf16* Op = (bf16*)(ws + WS_MIXED) + t * 2048 + h * 128;
        const float* sw = F.in[9];
#pragma unroll
        for (int d = 0; d < 4; ++d)
#pragma unroll
            for (int rg = 0; rg < 4; ++rg) { const int dv = 32 * d + 8 * rg + 4 * hi;
                const v2u g = *(const GAS v2u*)(Gp + dv); const f32x4 wv = *(const GAS f32x4*)(sw + dv);
                v2u ov; ov.x = pk2(o[d][4 * rg] * rs * wv[0] * bflo(g.x), o[d][4 * rg + 1] * rs * wv[1] * bfhi(g.x));
                ov.y = pk2(o[d][4 * rg + 2] * rs * wv[2] * bflo(g.y), o[d][4 * rg + 3] * rs * wv[3] * bfhi(g.y));
                *(GAS v2u*)(Op + dv) = ov; }
    }
    __syncthreads();
#if PROF
    { unsigned long long t_; asm volatile("s_memtime %0\n\ts_waitcnt lgkmcnt(0)" : "=s"(t_) :: "memory"); F.tacc[6] += t_ - F.tacc[7]; }
#endif
}
__device__ __forceinline__ void xattn_unit(Frame& F, int b, int h, int qb) {
    unsigned char* ws = F.ws; int tid_ = F.tid; asm volatile("" : "+v"(tid_)); const int w = F.wave, lane = tid_ & 63, r32 = lane & 31, hi = lane >> 5;
    const int q0w = qb * 256 + 32 * w; const size_t trow0 = (size_t)b * SEQ;
    const bf16* Qw = (const bf16*)(ws + WS_XQ) + (trow0 + q0w) * 512 + h * 128;
    const bf16* Kp = (const bf16*)(ws + WS_MK) + (size_t)(b * MEMLEN) * 512 + h * 128;
    const bf16* VTp = (const bf16*)(ws + WS_MVT) + (size_t)(h * 128) * MM + b * MEMLEN;
    f32x16 o[4]; float l;
    attn_core<8, false>(F.lds, Qw, 512, Kp, 512, VTp, MM, MEMLEN / 64, 0, 0, o, l, w, lane, F.tacc);
    const float inv = 1.f / l; const size_t t = trow0 + q0w + r32;
    const bf16* Gp = (const bf16*)(ws + WS_XG) + t * 512 + h * 128; bf16* Op = (bf16*)(ws + WS_MIXED) + t * 2048 + 1536 + h * 128;
#pragma unroll
    for (int d = 0; d < 4; ++d)
#pragma unroll
        for (int rg = 0; rg < 4; ++rg) { const int dv = 32 * d + 8 * rg + 4 * hi;
            const v2u g = *(const GAS v2u*)(Gp + dv);
            v2u ov; ov.x = pk2(o[d][4 * rg] * inv * bflo(g.x), o[d][4 * rg + 1] * inv * bfhi(g.x));
            ov.y = pk2(o[d][4 * rg + 2] * inv * bflo(g.y), o[d][4 * rg + 3] * inv * bfhi(g.y));
            *(GAS v2u*)(Op + dv) = ov; }
}
}
namespace ssd {
#if PROF
#define BSTAMP(k) do { unsigned long long t_; asm volatile("s_memtime %0\n\ts_waitcnt lgkmcnt(0)" : "=s"(t_) :: "memory"); F.tacc[k] += t_ - tlast; tlast = t_; } while (0)
#else
#define BSTAMP(k) do { } while (0)
#endif
using att::k_off; using att::pi32; using att::crow; using att::other_half;
__device__ __forceinline__ v4u pack8(const float (&s)[8]) { return (v4u){att::cvtpk(s[0], s[1]), att::cvtpk(s[2], s[3]), att::cvtpk(s[4], s[5]), att::cvtpk(s[6], s[7])}; }
__device__ __forceinline__ void unitA(Frame& F, int b, int c, int g) {
    unsigned char* ws = F.ws; int tid_ = F.tid; asm volatile("" : "+v"(tid_)); const int tid = tid_, lane = tid & 63, w = F.wave, r32 = lane & 31, hi = lane >> 5;
    const size_t t0 = (size_t)b * SEQ + c * 128;
    LAS unsigned char* tile = F.lds;
    LAS float* tab = (LAS float*)(F.lds + 98304);
    const float* DTg = (const float*)(ws + WS_DT); float* ACSg = (float*)(ws + WS_ACS);
    { const int hh = tid >> 7, l = tid & 127, h = g * 4 + hh;
      const float dt = DTg[(t0 + l) * 8 + h]; float v = dt * (-__expf(F.in[13][h]));
#pragma unroll
      for (int o = 1; o < 64; o <<= 1) { const float t = __shfl_up(v, o); if (lane >= o) v += t; }
      if ((w & 1) == 0 && lane == 63) tab[1536 + hh] = v;
      __syncthreads();
      if (w & 1) v += tab[1536 + hh];
      tab[hh * 128 + l] = dt; tab[512 + hh * 128 + l] = v; ACSg[(t0 + l) * 8 + h] = v;
      __syncthreads();
      tab[1024 + hh * 128 + l] = dt * __expf(tab[512 + hh * 128 + 127] - v);
      __syncthreads(); }
    { const int ch = tid; const int col = (ch < 256) ? g * 256 + ch : (ch < 384) ? 512 + g * 128 + (ch - 256) : 768 + g * 128 + (ch - 384);
      const float* cw = F.in[10]; const float w0 = cw[col], w1 = cw[1024 + col], w2 = cw[2048 + col], w3 = cw[3072 + col], bias = F.in[11][col];
      const bf16* src = (const bf16*)(ws + WS_XBC) + t0 * 1024 + col;
      float xx[11]; xx[0] = xx[1] = xx[2] = 0.f;
      if (c > 0) { xx[0] = bf2f(src[-3 * 1024]); xx[1] = bf2f(src[-2 * 1024]); xx[2] = bf2f(src[-1 * 1024]); }
      bf16* XTg = (bf16*)(ws + WS_XT) + ((size_t)(b * 16 + c) * 512 + g * 256 + ch) * 128;
      bf16* BCg = (bf16*)(ws + WS_BC) + t0 * 512 + ((ch < 384) ? g * 128 + (ch - 256) : 256 + g * 128 + (ch - 384));
      const int hh = (ch >> 6) & 3;
#pragma unroll 1
      for (int half = 0; half < 4; ++half) {
          bf16 raw[32];
#pragma unroll
          for (int j = 0; j < 32; ++j) raw[j] = src[(size_t)(half * 32 + j) * 1024];
#pragma unroll
          for (int lq = 0; lq < 4; ++lq) { const int lg = half * 4 + lq;
#pragma unroll
              for (int j = 0; j < 8; ++j) xx[3 + j] = bf2f(raw[lq * 8 + j]);
              float s[8];
#pragma unroll
              for (int j = 0; j < 8; ++j) { const float y = bias + w0 * xx[j] + w1 * xx[j + 1] + w2 * xx[j + 2] + w3 * xx[j + 3]; s[j] = y / (1.f + __expf(-y)); }
              xx[0] = xx[8]; xx[1] = xx[9]; xx[2] = xx[10];
              if (ch < 256) {
                  *(GAS v4u*)(XTg + lg * 8) = pack8(s);
                  const f32x4 wa = *(const LAS f32x4*)(tab + 1024 + hh * 128 + lg * 8), wb = *(const LAS f32x4*)(tab + 1024 + hh * 128 + lg * 8 + 4);
                  float sw[8] = {s[0] * wa[0], s[1] * wa[1], s[2] * wa[2], s[3] * wa[3], s[4] * wb[0], s[5] * wb[1], s[6] * wb[2], s[7] * wb[3]};
                  *(LAS v4u*)(tile + k_off(ch, lg)) = pack8(sw);
              } else {
#pragma unroll
                  for (int j = 0; j < 8; ++j) BCg[(size_t)(lg * 8 + j) * 512] = (bf16)f2bf(s[j]);
                  if (ch < 384) *(LAS v4u*)(tile + k_off(ch, lg)) = pack8(s);
              }
          }
      } }
    __syncthreads();
    { const int hh = w >> 1, nh = w & 1;
      f32x16 acc[2][2];
#pragma unroll
      for (int i = 0; i < 2; ++i)
#pragma unroll
          for (int j = 0; j < 2; ++j)
#pragma unroll
              for (int r = 0; r < 16; ++r) acc[i][j][r] = 0.f;
#pragma unroll
      for (int ks = 0; ks < 8; ++ks) {
          const bf16x8 a0 = *(const LAS bf16x8*)(tile + k_off(hh * 64 + r32, 2 * ks + hi)), a1 = *(const LAS bf16x8*)(tile + k_off(hh * 64 + 32 + r32, 2 * ks + hi));
          const bf16x8 b0 = *(const LAS bf16x8*)(tile + k_off(256 + nh * 64 + r32, 2 * ks + hi)), b1 = *(const LAS bf16x8*)(tile + k_off(256 + nh * 64 + 32 + r32, 2 * ks + hi));
          acc[0][0] = __builtin_amdgcn_mfma_f32_32x32x16_bf16(a0, b0, acc[0][0], 0, 0, 0); acc[0][1] = __builtin_amdgcn_mfma_f32_32x32x16_bf16(a0, b1, acc[0][1], 0, 0, 0);
          acc[1][0] = __builtin_amdgcn_mfma_f32_32x32x16_bf16(a1, b0, acc[1][0], 0, 0, 0); acc[1][1] = __builtin_amdgcn_mfma_f32_32x32x16_bf16(a1, b1, acc[1][1], 0, 0, 0);
      }
      float* cs = (float*)(ws + WS_CS) + (size_t)((b * 16 + c) * 8 + g * 4 + hh) * 8192;
#pragma unroll
      for (int pb = 0; pb < 2; ++pb)
#pragma unroll
          for (int nb = 0; nb < 2; ++nb)
#pragma unroll
              for (int r = 0; r < 16; ++r) cs[(32 * pb + crow(r, hi)) * 128 + nh * 64 + 32 * nb + r32] = acc[pb][nb][r]; }
    __syncthreads();
}

__device__ __forceinline__ void scan_unit(Frame& F, int b, int h, int sl) {
    unsigned char* ws = F.ws; int tid_ = F.tid; asm volatile("" : "+v"(tid_)); const int e = sl * 1024 + 2 * tid_;
    typedef float f32x2 __attribute__((ext_vector_type(2)));
    const float* CSg = (const float*)(ws + WS_CS) + (size_t)(b * 16 * 8 + h) * 8192 + e; const float* ACSg = (const float*)(ws + WS_ACS);
    unsigned* PVg = (unsigned*)((bf16*)(ws + WS_PREV) + (size_t)(b * 16 * 8 + h) * 8192 + e);
    f32x2 v[15]; float dec[15];
#pragma unroll
    for (int c = 0; c < 15; ++c) { v[c] = *(const GAS f32x2*)(CSg + (size_t)c * 8 * 8192); dec[c] = __expf(ACSg[((size_t)b * SEQ + c * 128 + 127) * 8 + h]); }
    f32x2 s = {0.f, 0.f};
#pragma unroll
    for (int c = 0; c < 16; ++c) { PVg[(size_t)c * 8 * 4096] = att::cvtpk(s[0], s[1]); if (c < 15) s = s * dec[c] + v[c]; }
}
__device__ __forceinline__ void scan_publish(Frame& F, int b, int g) {
    asm volatile("s_waitcnt vmcnt(0)" ::: "memory");
    __syncthreads();
    if (F.tid == 0) { __builtin_amdgcn_fence(__ATOMIC_RELEASE, "agent"); asm volatile("s_waitcnt vmcnt(0)" ::: "memory");
        __hip_atomic_fetch_add((unsigned*)(F.ws + WS_CTL) + 8192 + (b * 2 + g) * 64, 1u, __ATOMIC_RELAXED, __HIP_MEMORY_SCOPE_AGENT); }
}
__device__ __forceinline__ void scan_wait(Frame& F, int b, int g) {
    if (F.tid == 0) { unsigned* p = (unsigned*)(F.ws + WS_CTL) + 8192 + (b * 2 + g) * 64; unsigned sp = 0;
        while (__hip_atomic_load(p, __ATOMIC_RELAXED, __HIP_MEMORY_SCOPE_AGENT) < 32u) { __builtin_amdgcn_s_sleep(2); if (++sp > (1u << 22)) break; }
        __builtin_amdgcn_fence(__ATOMIC_ACQUIRE, "agent"); asm volatile("s_waitcnt vmcnt(0)" ::: "memory"); }
    __syncthreads();
}

__device__ __forceinline__ void unitB(Frame& F, int b, int c, int g, int half) {
    unsigned char* ws = F.ws; int tid_ = F.tid; asm volatile("" : "+v"(tid_)); const int tid = tid_, lane = tid & 63, w = F.wave, r32 = lane & 31, hi = lane >> 5;
    const size_t t0 = (size_t)b * SEQ + c * 128;
#if PROF
    unsigned long long tlast; asm volatile("s_memtime %0\n\ts_waitcnt lgkmcnt(0)" : "=s"(tlast) :: "memory");
#endif
    LAS unsigned char* btile = F.lds;
    LAS unsigned char* xtile = F.lds + 32768;
    LAS float* tab = (LAS float*)(F.lds + 98304);
    const float* DTg = (const float*)(ws + WS_DT); const float* ACSg = (const float*)(ws + WS_ACS);
    const bf16* BCg = (const bf16*)(ws + WS_BC) + t0 * 512;
    const bf16* XTg = (const bf16*)(ws + WS_XT) + ((size_t)(b * 16 + c) * 512 + g * 256) * 128;
    if (c > 0) scan_wait(F, b, g);
#pragma unroll
    for (int i = 0; i < 12; ++i) { const int pc = w * 12 + i;
        const int row = 4 * (pc < 32 ? pc : pc - 32) + (lane >> 4), ch = (lane & 15) ^ (row & 15);
        const bf16* src = (pc < 32) ? BCg + (size_t)row * 512 + g * 128 + ch * 8 : XTg + (size_t)row * 128 + ch * 8;
        __builtin_amdgcn_global_load_lds((const unsigned*)src, (LAS unsigned*)(F.lds + pc * 1024), 16, 0, 0); }
    { const int hq = tid >> 7, l = tid & 127; tab[hq * 128 + l] = DTg[(t0 + l) * 8 + g * 4 + hq]; tab[512 + hq * 128 + l] = ACSg[(t0 + l) * 8 + g * 4 + hq]; }
    BSTAMP(0);
    const int lbi = w >> 2, hh = w & 3, lb = half ? (lbi ? 2 : 1) : (lbi ? 3 : 0), l_loc = 32 * lb + r32;
    const bf16* PVg = (const bf16*)(ws + WS_PREV) + (size_t)((b * 16 + c) * 8 + g * 4 + hh) * 8192;
    bf16x8 cf[8];
#pragma unroll
    for (int ks = 0; ks < 8; ++ks) cf[ks] = *(const GAS bf16x8*)(BCg + (size_t)l_loc * 512 + 256 + g * 128 + 16 * ks + 8 * hi);
    const size_t t = t0 + l_loc; const bf16* Zg = (const bf16*)(ws + WS_Z) + t * 512 + g * 256 + hh * 64;
    v2u zq[2][4];
#pragma unroll
    for (int pb = 0; pb < 2; ++pb)
#pragma unroll
        for (int rg = 0; rg < 4; ++rg) zq[pb][rg] = *(const GAS v2u*)(Zg + 32 * pb + 8 * rg + 4 * hi);
    f32x16 acc[2];
    { bf16x8 pf[2][8];
      if (c > 0) {
#pragma unroll
          for (int pb = 0; pb < 2; ++pb)
#pragma unroll
              for (int ks = 0; ks < 8; ++ks) pf[pb][ks] = *(const GAS bf16x8*)(PVg + (32 * pb + r32) * 128 + 16 * ks + 8 * hi);
      }
#pragma unroll
      for (int pb = 0; pb < 2; ++pb) {
#pragma unroll
          for (int r = 0; r < 16; ++r) acc[pb][r] = 0.f;
          if (c > 0) {
#pragma unroll
              for (int ks = 0; ks < 8; ++ks) acc[pb] = __builtin_amdgcn_mfma_f32_32x32x16_bf16(pf[pb][ks], cf[ks], acc[pb], 0, 0, 0);
              const float e = __expf(ACSg[(t0 + l_loc) * 8 + g * 4 + hh]);
#pragma unroll
              for (int r = 0; r < 16; ++r) acc[pb][r] *= e;
          }
      } }
    BSTAMP(1);
    asm volatile("s_waitcnt vmcnt(0)" ::: "memory"); __syncthreads();
    BSTAMP(2);
    const float acs_l = tab[512 + hh * 128 + l_loc], Dh = F.in[14][g * 4 + hh];
#pragma unroll 1
    for (int sb = 0; sb <= lb; ++sb) {
        f32x16 gt;
#pragma unroll
        for (int r = 0; r < 16; ++r) gt[r] = 0.f;
#pragma unroll
        for (int ks = 0; ks < 8; ++ks) { const bf16x8 bfr = *(const LAS bf16x8*)(btile + k_off(32 * sb + pi32(r32), 2 * ks + hi)); gt = __builtin_amdgcn_mfma_f32_32x32x16_bf16(bfr, cf[ks], gt, 0, 0, 0); }
        float sc[16];
#pragma unroll
        for (int q4 = 0; q4 < 4; ++q4) { const int sbase = 32 * sb + 16 * (q4 >> 1) + 8 * hi + 4 * (q4 & 1);
            const f32x4 as = *(const LAS f32x4*)(tab + 512 + hh * 128 + sbase), ds = *(const LAS f32x4*)(tab + hh * 128 + sbase);
#pragma unroll
            for (int e = 0; e < 4; ++e) { const int r = 4 * q4 + e; float v = gt[r] * __builtin_amdgcn_exp2f(fminf(acs_l - as[e], 0.f) * LOG2E) * ds[e];
                if (sb == lb) { const int sl = 16 * (r >> 3) + 8 * hi + (r & 7); if (sl > r32) v = 0.f; if (sl == r32) v += Dh; }
                sc[r] = v; } }
        v4u scb[2];
        scb[0] = (v4u){att::cvtpk(sc[0], sc[1]), att::cvtpk(sc[2], sc[3]), att::cvtpk(sc[4], sc[5]), att::cvtpk(sc[6], sc[7])};
        scb[1] = (v4u){att::cvtpk(sc[8], sc[9]), att::cvtpk(sc[10], sc[11]), att::cvtpk(sc[12], sc[13]), att::cvtpk(sc[14], sc[15])};
#pragma unroll
        for (int pb = 0; pb < 2; ++pb)
#pragma unroll
            for (int k2 = 0; k2 < 2; ++k2) { const bf16x8 xf = *(const LAS bf16x8*)(xtile + k_off(hh * 64 + 32 * pb + r32, 4 * sb + 2 * k2 + hi));
                acc[pb] = __builtin_amdgcn_mfma_f32_32x32x16_bf16(xf, __builtin_bit_cast(bf16x8, scb[k2]), acc[pb], 0, 0, 0); }
    }
    BSTAMP(3);
    const float* nw = F.in[15] + g * 256 + hh * 64;
    f32x4 wv[2][4];
#pragma unroll
    for (int pb = 0; pb < 2; ++pb)
#pragma unroll
        for (int rg = 0; rg < 4; ++rg) wv[pb][rg] = *(const GAS f32x4*)(nw + 32 * pb + 8 * rg + 4 * hi);
    float ss = 0.f;
#pragma unroll
    for (int pb = 0; pb < 2; ++pb)
#pragma unroll
        for (int rg = 0; rg < 4; ++rg) { const v2u z = zq[pb][rg];
            const float y0 = acc[pb][4 * rg] * bflo(z.x), y1 = acc[pb][4 * rg + 1] * bfhi(z.x), y2 = acc[pb][4 * rg + 2] * bflo(z.y), y3 = acc[pb][4 * rg + 3] * bfhi(z.y);
            acc[pb][4 * rg] = y0; acc[pb][4 * rg + 1] = y1; acc[pb][4 * rg + 2] = y2; acc[pb][4 * rg + 3] = y3;
            ss += (y0 * y0 + y1 * y1) + (y2 * y2 + y3 * y3); }
    ss = att::swap_sum(ss);
    if (hi == 0) tab[1024 + hh * 128 + l_loc] = ss;
    __syncthreads();
    const float rs = rsqrtf(((tab[1024 + l_loc] + tab[1024 + 128 + l_loc]) + (tab[1024 + 256 + l_loc] + tab[1024 + 384 + l_loc])) * (1.f / 256.f) + EPS);
    bf16* Og = (bf16*)(ws + WS_MIXED) + t * 2048 + 1024 + g * 256 + hh * 64;
#pragma unroll
    for (int pb = 0; pb < 2; ++pb)
#pragma unroll
        for (int rg = 0; rg < 4; ++rg) { const f32x4 wq = wv[pb][rg];
            v2u o; o.x = pk2(acc[pb][4 * rg] * rs * wq[0], acc[pb][4 * rg + 1] * rs * wq[1]); o.y = pk2(acc[pb][4 * rg + 2] * rs * wq[2], acc[pb][4 * rg + 3] * rs * wq[3]);
            *(GAS v2u*)(Og + 32 * pb + 8 * rg + 4 * hi) = o; }
    asm volatile("s_waitcnt lgkmcnt(0)\n\ts_barrier" ::: "memory");
    BSTAMP(4);
}
}
struct Sched2 {
    int G, c; const char *A, *B;
    __device__ __forceinline__ bool next(int i, pg8::Unit& u) const {
        const long L = (long)i * G + c; if (L >= 256) return false;
        int wgid = (int)L; { const int xcd = wgid % 8, off = wgid / 8; wgid = xcd * 32 + off; }
        u.pm = (wgid / 64) * 8 + ((wgid % 64) % 8); u.pn = (wgid % 64) / 8; u.kind = 0;
        u.a = A + (size_t)u.pm * TSTEP; u.b = B + (size_t)u.pn * TSTEP; return true;
    }
    __device__ __forceinline__ void a_ready(const pg8::Unit&) const {}
    __device__ __forceinline__ void done(const pg8::Unit&) const {}
};
struct EpiF32 {
    static constexpr bool PERM = false, AFTER_DRAIN = false;
    float* O; int ldc;
    __device__ __forceinline__ void operator()(const pg8::f32x4 (&acc)[2][2][4][2], const pg8::Unit& u, int wr, int wc, int fr, int fq) const {
        const int row0 = u.pm * 256 + wr * 64 + fr, col0 = u.pn * 256 + wc * 32 + 4 * fq;
#pragma unroll
        for (int ai = 0; ai < 2; ++ai)
#pragma unroll
            for (int m = 0; m < 4; ++m) { float* rowp = O + (size_t)(row0 + ai * 128 + m * 16) * ldc + col0;
#pragma unroll
                for (int bj = 0; bj < 2; ++bj)
#pragma unroll
                    for (int n = 0; n < 2; ++n) *(pg8::f32x4*)(rowp + bj * 128 + n * 16) = acc[ai][bj][m][n]; }
    }
};

struct EpiRmsRes {
    static constexpr bool PERM = false, AFTER_DRAIN = true;
    const float* x; const float* w; float* out; float* slots; unsigned* cnt;
    __device__ __forceinline__ void fused(pg8::f32x4 (&acc)[2][2][4][2], const pg8::Unit& u, int wr, int wc, int fr, int fq, PG8_LAS unsigned char* lds, int wid, int lane) const {
        PG8_LAS float* P = (PG8_LAS float*)lds;
        const int col0 = u.pn * 256 + wc * 32 + 4 * fq;
        pg8::f32x4 pre[4][2][2];
#pragma unroll
        for (int m = 0; m < 4; ++m) { const size_t off = (size_t)(u.pm * 256 + wr * 64 + m * 16 + fr) * DM + col0;
#pragma unroll
            for (int bj = 0; bj < 2; ++bj)
#pragma unroll
                for (int n = 0; n < 2; ++n) pre[m][bj][n] = *(const pg8::f32x4*)(x + off + bj * 128 + n * 16); }
        PG8_LAS float* S = (PG8_LAS float*)(lds + 4096);
#pragma unroll
        for (int ai = 0; ai < 2; ++ai)
#pragma unroll
            for (int m = 0; m < 4; ++m) { float s = 0.f;
#pragma unroll
                for (int bj = 0; bj < 2; ++bj)
#pragma unroll
                    for (int n = 0; n < 2; ++n) { const pg8::f32x4 v = acc[ai][bj][m][n]; s += (v[0] * v[0] + v[1] * v[1]) + (v[2] * v[2] + v[3] * v[3]); }
                s += __shfl_xor(s, 16); s += __shfl_xor(s, 32);
                if (fq == 0) P[(ai * 128 + wr * 64 + m * 16 + fr) * 4 + wc] = s; }
        asm volatile("s_waitcnt lgkmcnt(0)" ::: "memory"); __builtin_amdgcn_s_barrier(); asm volatile("" ::: "memory");
        const int row = wid * 32 + (lane & 31);
        if (lane < 32) { const float t = (P[row * 4] + P[row * 4 + 1]) + (P[row * 4 + 2] + P[row * 4 + 3]);
            __hip_atomic_store(slots + (size_t)(u.pm * 256 + row) * 8 + u.pn, t, __ATOMIC_RELAXED, __HIP_MEMORY_SCOPE_AGENT); }
        asm volatile("s_waitcnt vmcnt(0)" ::: "memory");
        if (lane == 0) __hip_atomic_fetch_add(cnt + 64 * u.pm, 1u, __ATOMIC_RELAXED, __HIP_MEMORY_SCOPE_AGENT);
        if (wid == 0) { unsigned sp = 0;
            while ((unsigned)__builtin_amdgcn_readfirstlane(__hip_atomic_load(cnt + 64 * u.pm, __ATOMIC_RELAXED, __HIP_MEMORY_SCOPE_AGENT)) < 64u) { __builtin_amdgcn_s_sleep(2); if (++sp > (1u << 22)) break; }
            __builtin_amdgcn_fence(__ATOMIC_ACQUIRE, "agent"); }
        asm volatile("s_waitcnt vmcnt(0) lgkmcnt(0)" ::: "memory"); __builtin_amdgcn_s_barrier(); asm volatile("" ::: "memory");
        if (lane < 32) { const float* sl = slots + (size_t)(u.pm * 256 + row) * 8; float t = 0.f;
#pragma unroll
            for (int k = 0; k < 8; ++k) t += __hip_atomic_load(sl + k, __ATOMIC_RELAXED, __HIP_MEMORY_SCOPE_AGENT);
            S[row] = rsqrtf(t * (1.f / DM) + EPS); }
        asm volatile("s_waitcnt lgkmcnt(0)" ::: "memory"); __builtin_amdgcn_s_barrier(); asm volatile("" ::: "memory");
        pg8::f32x4 wv[2][2];
#pragma unroll
        for (int bj = 0; bj < 2; ++bj)
#pragma unroll
            for (int n = 0; n < 2; ++n) wv[bj][n] = *(const pg8::f32x4*)(w + col0 + bj * 128 + n * 16);
#pragma unroll
        for (int ai = 0; ai < 2; ++ai)
#pragma unroll
            for (int m = 0; m < 4; ++m) { const int r = ai * 128 + wr * 64 + m * 16 + fr; const float rs = S[r]; const size_t off = (size_t)(u.pm * 256 + r) * DM + col0;
#pragma unroll
                for (int bj = 0; bj < 2; ++bj)
#pragma unroll
                    for (int n = 0; n < 2; ++n) { const pg8::f32x4 xv = ai == 0 ? pre[m][bj][n] : *(const pg8::f32x4*)(x + off + bj * 128 + n * 16);
                        *(pg8::f32x4*)(out + off + bj * 128 + n * 16) = xv + acc[ai][bj][m][n] * rs * wv[bj][n]; }
                if (m & 1) asm volatile("" ::: "memory"); }
    }
};
__device__ __forceinline__ void p5_final(Frame& F) {
    const int gw = F.vcu * NWAVES + F.wave, NGW = F.G * NWAVES;
    const float* o2 = (const float*)(F.ws + WS_O2); const GAS f32x4* wr = (const GAS f32x4*)F.in[19] + F.lane;
    for (int mrow = gw; mrow < M; mrow += NGW) {
        const GAS f32x4* orow = (const GAS f32x4*)(o2 + (size_t)mrow * DM) + F.lane; const GAS f32x4* xr = (const GAS f32x4*)(F.in[0] + (size_t)mrow * DM) + F.lane;
        GAS f32x4* outr = (GAS f32x4*)(F.out + (size_t)mrow * DM) + F.lane;
        f32x4 v[8]; float s = 0.f;
#pragma unroll
        for (int j = 0; j < 8; ++j) { v[j] = orow[64 * j]; s += (v[j].x * v[j].x + v[j].y * v[j].y) + (v[j].z * v[j].z + v[j].w * v[j].w); }
        const float rstd = rsqrtf(wave_sum(s) * (1.f / DM) + EPS);
#pragma unroll
        for (int j = 0; j < 8; ++j) outr[64 * j] = xr[64 * j] + v[j] * rstd * wr[64 * j];
    }
}
constexpr int LDS_BYTES = 147456;
struct Args { const float* in[20]; float* out; unsigned char* ws; int ph_lo, ph_hi; int rep[10]; };
__global__ void __launch_bounds__(NTHR, 2) mega(Args args) {
    extern __shared__ __attribute__((aligned(16))) unsigned char lds[];
    Frame F;
    F.lds = (LAS unsigned char*)lds;
    F.tid = threadIdx.x; F.lane = F.tid & 63; F.wave = __builtin_amdgcn_readfirstlane(F.tid >> 6);
    F.G = gridDim.x; { const int bx = blockIdx.x; F.vcu = (F.G % 8 == 0) ? (bx % 8) * (F.G / 8) + bx / 8 : bx; }
#pragma unroll
    for (int i = 0; i < 20; ++i) F.in[i] = args.in[i];
    F.out = args.out; F.ws = args.ws;
#pragma unroll
    for (int i = 0; i < 8; ++i) F.tacc[i] = 0;
    const int lo = args.ph_lo, hi = args.ph_hi;
#if PROF
    const unsigned long long tk0 = __builtin_amdgcn_s_memrealtime();
#endif
#define IN(k) (lo <= (k) && (k) < hi)
    volatile LAS unsigned* MISC = (volatile LAS unsigned*)(F.lds + LDS_BYTES - 64);
    if (F.tid < 16) MISC[F.tid] = 0u;
    __syncthreads();
    const XcdBarrier bar = xcd_barrier_post((unsigned*)(F.ws + WS_CTL) + 4096, MISC + 8);
#if PROF
#define SEAM(k) do { if (IN(k) && IN((k) + 1)) { const unsigned long long t0_ = __builtin_amdgcn_s_memtime(); xcd_barrier(bar); const unsigned long long d_ = __builtin_amdgcn_s_memtime() - t0_; \
    if (args.rep[9] == 30 + (k) || (args.rep[9] == 41 && (k) == 2 && blockIdx.x < 80) || (args.rep[9] == 42 && (k) == 2 && blockIdx.x >= 80)) { const unsigned long long t1_ = __builtin_amdgcn_s_memtime(); while (__builtin_amdgcn_s_memtime() - t1_ < d_) __builtin_amdgcn_s_sleep(4); } if (args.rep[9] == 30 + (k) || ((args.rep[9] == 41 || args.rep[9] == 42) && (k) == 2)) xcd_barrier(bar); } } while (0)
#else
#define SEAM(k) do { if (IN(k) && IN((k) + 1)) xcd_barrier(bar); } while (0)
#endif
#define REPS(k) (args.rep[k])
#define RETID() do { int t_ = threadIdx.x; asm volatile("" : "+v"(t_)); F.tid = t_; F.lane = t_ & 63; } while (0)
    for (int rp = 0; rp < REPS(0); ++rp) { if (rp) xcd_barrier(bar);
    if (IN(0)) { RETID(); p0_prologue(F); }
#if PROF
    if (args.rep[9] > 20) { const int sel = args.rep[9] - 20; unsigned long long acc = sel == 1 ? F.tacc[0] : sel == 2 ? F.tacc[1] : sel == 3 ? F.tacc[2] : sel == 4 ? F.tacc[3] : F.tacc[4];
        const unsigned long long t0 = __builtin_amdgcn_s_memtime(); while (__builtin_amdgcn_s_memtime() - t0 < acc) __builtin_amdgcn_s_sleep(4); }
#pragma unroll
    for (int i = 0; i < 8; ++i) F.tacc[i] = 0;
#endif
    }
    SEAM(0);
    for (int rp = 0; rp < REPS(1); ++rp) { if (rp) xcd_barrier(bar);
    if (IN(1)) {
        pg8::Gemm g{DM}; Sched1 S{F.G, (int)blockIdx.x, (const char*)(F.ws + WS_HN), (const char*)(F.ws + WS_W1T), (const char*)(F.ws + WS_MEMN), (const char*)(F.ws + WS_WKVT), (unsigned*)(F.ws + WS_CTL) + CW_P1DONE};
        EpiP1 E{F.ws};
        pg8::gemm_phase<EpiP1, Sched1, true, true>(F.lds, g, S, E);
    }
    }
    const bool overlap = (F.G == 256);
    if (!overlap) SEAM(1);
    for (int rp = 0; rp < REPS(2); ++rp) { if (rp) xcd_barrier(bar);
    if (IN(2)) {
        if (overlap) {
            if (F.tid == 0) { unsigned* p = (unsigned*)(F.ws + WS_CTL) + CW_P1DONE; unsigned sp = 0;
                while (__hip_atomic_load(p, __ATOMIC_RELAXED, __HIP_MEMORY_SCOPE_AGENT) < (unsigned)P1_EARLY_UNITS * (unsigned)args.rep[1]) { __builtin_amdgcn_s_sleep(4); if (++sp > (1u << 22)) break; }
                __builtin_amdgcn_fence(__ATOMIC_ACQUIRE, "agent"); asm volatile("s_waitcnt vmcnt(0)" ::: "memory"); }
            for (;;) {
                __syncthreads();
                if (F.tid == 0) MISC[4] = __hip_atomic_fetch_add((unsigned*)(F.ws + WS_CTL) + CW_P2AQ, 1u, __ATOMIC_RELAXED, __HIP_MEMORY_SCOPE_AGENT);
                __syncthreads();
                const int item = (int)MISC[4];
                if (item >= 256 + 128) break;
                if (item < 128) ssd::unitA(F, item >> 5, (item >> 1) & 15, item & 1);
                else if (item < 256) { const int u = item - 128; att::xattn_unit(F, u >> 5, (u >> 3) & 3, u & 7); }
                else { RETID(); p0_wot_chunk(F, item - 256); }
            }
        } else
        { for (int u = F.vcu; u < 256; u += F.G) { if (u < 128) att::xattn_unit(F, u >> 5, (u >> 3) & 3, u & 7); else { const int v = u - 128; ssd::unitA(F, v >> 5, (v >> 1) & 15, v & 1); } }
          __syncthreads(); RETID(); p0_wot(F, F.vcu * NWAVES + F.wave, F.G * NWAVES); __syncthreads(); }
    }
    }
    SEAM(2);
    for (int rp = 0; rp < REPS(3); ++rp) { if (rp) xcd_barrier(bar);
    if (IN(3)) {
        const float d1 = wave_sum(F.lane < 64 ? F.in[5][F.lane] * F.in[6][F.lane] : 0.f), d2 = wave_sum(F.in[7][F.lane] * F.in[8][F.lane]);
        const float lam = __expf(d1) - __expf(d2) + LAMBDA_INIT;
        for (int r6 = 0; r6 < args.rep[6]; ++r6)
        for (int v = F.vcu; v < 256; v += F.G) { ssd::scan_unit(F, v >> 6, (v >> 3) & 7, v & 7); ssd::scan_publish(F, v >> 6, (v >> 5) & 1); }
        for (int r7 = 0; r7 < args.rep[7]; ++r7)
        for (int v = F.vcu; v < 256; v += F.G) { const int x = v >> 5, j = v & 31, bh1 = 4 * x + (j >> 4), bh2 = bh1 + 2, s = j & 15;
            att::diff_unit(F, bh1 >> 3, bh1 & 7, s, lam); att::diff_unit(F, bh2 >> 3, bh2 & 7, 15 - s, lam); }
        for (int r8 = 0; r8 < args.rep[8]; ++r8)
        for (int v = F.vcu; v < 256; v += F.G) ssd::unitB(F, v >> 6, (v >> 2) & 15, (v >> 1) & 1, v & 1);
    }
    }
    SEAM(3);
    for (int rp = 0; rp < REPS(4); ++rp) { if (rp) xcd_barrier(bar);
    if (IN(4)) {
        pg8::Gemm g{DM}; Sched2 S{F.G, (int)blockIdx.x, (const char*)(F.ws + WS_MIXED), (const char*)(F.ws + WS_WOT)};
        if (F.G == 256) {
            EpiRmsRes E{F.in[0], F.in[19], F.out, (float*)(F.ws + WS_SLOTS), (unsigned*)(F.ws + WS_CTL) + 12288};
            pg8::gemm_phase<EpiRmsRes, Sched2, false, true>(F.lds, g, S, E);
        } else {
            EpiF32 E{(float*)(F.ws + WS_O2), DM};
            pg8::gemm_phase<EpiF32, Sched2, false, true>(F.lds, g, S, E);
        }
    }
    }
    if (F.G != 256) SEAM(4);
    for (int rp = 0; rp < REPS(5); ++rp) { if (rp) xcd_barrier(bar);
    if (IN(5) && F.G != 256) { RETID(); p5_final(F); }
    }
#if PROF
    if (args.rep[9] == 40) { const unsigned long long d_ = __builtin_amdgcn_s_memrealtime() - tk0, t1_ = __builtin_amdgcn_s_memrealtime(); while (__builtin_amdgcn_s_memrealtime() - t1_ < d_) __builtin_amdgcn_s_sleep(8); }
#endif
#undef SEAM
#undef IN
}
extern "C" void kernel_launch(void* const* d_in, const int* in_sizes, int n_in, void* d_out, int out_size, void* d_ws, size_t ws_size, hipStream_t stream) {
    static int grid = 0;
    if (grid == 0) {
        if (n_in != 20 || in_sizes[0] != M * DM || out_size != M * DM || ws_size < WS_END) { fprintf(stderr, "kernel_launch: unexpected shapes (n_in %d, ws %zu)\n", n_in, ws_size); grid = -1; return; }
        int dev = 0, cus = 0, per_cu = 0;
        (void)hipGetDevice(&dev); (void)hipDeviceGetAttribute(&cus, hipDeviceAttributeMultiprocessorCount, dev);
        (void)hipFuncSetAttribute((const void*)mega, hipFuncAttributeMaxDynamicSharedMemorySize, LDS_BYTES);
        (void)hipOccupancyMaxActiveBlocksPerMultiprocessor(&per_cu, (const void*)mega, NTHR, LDS_BYTES);
        if (per_cu < 1) { fprintf(stderr, "kernel_launch: occupancy query says %d\n", per_cu); per_cu = 1; }
        (void)hipGetLastError();
        grid = cus * (per_cu < 1 ? 1 : 1);
    }
    if (grid < 0) return;
    unsigned char* ws = (unsigned char*)d_ws;
    Args a{};
    for (int i = 0; i < 20; ++i) a.in[i] = (const float*)d_in[i];
    a.out = (float*)d_out; a.ws = ws;
    if (hipMemsetAsync(ws + WS_CTL, 0, 65536, stream) != hipSuccess) { fprintf(stderr, "kernel_launch: memset failed\n"); return; }
    a.ph_lo = 0; a.ph_hi = 6;
    for (int k = 0; k < 10; ++k) a.rep[k] = 1;
    void* kargs[] = {&a};
    hipError_t e = hipLaunchCooperativeKernel((const void*)mega, dim3(grid), dim3(NTHR), kargs, LDS_BYTES, stream);
    if (e != hipSuccess) fprintf(stderr, "kernel_launch: cooperative launch failed: %s (grid %d)\n", hipGetErrorString(e), grid);
}
```

```cpp
#include <hip/hip_runtime.h>
#include <hip/hip_cooperative_groups.h>
#include <cstdio>
#include <cstdint>
#include <cmath>
namespace pg8 {
#define PG8_LAS __attribute__((address_space(3)))
typedef unsigned short bf16_t;
typedef short bf16x8 __attribute__((ext_vector_type(8)));
typedef float f32x4 __attribute__((ext_vector_type(4)));
typedef unsigned u32x4 __attribute__((ext_vector_type(4)));
constexpr int BM = 256, BK = 64, HALF = 128, HTB = HALF * BK * 2  , STAGE_BYTES = 8 * HTB, NXCD = 8, WGM = 8;

__host__ __device__ __forceinline__ int lds_byte(int r, int c) { const int st = (r >> 4) * 2 + (c >> 5), rr = r & 15, cc = c & 31, ob = rr * 64 + cc * 2; return st * 1024 + (ob ^ (((ob >> 9) & 1) << 5)); }
__host__ __device__ __forceinline__ void stage_rc(int b, int& R, int& C) { const int st = b / 1024, sb = b % 1024, swz = sb ^ (((sb >> 9) & 1) << 5); R = (st >> 1) * 16 + swz / 64; C = (st & 1) * 32 + (swz % 64) / 2; }
__host__ __device__ __forceinline__ int perm32(int rho) { const int n = rho >> 4, i = rho & 15; return 8 * (i >> 2) + 4 * n + (i & 3); }

struct Unit { const char* a; const char* b; int pm, pn, kind; };
struct Gemm { int K; };

__device__ __forceinline__ unsigned cvt_pk_bf16(float lo, float hi) { unsigned r; asm volatile("v_cvt_pk_bf16_f32 %0, %1, %2" : "=v"(r) : "v"(lo), "v"(hi)); return r; }
template <class Epi, class Sched, bool ALIGN_EPI = false, bool SP2 = false>
__device__ __forceinline__ void gemm_phase(PG8_LAS unsigned char* lds, const Gemm g, const Sched& S, const Epi& E) {
    int tid_ = threadIdx.x; asm volatile("" : "+v"(tid_));
    const int tid = tid_, wid = __builtin_amdgcn_readfirstlane(tid >> 6), lane = tid & 63, wr = wid >> 2, wc = wid & 3, fr = lane & 15, fq = lane >> 4;
    const int K = g.K, nt = K / BK;
    unsigned voffA[2], voffB[2];
#pragma unroll
    for (int i = 0; i < 2; ++i) { int R, C; stage_rc(tid * 16 + i * 8192, R, C); const int Rb = Epi::PERM ? ((R & ~31) + perm32(R & 31)) : R;
        voffA[i] = (unsigned)(R * K + C) * 2u; voffB[i] = (unsigned)(Rb * K + C) * 2u; }
    const size_t kstep = (size_t)(BK * 2);
    const size_t hstep = (size_t)HALF * K * 2;
        const unsigned ldsw = (unsigned)wid * 1024u;
    const int aoff = lds_byte(wr * 64 + fr, fq * 8), boff = lds_byte(wc * 32 + fr, fq * 8);
#define PG8_SA(b, h) (((b) * 2 + (h)) * HTB)
#define PG8_SB(b, h) ((4 + (b) * 2 + (h)) * HTB)
#define PG8_STAGE(bufoff, gbase, voff) do { _Pragma("unroll") for (int _i = 0; _i < 2; ++_i) \
        __builtin_amdgcn_global_load_lds((const unsigned*)((const char*)(gbase) + (voff)[_i]), (PG8_LAS unsigned*)(lds + (bufoff) + ldsw + _i * 8192), 16, 0, 0); } while (0)
#define PG8_LDA(dst, b, h) do { _Pragma("unroll") for (int m = 0; m < 4; ++m) _Pragma("unroll") for (int k = 0; k < 2; ++k) dst[m][k] = *(const PG8_LAS bf16x8*)(lds + PG8_SA(b, h) + aoff + m * 2048 + k * 1024); } while (0)
#define PG8_LDB(dst, b, h) do { _Pragma("unroll") for (int n = 0; n < 2; ++n) _Pragma("unroll") for (int k = 0; k < 2; ++k) dst[n][k] = *(const PG8_LAS bf16x8*)(lds + PG8_SB(b, h) + boff + n * 2048 + k * 1024); } while (0)
#define PG8_MMA(ai, bj, At, Bt) do { __builtin_amdgcn_s_setprio(1); _Pragma("unroll") for (int m = 0; m < 4; ++m) _Pragma("unroll") for (int n = 0; n < 2; ++n) _Pragma("unroll") for (int k = 0; k < 2; ++k) \
        acc[ai][bj][m][n] = __builtin_amdgcn_mfma_f32_16x16x32_bf16(Bt[n][k], At[m][k], acc[ai][bj][m][n], 0, 0, 0); __builtin_amdgcn_s_setprio(0); } while (0)
#define PG8_WAIT_V(n) asm volatile("s_waitcnt vmcnt(" #n ")" ::: "memory")
#define PG8_WAIT_L(n) asm volatile("s_waitcnt lgkmcnt(" #n ")" ::: "memory")
#define PG8_BAR __builtin_amdgcn_s_barrier()
#define PG8_SCHED __builtin_amdgcn_sched_barrier(0)
    Unit cur, nxt; int ui = 0;
    if (!S.next(0, cur)) return;
    f32x4 acc[2][2][4][2];
#pragma unroll
    for (int a = 0; a < 2; ++a)
#pragma unroll
        for (int b = 0; b < 2; ++b)
#pragma unroll
            for (int m = 0; m < 4; ++m)
#pragma unroll
                for (int n = 0; n < 2; ++n) acc[a][b][m][n] = (f32x4){0.f, 0.f, 0.f, 0.f};
    bf16x8 At[4][2], B0[2][2], B1[2][2];
    const char* cA = cur.a; const char* cB = cur.b;
    S.a_ready(cur);
    if constexpr (SP2) {
        PG8_STAGE(PG8_SB(0, 0), cB, voffB); PG8_STAGE(PG8_SB(0, 1), cB + hstep, voffB); PG8_STAGE(PG8_SA(0, 0), cA, voffA); PG8_STAGE(PG8_SA(0, 1), cA + hstep, voffA);
        if (wr == 1) PG8_BAR;
        PG8_WAIT_V(2); PG8_BAR;
        PG8_STAGE(PG8_SB(1, 0), cB + kstep, voffB); PG8_STAGE(PG8_SA(1, 0), cA + kstep, voffA); PG8_STAGE(PG8_SB(1, 1), cB + hstep + kstep, voffB);
        PG8_WAIT_V(6); PG8_BAR;
    } else {
        PG8_STAGE(PG8_SB(0, 0), cB, voffB); PG8_STAGE(PG8_SA(0, 0), cA, voffA); PG8_STAGE(PG8_SB(0, 1), cB + hstep, voffB); PG8_STAGE(PG8_SA(0, 1), cA + hstep, voffA);
        if (wr == 1) PG8_BAR;
        PG8_WAIT_V(4); PG8_BAR;
        PG8_STAGE(PG8_SB(1, 0), cB + kstep, voffB); PG8_STAGE(PG8_SA(1, 0), cA + kstep, voffA); PG8_STAGE(PG8_SB(1, 1), cB + hstep + kstep, voffB);
        PG8_WAIT_V(6); PG8_BAR;
    }
    for (;;) {
        const bool has_next = S.next(ui + 1, nxt);
        const char* nA = has_next ? nxt.a : cA; const char* nB = has_next ? nxt.b : cB;
        for (int t = 0; t < nt; t += 2) {
            const bool last = (t == nt - 2);
            const char* a1 = cA + (size_t)(t + 1) * kstep;
            const char* a2 = last ? nA : cA + (size_t)(t + 2) * kstep; const char* b2 = last ? nB : cB + (size_t)(t + 2) * kstep;
            const char* a3 = a2 + kstep; const char* b3 = b2 + kstep;
            if (last && has_next) S.a_ready(nxt);
            if constexpr (SP2) {
            PG8_LDB(B0, 0, 0); PG8_LDB(B1, 0, 1); PG8_SCHED; PG8_LDA(At, 0, 0); PG8_STAGE(PG8_SA(1, 1), a1 + hstep, voffA);
            PG8_WAIT_V(8); PG8_WAIT_L(0); PG8_BAR; PG8_MMA(0, 0, At, B0); PG8_MMA(0, 1, At, B1); PG8_BAR; PG8_SCHED;
            PG8_LDA(At, 0, 1); PG8_STAGE(PG8_SB(0, 0), b2, voffB); PG8_STAGE(PG8_SB(0, 1), b2 + hstep, voffB); PG8_STAGE(PG8_SA(0, 0), a2, voffA);
            PG8_WAIT_V(8); PG8_WAIT_L(0); PG8_BAR; PG8_MMA(1, 0, At, B0); PG8_MMA(1, 1, At, B1); PG8_BAR; PG8_SCHED;
            PG8_LDB(B0, 1, 0); PG8_LDB(B1, 1, 1); PG8_SCHED; PG8_LDA(At, 1, 0); PG8_STAGE(PG8_SA(0, 1), a2 + hstep, voffA);
            PG8_WAIT_V(8); PG8_WAIT_L(0); PG8_BAR; PG8_MMA(0, 0, At, B0); PG8_MMA(0, 1, At, B1); PG8_BAR; PG8_SCHED;
            PG8_LDA(At, 1, 1); PG8_STAGE(PG8_SB(1, 0), b3, voffB); PG8_STAGE(PG8_SB(1, 1), b3 + hstep, voffB); PG8_STAGE(PG8_SA(1, 0), a3, voffA);
            PG8_WAIT_V(8); PG8_WAIT_L(0); PG8_BAR; PG8_MMA(1, 0, At, B0); PG8_MMA(1, 1, At, B1); PG8_BAR; PG8_SCHED;
            } else {
            PG8_LDB(B0, 0, 0); PG8_SCHED; PG8_LDA(At, 0, 0); PG8_STAGE(PG8_SA(1, 1), a1 + hstep, voffA);
            PG8_WAIT_L(8); PG8_BAR; PG8_WAIT_L(0); PG8_MMA(0, 0, At, B0); PG8_BAR; PG8_SCHED;
            PG8_LDB(B1, 0, 1); PG8_STAGE(PG8_SB(0, 0), b2, voffB);
            PG8_BAR; PG8_WAIT_L(0); PG8_MMA(0, 1, At, B1); PG8_BAR;
            PG8_LDA(At, 0, 1); PG8_STAGE(PG8_SA(0, 0), a2, voffA);
            PG8_BAR; PG8_WAIT_L(0); PG8_MMA(1, 0, At, B0); PG8_BAR; PG8_SCHED;
            PG8_STAGE(PG8_SB(0, 1), b2 + hstep, voffB);
            PG8_WAIT_V(6); PG8_BAR; PG8_MMA(1, 1, At, B1); PG8_BAR;
            PG8_LDB(B0, 1, 0); PG8_SCHED; PG8_LDA(At, 1, 0); PG8_STAGE(PG8_SA(0, 1), a2 + hstep, voffA);
            PG8_WAIT_L(8); PG8_BAR; PG8_WAIT_L(0); PG8_MMA(0, 0, At, B0); PG8_BAR; PG8_SCHED;
            PG8_LDB(B1, 1, 1); PG8_STAGE(PG8_SB(1, 0), b3, voffB);
            PG8_BAR; PG8_WAIT_L(0); PG8_MMA(0, 1, At, B1); PG8_BAR;
            PG8_LDA(At, 1, 1); PG8_STAGE(PG8_SA(1, 0), a3, voffA);
            PG8_BAR; PG8_WAIT_L(0); PG8_MMA(1, 0, At, B0); PG8_BAR; PG8_SCHED;
            PG8_STAGE(PG8_SB(1, 1), b3 + hstep, voffB);
            PG8_WAIT_V(6); PG8_BAR; PG8_MMA(1, 1, At, B1); PG8_BAR;
            }
        }
        if constexpr (ALIGN_EPI) { if (wr == 0) PG8_BAR; }
        if constexpr (!Epi::AFTER_DRAIN) { E(acc, cur, wr, wc, fr, fq); S.done(cur); }
        if (!has_next) break;
#pragma unroll
        for (int a = 0; a < 2; ++a)
#pragma unroll
            for (int b = 0; b < 2; ++b)
#pragma unroll
                for (int m = 0; m < 4; ++m)
#pragma unroll
                    for (int n = 0; n < 2; ++n) acc[a][b][m][n] = (f32x4){0.f, 0.f, 0.f, 0.f};
        cur = nxt; cA = nA; cB = nB; ++ui;
        if constexpr (ALIGN_EPI) { if (wr == 1) PG8_BAR; }
    }
    PG8_WAIT_V(0);
    if constexpr (!ALIGN_EPI) { if (wr == 0) PG8_BAR; }
    PG8_BAR;
    if constexpr (Epi::AFTER_DRAIN) { E.fused(acc, cur, wr, wc, fr, fq, lds, wid, lane); S.done(cur); }
#undef PG8_SA
#undef PG8_SB
#undef PG8_STAGE
#undef PG8_LDA
#undef PG8_LDB
#undef PG8_MMA
#undef PG8_WAIT_V
#undef PG8_WAIT_L
#undef PG8_BAR
#undef PG8_SCHED
}
}
constexpr int NWAVES = 8, NTHR = NWAVES * 64;
constexpr int BATCH = 4, SEQ = 2048, DM = 2048, M = BATCH * SEQ, DIN = 6664, MEMLEN = 256, MM = BATCH * MEMLEN;
constexpr int NW1 = 6656;
constexpr float EPS = 1e-6f, LOG2E = 1.4426950408889634f;
constexpr float C2Q = 0.125f * LOG2E;
constexpr float C2X = 0.08838834764831845f * LOG2E;
constexpr float LAMBDA_INIT = 0.2f;
constexpr size_t MiB = 1u << 20;
constexpr size_t WS_CTL = 0, CTL_ZERO_BYTES = 1 * MiB;
constexpr size_t WS_W1T = 1 * MiB, WS_WOT = 27 * MiB, WS_WKVT = 35 * MiB, WS_HN = 39 * MiB, WS_MEMN = 71 * MiB;
constexpr size_t WS_DT = 75 * MiB, WS_ACS = 75 * MiB + 256 * 1024, WS_ROPE = 76 * MiB;
constexpr size_t WS_Q = 78 * MiB, WS_K = 94 * MiB, WS_VT = 110 * MiB, WS_G = 126 * MiB, WS_Z = 142 * MiB, WS_XBC = 150 * MiB, WS_XQ = 166 * MiB, WS_XG = 174 * MiB;
constexpr size_t WS_MK = 182 * MiB, WS_MVT = 183 * MiB, WS_XT = 184 * MiB, WS_BC = 192 * MiB, WS_CS = 200 * MiB, WS_MIXED = 216 * MiB, WS_PREV = 248 * MiB, WS_END = 256 * MiB;
constexpr size_t WS_SLOTS = 75 * MiB + 512 * 1024;
constexpr size_t WS_O2 = 39 * MiB;
constexpr size_t TSTEP = (size_t)256 * DM * 2;

#define GAS __attribute__((address_space(1)))
#define LAS __attribute__((address_space(3)))
typedef unsigned short bf16;
typedef unsigned v4u __attribute__((ext_vector_type(4)));
typedef unsigned v2u __attribute__((ext_vector_type(2)));
typedef float f32x4 __attribute__((ext_vector_type(4)));
typedef float f32x16 __attribute__((ext_vector_type(16)));
typedef short bf16x8 __attribute__((ext_vector_type(8)));
#define LDS_WAIT() asm volatile("s_waitcnt lgkmcnt(0)" ::: "memory")
#define VM_WAIT() asm volatile("s_waitcnt vmcnt(0)" ::: "memory")
__device__ __forceinline__ unsigned f2bf(float f) { unsigned u = __builtin_bit_cast(unsigned, f); return (u + 0x7fffu + ((u >> 16) & 1u)) >> 16; }
__device__ __forceinline__ unsigned pk2(float lo, float hi) { return f2bf(lo) | (f2bf(hi) << 16); }
__device__ __forceinline__ float bf2f(bf16 v) { return __builtin_bit_cast(float, (unsigned)v << 16); }
__device__ __forceinline__ float bflo(unsigned w) { return __builtin_bit_cast(float, w << 16); }
__device__ __forceinline__ float bfhi(unsigned w) { return __builtin_bit_cast(float, w & 0xffff0000u); }
__device__ __forceinline__ float silu_f(float v) { return v / (1.f + __expf(-v)); }
__device__ __forceinline__ float wave_sum(float v) {
#pragma unroll
    for (int o = 1; o < 64; o <<= 1) v += __shfl_xor(v, o);
    return v;
}

struct Frame {
    LAS unsigned char* lds;
    int tid, lane, wave, vcu, G;
    const float* in[20]; float* out; unsigned char* ws;
    unsigned long long tacc[8];
};

__device__ __forceinline__ int w1_src_col(int r) {
    if (r < 2048) { const int p = r & 63, i = p >> 2, j = p & 3; return (r & ~63) + 2 * i + (j & 1) + 32 * (j >> 1); }
    if (r < 3072) return 3072 + (r - 2048);
    if (r < 3584) return 4096 + (r - 3072);
    if (r < 4608) return 4608 + (r - 3584);
    if (r < 5120) return 5640 + (r - 4608);
    if (r < 5632) return 6152 + (r - 5120);
    return 2048 + (r - 5632);
}
struct TItem { const float* src; bf16* dst; int N; };
__device__ __forceinline__ TItem p0_item(const Frame& F, int it, int lane) {
    constexpr int I_1 = (NW1 / 32) * (DM / 64), I_KV = (1024 / 32) * (DM / 64);
    const float* W; bf16* WT; int N, r = it; bool map = false;
    int nblk;
    if (r < I_1) { W = F.in[4]; N = DIN; WT = (bf16*)(F.ws + WS_W1T); map = true; nblk = NW1 / 32; }
    else if (r < I_1 + I_KV) { r -= I_1; W = F.in[17]; N = 1024; WT = (bf16*)(F.ws + WS_WKVT); nblk = 32; }
    else { r -= I_1 + I_KV; W = F.in[18]; N = DM; WT = (bf16*)(F.ws + WS_WOT); nblk = 64; }
    const int kb = r / nblk, nb = r - kb * nblk, k0 = 64 * kb, n0 = 32 * nb;
    const int sc = map ? w1_src_col(n0 + (lane & 31)) : n0 + (lane & 31);
    TItem t; t.src = W + (size_t)(k0 + (lane >> 5)) * N + sc; t.dst = WT + (size_t)n0 * DM + k0; t.N = N; return t;
}
__device__ __forceinline__ void p0_item_load(float (&tv)[32], const TItem& t) {
#pragma unroll
    for (int i = 0; i < 32; ++i) tv[i] = t.src[(size_t)(2 * i) * t.N];
}
__device__ __forceinline__ void p0_item_store(const float (&tv)[32], const TItem& t, LAS float* scr, int lane) {
#pragma unroll
    for (int i = 0; i < 32; ++i) scr[(2 * i + (lane >> 5)) * 33 + (lane & 31)] = tv[i];
    LDS_WAIT(); asm volatile("" ::: "memory");
    const int c = lane & 7;
#pragma unroll
    for (int j = 0; j < 4; ++j) { const int n = (lane >> 3) + 8 * j; const LAS float* s = scr + (8 * c) * 33 + n;
        v4u o; o.x = pk2(s[0 * 33], s[1 * 33]); o.y = pk2(s[2 * 33], s[3 * 33]); o.z = pk2(s[4 * 33], s[5 * 33]); o.w = pk2(s[6 * 33], s[7 * 33]);
        *(GAS v4u*)(t.dst + (size_t)n * DM + 8 * c) = o; }
    LDS_WAIT(); asm volatile("" ::: "memory");
}
__device__ __forceinline__ void p0_row_load(f32x4 (&v)[8], const Frame& F, int m, int lane) {
    const GAS f32x4* xr = (const GAS f32x4*)((m < M) ? F.in[0] + (size_t)m * DM : F.in[1] + (size_t)(m - M) * DM) + lane;
#pragma unroll
    for (int j = 0; j < 8; ++j) v[j] = xr[64 * j];
}
__device__ __forceinline__ void p0_row_finish(f32x4 (&v)[8], const Frame& F, int m, const LAS float* wdt, int lane) {
    const bool isx = m < M;
    const GAS f32x4* wr = (const GAS f32x4*)(isx ? F.in[3] : F.in[16]) + lane;
    bf16* orow = isx ? (bf16*)(F.ws + WS_HN) + (size_t)m * DM : (bf16*)(F.ws + WS_MEMN) + (size_t)(m - M) * DM;
    float s = 0.f;
#pragma unroll
    for (int j = 0; j < 8; ++j) s += (v[j].x * v[j].x + v[j].y * v[j].y) + (v[j].z * v[j].z + v[j].w * v[j].w);
    const float rstd = rsqrtf(wave_sum(s) * (1.f / DM) + EPS);
    GAS v2u* o8 = (GAS v2u*)orow + lane;
#pragma unroll
    for (int j = 0; j < 8; ++j) { v[j] = v[j] * rstd * wr[64 * j]; v2u o; o.x = pk2(v[j].x, v[j].y); o.y = pk2(v[j].z, v[j].w); o8[64 * j] = o; }
    if (isx) {
        float d[8];
#pragma unroll
        for (int h = 0; h < 8; ++h) { float a = 0.f;
#pragma unroll
            for (int j = 0; j < 8; ++j) { const f32x4 ww = *(const LAS f32x4*)(wdt + h * DM + 4 * (lane + 64 * j)); a += (v[j].x * ww.x + v[j].y * ww.y) + (v[j].z * ww.z + v[j].w * ww.w); }
            d[h] = wave_sum(a); }
        float mine = 0.f;
#pragma unroll
        for (int h = 0; h < 8; ++h) mine = (lane == h) ? d[h] : mine;
        if (lane < 8) { const float r = mine + F.in[12][lane]; ((float*)(F.ws + WS_DT))[(size_t)m * 8 + lane] = (r > 20.f) ? r : log1pf(__expf(r)); }
    }
}
constexpr int P0_NT = (NW1 / 32) * (DM / 64) + (1024 / 32) * (DM / 64), P0_NT_ALL = P0_NT + (DM / 32) * (DM / 64);
__device__ __forceinline__ void p0_wot(Frame& F, int wi, int nw_total) {
    LAS float* scr = (LAS float*)(F.lds + F.wave * 8448); float ta[32]; const int lane = F.lane;
    for (int it = P0_NT + wi; it < P0_NT_ALL; it += nw_total) { const TItem ia = p0_item(F, it, lane); p0_item_load(ta, ia); p0_item_store(ta, ia, scr, lane); }
}
__device__ __forceinline__ void p0_wot_chunk(Frame& F, int ci) {
    LAS float* scr = (LAS float*)(F.lds + F.wave * 8448); float ta[32]; const int lane = F.lane;
#pragma unroll 1
    for (int k = 0; k < 2; ++k) { const TItem ia = p0_item(F, P0_NT + ci * 16 + F.wave * 2 + k, lane); p0_item_load(ta, ia); p0_item_store(ta, ia, scr, lane); }
}
__device__ __forceinline__ void p0_prologue(Frame& F) {
#if PROF
    unsigned long long tlast; asm volatile("s_memtime %0\n\ts_waitcnt lgkmcnt(0)" : "=s"(tlast) :: "memory");
#define PSTAMP(k) do { unsigned long long t_; asm volatile("s_memtime %0\n\ts_waitcnt lgkmcnt(0)" : "=s"(t_) :: "memory"); F.tacc[k] += t_ - tlast; tlast = t_; } while (0)
#else
#define PSTAMP(k) do { } while (0)
#endif
    const int lane = F.lane;
    LAS float* scr = (LAS float*)(F.lds + F.wave * 8448);
    LAS float* wdt = (LAS float*)(F.lds + 69632);
    const int gw = F.vcu * NWAVES + F.wave, NGW = F.G * NWAVES;
    for (int idx = F.tid; idx < DM * 8; idx += NTHR) { const int k = idx >> 3, h = idx & 7; wdt[h * DM + k] = F.in[4][(size_t)k * DIN + 5632 + h]; }
    __syncthreads();
    PSTAMP(0);
    constexpr int NT = P0_NT;
    { float ta[32], tb[32]; TItem ia, ib; int it = gw;
      if (it < NT) { ia = p0_item(F, it, lane); p0_item_load(ta, ia); }
      for (; it < NT; it += 2 * NGW) {
          const int n1 = it + NGW, n2 = n1 + NGW;
          if (n1 < NT) { ib = p0_item(F, n1, lane); p0_item_load(tb, ib); }
          p0_item_store(ta, ia, scr, lane);
          if (n2 < NT) { ia = p0_item(F, n2, lane); p0_item_load(ta, ia); }
          if (n1 < NT) p0_item_store(tb, ib, scr, lane);
      } }
    PSTAMP(1);
    { f32x4 va[8], vb[8]; int m = gw; constexpr int NR = M + MM;
      if (m < NR) p0_row_load(va, F, m, lane);
      for (; m < NR; m += 2 * NGW) {
          const int m1 = m + NGW, m2 = m1 + NGW;
          if (m1 < NR) p0_row_load(vb, F, m1, lane);
          p0_row_finish(va, F, m, wdt, lane);
          if (m2 < NR) p0_row_load(va, F, m2, lane);
          if (m1 < NR) p0_row_finish(vb, F, m1, wdt, lane);
      } }
    PSTAMP(2);
    { const int* pos = (const int*)F.in[2]; float* rope = (float*)(F.ws + WS_ROPE);
      for (int idx = (F.vcu * NTHR + F.tid); idx < M * 32; idx += F.G * NTHR) { const int t = idx >> 5, f = idx & 31;
          const float inv = 1.0f / powf(10000.f, (float)(2 * f) / 64.f); const float ang = (float)pos[t] * inv;
          rope[2 * idx] = cosf(ang); rope[2 * idx + 1] = sinf(ang); } }
    PSTAMP(3);
    __syncthreads();
    PSTAMP(4);
}

constexpr int CW_P1DONE = 10240, CW_P2AQ = 10304, CW_P2BQ = 10368  , P1_EARLY_UNITS = 272;
struct Sched1 {
    int G, c; const char *HN, *W1T, *MEMN, *WKVT; unsigned* cnt;
    __device__ __forceinline__ bool next(int i, pg8::Unit& u) const {
        const long L = (long)i * G + c; if (L >= 848) return false;
        if (L < 256) {
            int wgid = (int)L; { const int xcd = wgid % 8, off = wgid / 8; wgid = xcd * 32 + off; }
            const int pm = (wgid / 64) * 8 + ((wgid % 64) % 8), pn = 14 + (wgid % 64) / 8;
            u.kind = 0; u.pm = pm; u.pn = pn; u.a = HN + (size_t)pm * TSTEP; u.b = W1T + (size_t)pn * TSTEP;
        } else if (L < 264) { const int r = (int)L - 256;
            u.kind = 2; u.pm = r & 3; u.pn = r >> 2; u.a = MEMN + (size_t)u.pm * TSTEP; u.b = WKVT + (size_t)u.pn * TSTEP;
        } else if (L < 272) { const int r = (int)L - 264;
            u.kind = 3; u.pm = r & 1; u.pn = r >> 1; u.a = WKVT + (size_t)(2 + u.pm) * TSTEP; u.b = MEMN + (size_t)u.pn * TSTEP;
        } else if (L < 720) {
            int wgid = (int)L - 272; { const int xcd = wgid % 8, off = wgid / 8; wgid = xcd * 56 + off; }
            const int pm = (wgid / 112) * 8 + ((wgid % 112) % 8), pn = (wgid % 112) / 8;
            u.kind = 0; u.pm = pm; u.pn = pn; u.a = HN + (size_t)pm * TSTEP; u.b = W1T + (size_t)pn * TSTEP;
        } else { const int r = (int)L - 720;
            u.kind = 1; u.pm = r & 3; u.pn = r >> 2; u.a = W1T + (size_t)(22 + u.pm) * TSTEP; u.b = HN + (size_t)u.pn * TSTEP; }
        return true;
    }
    __device__ __forceinline__ void a_ready(const pg8::Unit&) const {}
    __device__ __forceinline__ void done(const pg8::Unit& u) const {
        if (u.kind == 2 || u.kind == 3 || (u.kind == 0 && u.pn >= 14)) {
            asm volatile("s_waitcnt vmcnt(0)\n\ts_barrier" ::: "memory");
            if (threadIdx.x == 0) { __builtin_amdgcn_fence(__ATOMIC_RELEASE, "agent"); asm volatile("s_waitcnt vmcnt(0)" ::: "memory");
                __hip_atomic_fetch_add(cnt, 1u, __ATOMIC_RELAXED, __HIP_MEMORY_SCOPE_AGENT); }
        }
    }
};
struct EpiP1 {
    static constexpr bool PERM = true, AFTER_DRAIN = false;
    unsigned char* ws;
    __device__ __forceinline__ void operator()(const pg8::f32x4 (&acc)[2][2][4][2], const pg8::Unit& u, int wr, int wc, int fr, int fq) const {
        bf16* base; int ldc, op = 0, colt; float sc = 1.f;
        if (u.kind == 0) { const int pn = u.pn;
            if (pn < 4) { base = (bf16*)(ws + WS_Q); ldc = 1024; colt = pn * 256; op = 2; sc = C2Q; }
            else if (pn < 8) { base = (bf16*)(ws + WS_K); ldc = 1024; colt = (pn - 4) * 256; op = 2; }
            else if (pn < 12) { base = (bf16*)(ws + WS_G); ldc = 1024; colt = (pn - 8) * 256; op = 1; }
            else if (pn < 14) { base = (bf16*)(ws + WS_Z); ldc = 512; colt = (pn - 12) * 256; op = 1; }
            else if (pn < 18) { base = (bf16*)(ws + WS_XBC); ldc = 1024; colt = (pn - 14) * 256; }
            else if (pn < 20) { base = (bf16*)(ws + WS_XQ); ldc = 512; colt = (pn - 18) * 256; sc = C2X; }
            else { base = (bf16*)(ws + WS_XG); ldc = 512; colt = (pn - 20) * 256; op = 1; }
        } else if (u.kind == 1) { base = (bf16*)(ws + WS_VT); ldc = M; colt = u.pn * 256; }
        else if (u.kind == 2) { base = (bf16*)(ws + WS_MK); ldc = 512; colt = u.pn * 256; }
        else { base = (bf16*)(ws + WS_MVT); ldc = MM; colt = u.pn * 256; }
        const int row0 = u.pm * 256 + wr * 64 + fr, col0 = colt + wc * 32 + 8 * fq;
        const float* rope = (const float*)(ws + WS_ROPE); const int i0 = 8 * (wc & 1) + 2 * fq;
#pragma unroll
        for (int ai = 0; ai < 2; ++ai)
#pragma unroll
            for (int m = 0; m < 4; ++m) { const int row = row0 + ai * 128 + m * 16; bf16* rowp = base + (size_t)row * ldc + col0;
                f32x4 cs0 = {1.f, 0.f, 1.f, 0.f}, cs1 = {1.f, 0.f, 1.f, 0.f};
                if (op == 2) { cs0 = *(const f32x4*)(rope + ((size_t)row * 32 + 2 * i0) * 2); cs1 = *(const f32x4*)(rope + ((size_t)row * 32 + 2 * i0 + 2) * 2); }
#pragma unroll
                for (int bj = 0; bj < 2; ++bj) { f32x4 v0 = acc[ai][bj][m][0], v1 = acc[ai][bj][m][1];
                    if (op == 1) { v0 = (f32x4){silu_f(v0[0]), silu_f(v0[1]), silu_f(v0[2]), silu_f(v0[3])}; v1 = (f32x4){silu_f(v1[0]), silu_f(v1[1]), silu_f(v1[2]), silu_f(v1[3])}; }
                    if (op == 2) {
                        v0 = (f32x4){v0[0] * cs0[0] - v0[2] * cs0[1], v0[1] * cs0[2] - v0[3] * cs0[3], v0[2] * cs0[0] + v0[0] * cs0[1], v0[3] * cs0[2] + v0[1] * cs0[3]};
                        v1 = (f32x4){v1[0] * cs1[0] - v1[2] * cs1[1], v1[1] * cs1[2] - v1[3] * cs1[3], v1[2] * cs1[0] + v1[0] * cs1[1], v1[3] * cs1[2] + v1[1] * cs1[3]}; }
                    v0 = v0 * sc; v1 = v1 * sc;
                    v4u w; w.x = pg8::cvt_pk_bf16(v0[0], v0[1]); w.y = pg8::cvt_pk_bf16(v0[2], v0[3]); w.z = pg8::cvt_pk_bf16(v1[0], v1[1]); w.w = pg8::cvt_pk_bf16(v1[2], v1[3]);
                    *(v4u*)(rowp + bj * 128) = w; } }
    }
};
#define XB_TMO      128
#define XB_XCNT(j)  (256  + 64 * (j))
#define XB_XSUB(j)  (1280 + 64 * (j))
#define XB_XGEN(j)  (2304 + 64 * (j))
#define XB_TOP      3328
#define XB_TOPGEN   3392
#define XCD_BAR_WORDS 3456
#define XB_SPIN_CAP (1u << 18)

__device__ __forceinline__ unsigned xb_ld(unsigned* p)              { return __hip_atomic_load(p, __ATOMIC_RELAXED, __HIP_MEMORY_SCOPE_AGENT); }
__device__ __forceinline__ unsigned xb_add(unsigned* p, unsigned v) { return __hip_atomic_fetch_add(p, v, __ATOMIC_RELAXED, __HIP_MEMORY_SCOPE_AGENT); }
__device__ __forceinline__ unsigned xb_xcc_id() { return (unsigned)__builtin_amdgcn_s_getreg((3 << 11) | 20) & 0xFu; }
#define XB_SPIN(cond, bar) do { unsigned _sp = 0; while (cond) { __builtin_amdgcn_s_sleep(1); \
    if ((++_sp & 255u) == 0u) { if (xb_ld(&(bar)[XB_TMO])) break; if (_sp > XB_SPIN_CAP) { atomicAdd(&(bar)[XB_TMO], 1u); break; } } } } while (0)

struct XcdBarrier {
    unsigned* bar; unsigned x;
    volatile LAS unsigned* st;
};

__device__ __forceinline__ XcdBarrier xcd_barrier_post(unsigned* bar, volatile LAS unsigned* st) {
    XcdBarrier b; b.bar = bar; b.x = xb_xcc_id(); b.st = st;
    if (threadIdx.x == 0) (void)xb_add(&bar[XB_XCNT(b.x)], 1u);
    return b;
}
__device__ __forceinline__ void xcd_barrier_complete(unsigned* bar, unsigned x, unsigned& nloc, unsigned& nx) {
    const unsigned G = gridDim.x * gridDim.y * gridDim.z;
    unsigned sum, cnt, mine, sp = 0u;
    for (;;) {
        sum = 0u; cnt = 0u; mine = 0u;
#pragma unroll
        for (unsigned j = 0; j < 16; ++j) { const unsigned c = xb_ld(&bar[XB_XCNT(j)]); sum += c; cnt += (c > 0u) ? 1u : 0u; mine = (j == x) ? c : mine; }
        if (sum == G) break;
        __builtin_amdgcn_s_sleep(1);
        if ((++sp & 255u) == 0u) { if (xb_ld(&bar[XB_TMO])) break; if (sp > XB_SPIN_CAP) { atomicAdd(&bar[XB_TMO], 1u); break; } }
    }
    nloc = mine > 0u ? mine : 1u; nx = cnt > 0u ? cnt : 1u;
}

__device__ __forceinline__ void xcd_barrier(const XcdBarrier& b) {
    asm volatile("s_waitcnt vmcnt(0)" ::: "memory");
    __syncthreads();
    if (threadIdx.x == 0) {
        unsigned* bar = b.bar;
        __builtin_amdgcn_s_waitcnt(0);
        unsigned nloc = b.st[0], nx = b.st[1];
        if (nloc == 0u) { xcd_barrier_complete(bar, b.x, nloc, nx); b.st[0] = nloc; b.st[1] = nx; }
        const unsigned old = xb_add(&bar[XB_XSUB(b.x)], 1u);
        const unsigned gen = old / nloc;
        if (old + 1u == (gen + 1u) * nloc) {
            __builtin_amdgcn_fence(__ATOMIC_RELEASE, "agent");
            asm volatile("s_waitcnt vmcnt(0)" ::: "memory");
            const unsigned og = xb_add(&bar[XB_TOP], 1u);
            const unsigned tg = og / nx;
            if (og + 1u == (tg + 1u) * nx) xb_add(&bar[XB_TOPGEN], 1u);
            else XB_SPIN(xb_ld(&bar[XB_TOPGEN]) == tg, bar);
            __builtin_amdgcn_fence(__ATOMIC_ACQUIRE, "agent");
            xb_add(&bar[XB_XGEN(b.x)], 1u);
            asm volatile("s_waitcnt vmcnt(0)" ::: "memory");
        } else {
            XB_SPIN(xb_ld(&bar[XB_XGEN(b.x)]) == gen, bar);
            __builtin_amdgcn_fence(__ATOMIC_ACQUIRE, "agent");
            asm volatile("s_waitcnt vmcnt(0)" ::: "memory");
        }
    }
    __syncthreads();
}
namespace att {
#ifndef PROF
#define PROF 0
#endif
#if PROF
#define STAMP(k) do { unsigned long long t_; asm volatile("s_memtime %0\n\ts_waitcnt lgkmcnt(0)" : "=s"(t_) :: "memory"); F_tacc[k] += t_ - tlast; tlast = t_; } while (0)
#else
#define STAMP(k) do { } while (0)
#endif
constexpr int STAGE = 32768;
__device__ __forceinline__ int k_off(int row, int ch) { return row * 256 + ((ch ^ (row & 15)) << 4); }
__device__ __forceinline__ int v_off(int row, int ch) { return 16384 + (row >> 1) * 256 + ((((row & 1) << 3) | (ch ^ ((row >> 1) & 7))) << 4); }
__device__ __forceinline__ int pi32(int i) { return (i & 0x13) | ((i & 4) << 1) | ((i & 8) >> 1); }
__device__ __forceinline__ float other_half(float v) {
    return __shfl_xor(v, 32);
}
__device__ __forceinline__ unsigned cvtpk(float lo, float hi) { typedef float f2 __attribute__((ext_vector_type(2))); typedef __bf16 b2 __attribute__((ext_vector_type(2))); f2 v = {lo, hi}; b2 b = __builtin_convertvector(v, b2); return __builtin_bit_cast(unsigned, b); }
constexpr int NST = 4;
struct Stager {
    const bf16* ks[2]; const bf16* vs[2]; size_t kstep; unsigned kd[2], vd[2];
    __device__ __forceinline__ void init(const bf16* Kp, int ldk, const bf16* VTp, int ldv, int wave, int lane) {
#pragma unroll
        for (int i = 0; i < 2; ++i) { const int pc = wave * 2 + i;
            const int row = 4 * pc + (lane >> 4), ch = (lane & 15) ^ (row & 15);
            ks[i] = Kp + (size_t)row * ldk + ch * 8; kd[i] = pc * 1024;
            const int line = 4 * pc + (lane >> 4), slot = lane & 15, vrow = 2 * line + (slot >> 3), vch = (slot & 7) ^ (line & 7);
            vs[i] = VTp + (size_t)vrow * ldv + vch * 8; vd[i] = 16384 + pc * 1024; }
        kstep = (size_t)64 * ldk;
    }
    __device__ __forceinline__ void issue(LAS unsigned char* lds, int t) const {
        LAS unsigned char* buf = lds + (t & (NST - 1)) * STAGE;
#pragma unroll
        for (int i = 0; i < 2; ++i) {
            __builtin_amdgcn_global_load_lds((const unsigned*)(ks[i] + (size_t)t * kstep), (LAS unsigned*)(buf + kd[i]), 16, 0, 0);
            __builtin_amdgcn_global_load_lds((const unsigned*)(vs[i] + (size_t)t * 64), (LAS unsigned*)(buf + vd[i]), 16, 0, 0); }
    }
};
__device__ __forceinline__ void wait_bar(int ahead) {
    if (ahead >= 2) asm volatile("s_waitcnt vmcnt(8)\n\ts_barrier" ::: "memory");
    else if (ahead == 1) asm volatile("s_waitcnt vmcnt(4)\n\ts_barrier" ::: "memory");
    else asm volatile("s_waitcnt vmcnt(0)\n\ts_barrier" ::: "memory");
}
__device__ __forceinline__ float swap_max(float v) { auto r = __builtin_amdgcn_permlane32_swap(__float_as_uint(v), __float_as_uint(v), false, false); return fmaxf(__uint_as_float(r[0]), __uint_as_float(r[1])); }
__device__ __forceinline__ float swap_sum(float v) { auto r = __builtin_amdgcn_permlane32_swap(__float_as_uint(v), __float_as_uint(v), false, false); return __uint_as_float(r[0]) + __uint_as_float(r[1]); }
template <int KSTEPS, bool CAUSAL>
__device__ __forceinline__ void attn_core(LAS unsigned char* lds, const bf16* Qw, int ldq, const bf16* Kp, int ldk, const bf16* VTp, int ldv, int ntiles, int q0rel, int coff,
                                          f32x16 (&o)[4], float& l_out, int wave, int lane, unsigned long long* F_tacc) {
    const int r32 = lane & 31, hi = lane >> 5; const bool trail = wave >= 4;
#if PROF
    unsigned long long tlast; asm volatile("s_memtime %0\n\ts_waitcnt lgkmcnt(0)" : "=s"(tlast) :: "memory");
#endif
    bf16x8 qf[KSTEPS];
#pragma unroll
    for (int ks = 0; ks < KSTEPS; ++ks) qf[ks] = *(const GAS bf16x8*)(Qw + (size_t)r32 * ldq + ks * 16 + hi * 8);
    Stager sg; sg.init(Kp, ldk, VTp, ldv, wave, lane);
    asm volatile("s_waitcnt vmcnt(0)" ::: "memory");
#pragma unroll
    for (int t = 0; t < NST - 1; ++t) if (t < ntiles) sg.issue(lds, t);
#pragma unroll
    for (int d = 0; d < 4; ++d)
#pragma unroll
        for (int r = 0; r < 16; ++r) o[d][r] = 0.f;
    float mref = 0.f, l = 0.f;
    f32x16 negm;
#pragma unroll
    for (int r = 0; r < 16; ++r) negm[r] = 0.f;
    const int krow = pi32(r32), kch0 = (coff >> 3) + hi;
    STAMP(0);
    if (trail) wait_bar(ntiles - 1);
    for (int t = 0; t < ntiles; ++t) {
        if (!trail) wait_bar(ntiles - 1 - t); else asm volatile("s_barrier" ::: "memory");
        STAMP(1);
        if (trail && t + NST - 1 < ntiles) sg.issue(lds, t + NST - 1);
        LAS unsigned char* buf = lds + (t & (NST - 1)) * STAGE;
        const int kv0 = t * 64;
        const bool active = !CAUSAL || (kv0 <= q0rel + 31);
        v4u pw[4]; f32x16 pa, pb;
        if (active) {
            f32x16 p0 = negm, p1 = negm;
#pragma unroll
            for (int kb = 0; kb < KSTEPS; kb += 4) {
                bf16x8 kf[8];
#pragma unroll
                for (int ks = 0; ks < 4; ++ks) { kf[2 * ks] = *(const LAS bf16x8*)(buf + k_off(krow, kch0 + 2 * (kb + ks))); kf[2 * ks + 1] = *(const LAS bf16x8*)(buf + k_off(32 + krow, kch0 + 2 * (kb + ks))); }
                __builtin_amdgcn_sched_barrier(0);
#pragma unroll
                for (int ks = 0; ks < 4; ++ks) {
                    p0 = __builtin_amdgcn_mfma_f32_32x32x16_bf16(kf[2 * ks], qf[kb + ks], p0, 0, 0, 0);
                    p1 = __builtin_amdgcn_mfma_f32_32x32x16_bf16(kf[2 * ks + 1], qf[kb + ks], p1, 0, 0, 0);
                }
            }
            if (CAUSAL && (kv0 + 63 > q0rel)) {
                const int qg = q0rel + r32;
#pragma unroll
                for (int r = 0; r < 16; ++r) { const int kv = kv0 + 16 * (r >> 3) + 8 * hi + (r & 7); if (kv > qg) p0[r] = -INFINITY; if (kv + 32 > qg) p1[r] = -INFINITY; }
            }
            float ra = fmaxf(fmaxf(p0[0], p0[1]), p1[0]), rb = fmaxf(fmaxf(p0[2], p0[3]), p1[1]);
            ra = fmaxf(fmaxf(ra, p1[2]), p1[3]);
#pragma unroll
            for (int r = 4; r < 16; r += 4) { ra = fmaxf(fmaxf(ra, p0[r]), p0[r + 1]); rb = fmaxf(fmaxf(rb, p0[r + 2]), p0[r + 3]); ra = fmaxf(fmaxf(ra, p1[r]), p1[r + 1]); rb = fmaxf(fmaxf(rb, p1[r + 2]), p1[r + 3]); }
            const float rm = swap_max(fmaxf(ra, rb));
            if (t == 0) {
                mref = rm;
#pragma unroll
                for (int r = 0; r < 16; ++r) { p0[r] -= rm; p1[r] -= rm; negm[r] = -rm; }
            } else if (__any(rm > 8.f)) {
                const float dl = fmaxf(rm, 0.f), al = __builtin_amdgcn_exp2f(-dl);
                mref += dl; l *= al;
#pragma unroll
                for (int r = 0; r < 16; ++r) { p0[r] -= dl; p1[r] -= dl; negm[r] = -mref; }
#pragma unroll
                for (int d = 0; d < 4; ++d)
#pragma unroll
                    for (int r = 0; r < 16; ++r) o[d][r] *= al;
            }
#pragma unroll
            for (int r = 0; r < 16; ++r) p0[r] = __builtin_amdgcn_exp2f(p0[r]);
#pragma unroll
            for (int s = 0; s < 2; ++s)
                pw[s] = (v4u){cvtpk(p0[8 * s], p0[8 * s + 1]), cvtpk(p0[8 * s + 2], p0[8 * s + 3]), cvtpk(p0[8 * s + 4], p0[8 * s + 5]), cvtpk(p0[8 * s + 6], p0[8 * s + 7])};
            pa = p0; pb = p1;
        }
        STAMP(2);
        if (!trail) asm volatile("s_barrier" ::: "memory"); else if (t + 1 < ntiles) wait_bar(ntiles - 2 - t); else asm volatile("s_barrier" ::: "memory");
        STAMP(3);
        if (!trail && t + NST - 1 < ntiles) sg.issue(lds, t + NST - 1);
        if (active) {
            bf16x8 vf[8];
#pragma unroll
            for (int ks = 0; ks < 2; ++ks)
#pragma unroll
                for (int d = 0; d < 4; ++d) vf[4 * ks + d] = *(const LAS bf16x8*)(buf + v_off(32 * d + r32, 2 * ks + hi));
            float ls = 0.f;
#pragma unroll
            for (int r = 0; r < 16; ++r) { pb[r] = __builtin_amdgcn_exp2f(pb[r]); ls += pa[r]; }
#pragma unroll
            for (int ks = 0; ks < 2; ++ks)
#pragma unroll
                for (int d = 0; d < 4; ++d) o[d] = __builtin_amdgcn_mfma_f32_32x32x16_bf16(vf[4 * ks + d], __builtin_bit_cast(bf16x8, pw[ks]), o[d], 0, 0, 0);
#pragma unroll
            for (int ks = 2; ks < 4; ++ks)
#pragma unroll
                for (int d = 0; d < 4; ++d) vf[4 * (ks - 2) + d] = *(const LAS bf16x8*)(buf + v_off(32 * d + r32, 2 * ks + hi));
#pragma unroll
            for (int s = 0; s < 2; ++s)
                pw[2 + s] = (v4u){cvtpk(pb[8 * s], pb[8 * s + 1]), cvtpk(pb[8 * s + 2], pb[8 * s + 3]), cvtpk(pb[8 * s + 4], pb[8 * s + 5]), cvtpk(pb[8 * s + 6], pb[8 * s + 7])};
#pragma unroll
            for (int r = 0; r < 16; ++r) ls += pb[r];
            l += ls;
#pragma unroll
            for (int ks = 2; ks < 4; ++ks)
#pragma unroll
                for (int d = 0; d < 4; ++d) o[d] = __builtin_amdgcn_mfma_f32_32x32x16_bf16(vf[4 * (ks - 2) + d], __builtin_bit_cast(bf16x8, pw[ks]), o[d], 0, 0, 0);
        }
        STAMP(4);
    }
    if (!trail) asm volatile("s_barrier" ::: "memory");
    asm volatile("s_waitcnt lgkmcnt(0)\n\ts_barrier" ::: "memory");
    l_out = swap_sum(l);
    STAMP(5);
}
__device__ __forceinline__ int crow(int r, int hi) { return (r & 3) + 8 * (r >> 2) + 4 * hi; }

__device__ __forceinline__ void diff_unit(Frame& F, int b, int h, int qb, float lam) {
    unsigned char* ws = F.ws; int tid_ = F.tid; asm volatile("" : "+v"(tid_)); const int w = F.wave, c = w >> 2, sb = w & 3, lane = tid_ & 63, r32 = lane & 31, hi = lane >> 5;
    const int q0 = qb * 128, q0w = q0 + 32 * sb; const size_t trow0 = (size_t)b * SEQ;
    const bf16* Qw = (const bf16*)(ws + WS_Q) + (trow0 + q0w) * 1024 + h * 128 + c * 64;
    const bf16* Kp = (const bf16*)(ws + WS_K) + trow0 * 1024 + h * 128;
    const bf16* VTp = (const bf16*)(ws + WS_VT) + (size_t)(h * 128) * M + trow0;
    f32x16 o[4]; float l;
#if PROF
    { unsigned long long t_; asm volatile("s_memtime %0\n\ts_waitcnt lgkmcnt(0)" : "=s"(t_) :: "memory"); F.tacc[7] = t_; }
#endif
    attn_core<4, true>(F.lds, Qw, 1024, Kp, 1024, VTp, M, (q0 + 128) / 64, q0w, c * 64, o, l, w, lane, F.tacc);
    const float inv = 1.f / l;
    LAS float* xch = (LAS float*)F.lds + sb * 4096 + lane;
    if (c == 1) {
        const float f = lam * inv;
#pragma unroll
        for (int d = 0; d < 4; ++d)
#pragma unroll
            for (int r = 0; r < 16; ++r) xch[(d * 16 + r) * 64] = o[d][r] * f;
    }
    __syncthreads();
    if (c == 0) {
        float ss = 0.f;
#pragma unroll
        for (int d = 0; d < 4; ++d)
#pragma unroll
            for (int r = 0; r < 16; ++r) { const float v = o[d][r] * inv - xch[(d * 16 + r) * 64]; o[d][r] = v; ss += v * v; }
        ss = swap_sum(ss);
        const float rs = rsqrtf(ss * (1.f / 128.f) + EPS) * (1.f - LAMBDA_INIT);
        const size_t t = trow0 + q0w + r32;
        const bf16* Gp = (const bf16*)(ws + WS_G) + t * 1024 + h * 128; bf16* Op = (bf16*)(ws + WS_MIXED) + t * 2048 + h * 128;
        const float* sw = F.in[9];
#pragma unroll
        for (int d = 0; d < 4; ++d)
#pragma unroll
            for (int rg = 0; rg < 4; ++rg) { const int dv = 32 * d + 8 * rg + 4 * hi;
                const v2u g = *(const GAS v2u*)(Gp + dv); const f32x4 wv = *(const GAS f32x4*)(sw + dv);
                v2u ov; ov.x = pk2(o[d][4 * rg] * rs * wv[0] * bflo(g.x), o[d][4 * rg + 1] * rs * wv[1] * bfhi(g.x));
                ov.y = pk2(o[d][4 * rg + 2] * rs * wv[2] * bflo(g.y), o[d][4 * rg + 3] * rs * wv[3] * bfhi(g.y));
                *(GAS v2u*)(Op + dv) = ov; }
    }
    __syncthreads();
#if PROF
    { unsigned long long t_; asm volatile("s_memtime %0\n\ts_waitcnt lgkmcnt(0)" : "=s"(t_) :: "memory"); F.tacc[6] += t_ - F.tacc[7]; }
#endif
}
__device__ __forceinline__ void xattn_unit(Frame& F, int b, int h, int qb) {
    unsigned char* ws = F.ws; int tid_ = F.tid; asm volatile("" : "+v"(tid_)); const int w = F.wave, lane = tid_ & 63, r32 = lane & 31, hi = lane >> 5;
    const int q0w = qb * 256 + 32 * w; const size_t trow0 = (size_t)b * SEQ;
    const bf16* Qw = (const bf16*)(ws + WS_XQ) + (trow0 + q0w) * 512 + h * 128;
    const bf16* Kp = (const bf16*)(ws + WS_MK) + (size_t)(b * MEMLEN) * 512 + h * 128;
    const bf16* VTp = (const bf16*)(ws + WS_MVT) + (size_t)(h * 128) * MM + b * MEMLEN;
    f32x16 o[4]; float l;
    attn_core<8, false>(F.lds, Qw, 512, Kp, 512, VTp, MM, MEMLEN / 64, 0, 0, o, l, w, lane, F.tacc);
    const float inv = 1.f / l; const size_t t = trow0 + q0w + r32;
    const bf16* Gp = (const bf16*)(ws + WS_XG) + t * 512 + h * 128; bf16* Op = (bf16*)(ws + WS_MIXED) + t * 2048 + 1536 + h * 128;
#pragma unroll
    for (int d = 0; d < 4; ++d)
#pragma unroll
        for (int rg = 0; rg < 4; ++rg) { const int dv = 32 * d + 8 * rg + 4 * hi;
            const v2u g = *(const GAS v2u*)(Gp + dv);
            v2u ov; ov.x = pk2(o[d][4 * rg] * inv * bflo(g.x), o[d][4 * rg + 1] * inv * bfhi(g.x));
            ov.y = pk2(o[d][4 * rg + 2] * inv * bflo(g.y), o[d][4 * rg + 3] * inv * bfhi(g.y));
            *(GAS v2u*)(Op + dv) = ov; }
}
}
namespace ssd {
#if PROF
#define BSTAMP(k) do { unsigned long long t_; asm volatile("s_memtime %0\n\ts_waitcnt lgkmcnt(0)" : "=s"(t_) :: "memory"); F.tacc[k] += t_ - tlast; tlast = t_; } while (0)
#else
#define BSTAMP(k) do { } while (0)
#endif
using att::k_off; using att::pi32; using att::crow; using att::other_half;
__device__ __forceinline__ v4u pack8(const float (&s)[8]) { return (v4u){att::cvtpk(s[0], s[1]), att::cvtpk(s[2], s[3]), att::cvtpk(s[4], s[5]), att::cvtpk(s[6], s[7])}; }
__device__ __forceinline__ void unitA(Frame& F, int b, int c, int g) {
    unsigned char* ws = F.ws; int tid_ = F.tid; asm volatile("" : "+v"(tid_)); const int tid = tid_, lane = tid & 63, w = F.wave, r32 = lane & 31, hi = lane >> 5;
    const size_t t0 = (size_t)b * SEQ + c * 128;
#if PROF
    unsigned long long tlast; asm volatile("s_memtime %0\n\ts_waitcnt lgkmcnt(0)" : "=s"(tlast) :: "memory");
#endif
    LAS unsigned char* tile = F.lds;
    LAS float* tab = (LAS float*)(F.lds + 98304);
    const float* DTg = (const float*)(ws + WS_DT); float* ACSg = (float*)(ws + WS_ACS);
    { const int hh = tid >> 7, l = tid & 127, h = g * 4 + hh;
      const float dt = DTg[(t0 + l) * 8 + h]; float v = dt * (-__expf(F.in[13][h]));
#pragma unroll
      for (int o = 1; o < 64; o <<= 1) { const float t = __shfl_up(v, o); if (lane >= o) v += t; }
      if ((w & 1) == 0 && lane == 63) tab[1536 + hh] = v;
      __syncthreads();
      if (w & 1) v += tab[1536 + hh];
      tab[hh * 128 + l] = dt; tab[512 + hh * 128 + l] = v; ACSg[(t0 + l) * 8 + h] = v;
      __syncthreads();
      tab[1024 + hh * 128 + l] = dt * __expf(tab[512 + hh * 128 + 127] - v);
      __syncthreads(); }
    BSTAMP(0);
    { const int ch = tid; const int col = (ch < 256) ? g * 256 + ch : (ch < 384) ? 512 + g * 128 + (ch - 256) : 768 + g * 128 + (ch - 384);
      const float* cw = F.in[10]; const float w0 = cw[col], w1 = cw[1024 + col], w2 = cw[2048 + col], w3 = cw[3072 + col], bias = F.in[11][col];
      const bf16* src = (const bf16*)(ws + WS_XBC) + t0 * 1024 + col;
      float xx[11]; xx[0] = xx[1] = xx[2] = 0.f;
      if (c > 0) { xx[0] = bf2f(src[-3 * 1024]); xx[1] = bf2f(src[-2 * 1024]); xx[2] = bf2f(src[-1 * 1024]); }
      bf16* XTg = (bf16*)(ws + WS_XT) + ((size_t)(b * 16 + c) * 512 + g * 256 + ch) * 128;
      bf16* BCg = (bf16*)(ws + WS_BC) + t0 * 512 + ((ch < 384) ? g * 128 + (ch - 256) : 256 + g * 128 + (ch - 384));
      const int hh = (ch >> 6) & 3;
#pragma unroll 1
      for (int half = 0; half < 4; ++half) {
          bf16 raw[32];
#pragma unroll
          for (int j = 0; j < 32; ++j) raw[j] = src[(size_t)(half * 32 + j) * 1024];
#pragma unroll
          for (int lq = 0; lq < 4; ++lq) { const int lg = half * 4 + lq;
#pragma unroll
              for (int j = 0; j < 8; ++j) xx[3 + j] = bf2f(raw[lq * 8 + j]);
              float s[8];
#pragma unroll
              for (int j = 0; j < 8; ++j) { const float y = bias + w0 * xx[j] + w1 * xx[j + 1] + w2 * xx[j + 2] + w3 * xx[j + 3]; s[j] = y / (1.f + __expf(-y)); }
              xx[0] = xx[8]; xx[1] = xx[9]; xx[2] = xx[10];
              if (ch < 256) {
                  *(GAS v4u*)(XTg + lg * 8) = pack8(s);
                  const f32x4 wa = *(const LAS f32x4*)(tab + 1024 + hh * 128 + lg * 8), wb = *(const LAS f32x4*)(tab + 1024 + hh * 128 + lg * 8 + 4);
                  float sw[8] = {s[0] * wa[0], s[1] * wa[1], s[2] * wa[2], s[3] * wa[3], s[4] * wb[0], s[5] * wb[1], s[6] * wb[2], s[7] * wb[3]};
                  *(LAS v4u*)(tile + k_off(ch, lg)) = pack8(sw);
              } else {
#pragma unroll
                  for (int j = 0; j < 8; ++j) BCg[(size_t)(lg * 8 + j) * 512] = (bf16)f2bf(s[j]);
                  if (ch < 384) *(LAS v4u*)(tile + k_off(ch, lg)) = pack8(s);
              }
          }
      } }
    BSTAMP(1);
    __syncthreads();
    BSTAMP(2);
    { const int hh = w >> 1, nh = w & 1;
      f32x16 acc[2][2];
#pragma unroll
      for (int i = 0; i < 2; ++i)
#pragma unroll
          for (int j = 0; j < 2; ++j)
#pragma unroll
              for (int r = 0; r < 16; ++r) acc[i][j][r] = 0.f;
#pragma unroll
      for (int ks = 0; ks < 8; ++ks) {
          const bf16x8 a0 = *(const LAS bf16x8*)(tile + k_off(hh * 64 + r32, 2 * ks + hi)), a1 = *(const LAS bf16x8*)(tile + k_off(hh * 64 + 32 + r32, 2 * ks + hi));
          const bf16x8 b0 = *(const LAS bf16x8*)(tile + k_off(256 + nh * 64 + r32, 2 * ks + hi)), b1 = *(const LAS bf16x8*)(tile + k_off(256 + nh * 64 + 32 + r32, 2 * ks + hi));
          acc[0][0] = __builtin_amdgcn_mfma_f32_32x32x16_bf16(a0, b0, acc[0][0], 0, 0, 0); acc[0][1] = __builtin_amdgcn_mfma_f32_32x32x16_bf16(a0, b1, acc[0][1], 0, 0, 0);
          acc[1][0] = __builtin_amdgcn_mfma_f32_32x32x16_bf16(a1, b0, acc[1][0], 0, 0, 0); acc[1][1] = __builtin_amdgcn_mfma_f32_32x32x16_bf16(a1, b1, acc[1][1], 0, 0, 0);
      }
      float* cs = (float*)(ws + WS_CS) + (size_t)((b * 16 + c) * 8 + g * 4 + hh) * 8192;
#pragma unroll
      for (int pb = 0; pb < 2; ++pb)
#pragma unroll
          for (int nb = 0; nb < 2; ++nb)
#pragma unroll
              for (int r = 0; r < 16; ++r) cs[(32 * pb + crow(r, hi)) * 128 + nh * 64 + 32 * nb + r32] = acc[pb][nb][r]; }
    BSTAMP(3);
    __syncthreads();
    BSTAMP(4);
}

__device__ __forceinline__ void scan_unit(Frame& F, int b, int h, int sl) {
    unsigned char* ws = F.ws; int tid_ = F.tid; asm volatile("" : "+v"(tid_)); const int e = sl * 1024 + 2 * tid_;
    typedef float f32x2 __attribute__((ext_vector_type(2)));
    const float* CSg = (const float*)(ws + WS_CS) + (size_t)(b * 16 * 8 + h) * 8192 + e; const float* ACSg = (const float*)(ws + WS_ACS);
    unsigned* PVg = (unsigned*)((bf16*)(ws + WS_PREV) + (size_t)(b * 16 * 8 + h) * 8192 + e);
    f32x2 v[15]; float dec[15];
#pragma unroll
    for (int c = 0; c < 15; ++c) { v[c] = *(const GAS f32x2*)(CSg + (size_t)c * 8 * 8192); dec[c] = __expf(ACSg[((size_t)b * SEQ + c * 128 + 127) * 8 + h]); }
    f32x2 s = {0.f, 0.f};
#pragma unroll
    for (int c = 0; c < 16; ++c) { PVg[(size_t)c * 8 * 4096] = att::cvtpk(s[0], s[1]); if (c < 15) s = s * dec[c] + v[c]; }
}
__device__ __forceinline__ void scan_publish(Frame& F, int b, int g) {
    asm volatile("s_waitcnt vmcnt(0)" ::: "memory");
    __syncthreads();
    if (F.tid == 0) { __builtin_amdgcn_fence(__ATOMIC_RELEASE, "agent"); asm volatile("s_waitcnt vmcnt(0)" ::: "memory");
        __hip_atomic_fetch_add((unsigned*)(F.ws + WS_CTL) + 8192 + (b * 2 + g) * 64, 1u, __ATOMIC_RELAXED, __HIP_MEMORY_SCOPE_AGENT); }
}
__device__ __forceinline__ void scan_wait(Frame& F, int b, int g) {
    if (F.tid == 0) { unsigned* p = (unsigned*)(F.ws + WS_CTL) + 8192 + (b * 2 + g) * 64; unsigned sp = 0;
        while (__hip_atomic_load(p, __ATOMIC_RELAXED, __HIP_MEMORY_SCOPE_AGENT) < 32u) { __builtin_amdgcn_s_sleep(2); if (++sp > (1u << 22)) break; }
        __builtin_amdgcn_fence(__ATOMIC_ACQUIRE, "agent"); asm volatile("s_waitcnt vmcnt(0)" ::: "memory"); }
    __syncthreads();
}

__device__ __forceinline__ void unitB(Frame& F, int b, int c, int g, int half) {
    unsigned char* ws = F.ws; int tid_ = F.tid; asm volatile("" : "+v"(tid_)); const int tid = tid_, lane = tid & 63, w = F.wave, r32 = lane & 31, hi = lane >> 5;
    const size_t t0 = (size_t)b * SEQ + c * 128;
#if PROF
    unsigned long long tlast; asm volatile("s_memtime %0\n\ts_waitcnt lgkmcnt(0)" : "=s"(tlast) :: "memory");
#endif
    LAS unsigned char* btile = F.lds;
    LAS unsigned char* xtile = F.lds + 32768;
    LAS float* tab = (LAS float*)(F.lds + 98304);
    const float* DTg = (const float*)(ws + WS_DT); const float* ACSg = (const float*)(ws + WS_ACS);
    const bf16* BCg = (const bf16*)(ws + WS_BC) + t0 * 512;
    const bf16* XTg = (const bf16*)(ws + WS_XT) + ((size_t)(b * 16 + c) * 512 + g * 256) * 128;
    if (c > 0) scan_wait(F, b, g);
#pragma unroll
    for (int i = 0; i < 12; ++i) { const int pc = w * 12 + i;
        const int row = 4 * (pc < 32 ? pc : pc - 32) + (lane >> 4), ch = (lane & 15) ^ (row & 15);
        const bf16* src = (pc < 32) ? BCg + (size_t)row * 512 + g * 128 + ch * 8 : XTg + (size_t)row * 128 + ch * 8;
        __builtin_amdgcn_global_load_lds((const unsigned*)src, (LAS unsigned*)(F.lds + pc * 1024), 16, 0, 0); }
    { const int hq = tid >> 7, l = tid & 127; tab[hq * 128 + l] = DTg[(t0 + l) * 8 + g * 4 + hq]; tab[512 + hq * 128 + l] = ACSg[(t0 + l) * 8 + g * 4 + hq]; }
    BSTAMP(0);
    const int lbi = w >> 2, hh = w & 3, lb = half ? (lbi ? 2 : 1) : (lbi ? 3 : 0), l_loc = 32 * lb + r32;
    const bf16* PVg = (const bf16*)(ws + WS_PREV) + (size_t)((b * 16 + c) * 8 + g * 4 + hh) * 8192;
    bf16x8 cf[8];
#pragma unroll
    for (int ks = 0; ks < 8; ++ks) cf[ks] = *(const GAS bf16x8*)(BCg + (size_t)l_loc * 512 + 256 + g * 128 + 16 * ks + 8 * hi);
    const size_t t = t0 + l_loc; const bf16* Zg = (const bf16*)(ws + WS_Z) + t * 512 + g * 256 + hh * 64;
    v2u zq[2][4];
#pragma unroll
    for (int pb = 0; pb < 2; ++pb)
#pragma unroll
        for (int rg = 0; rg < 4; ++rg) zq[pb][rg] = *(const GAS v2u*)(Zg + 32 * pb + 8 * rg + 4 * hi);
    f32x16 acc[2];
    { bf16x8 pf[2][8];
      if (c > 0) {
#pragma unroll
          for (int pb = 0; pb < 2; ++pb)
#pragma unroll
              for (int ks = 0; ks < 8; ++ks) pf[pb][ks] = *(const GAS bf16x8*)(PVg + (32 * pb + r32) * 128 + 16 * ks + 8 * hi);
      }
#pragma unroll
      for (int pb = 0; pb < 2; ++pb) {
#pragma unroll
          for (int r = 0; r < 16; ++r) acc[pb][r] = 0.f;
          if (c > 0) {
#pragma unroll
              for (int ks = 0; ks < 8; ++ks) acc[pb] = __builtin_amdgcn_mfma_f32_32x32x16_bf16(pf[pb][ks], cf[ks], acc[pb], 0, 0, 0);
              const float e = __expf(ACSg[(t0 + l_loc) * 8 + g * 4 + hh]);
#pragma unroll
              for (int r = 0; r < 16; ++r) acc[pb][r] *= e;
          }
      } }
    BSTAMP(1);
    asm volatile("s_waitcnt vmcnt(0)" ::: "memory"); __syncthreads();
    BSTAMP(2);
    const float acs_l = tab[512 + hh * 128 + l_loc], Dh = F.in[14][g * 4 + hh];
#pragma unroll 1
    for (int sb = 0; sb <= lb; ++sb) {
        f32x16 gt;
#pragma unroll
        for (int r = 0; r < 16; ++r) gt[r] = 0.f;
#pragma unroll
        for (int ks = 0; ks < 8; ++ks) { const bf16x8 bfr = *(const LAS bf16x8*)(btile + k_off(32 * sb + pi32(r32), 2 * ks + hi)); gt = __builtin_amdgcn_mfma_f32_32x32x16_bf16(bfr, cf[ks], gt, 0, 0, 0); }
        float sc[16];
#pragma unroll
        for (int q4 = 0; q4 < 4; ++q4) { const int sbase = 32 * sb + 16 * (q4 >> 1) + 8 * hi + 4 * (q4 & 1);
            const f32x4 as = *(const LAS f32x4*)(tab + 512 + hh * 128 + sbase), ds = *(const LAS f32x4*)(tab + hh * 128 + sbase);
#pragma unroll
            for (int e = 0; e < 4; ++e) { const int r = 4 * q4 + e; float v = gt[r] * __builtin_amdgcn_exp2f(fminf(acs_l - as[e], 0.f) * LOG2E) * ds[e];
                if (sb == lb) { const int sl = 16 * (r >> 3) + 8 * hi + (r & 7); if (sl > r32) v = 0.f; if (sl == r32) v += Dh; }
                sc[r] = v; } }
        v4u scb[2];
        scb[0] = (v4u){att::cvtpk(sc[0], sc[1]), att::cvtpk(sc[2], sc[3]), att::cvtpk(sc[4], sc[5]), att::cvtpk(sc[6], sc[7])};
        scb[1] = (v4u){att::cvtpk(sc[8], sc[9]), att::cvtpk(sc[10], sc[11]), att::cvtpk(sc[12], sc[13]), att::cvtpk(sc[14], sc[15])};
#pragma unroll
        for (int pb = 0; pb < 2; ++pb)
#pragma unroll
            for (int k2 = 0; k2 < 2; ++k2) { const bf16x8 xf = *(const LAS bf16x8*)(xtile + k_off(hh * 64 + 32 * pb + r32, 4 * sb + 2 * k2 + hi));
                acc[pb] = __builtin_amdgcn_mfma_f32_32x32x16_bf16(xf, __builtin_bit_cast(bf16x8, scb[k2]), acc[pb], 0, 0, 0); }
    }
    BSTAMP(3);
    const float* nw = F.in[15] + g * 256 + hh * 64;
    f32x4 wv[2][4];
#pragma unroll
    for (int pb = 0; pb < 2; ++pb)
#pragma unroll
        for (int rg = 0; rg < 4; ++rg) wv[pb][rg] = *(const GAS f32x4*)(nw + 32 * pb + 8 * rg + 4 * hi);
    float ss = 0.f;
#pragma unroll
    for (int pb = 0; pb < 2; ++pb)
#pragma unroll
        for (int rg = 0; rg < 4; ++rg) { const v2u z = zq[pb][rg];
            const float y0 = acc[pb][4 * rg] * bflo(z.x), y1 = acc[pb][4 * rg + 1] * bfhi(z.x), y2 = acc[pb][4 * rg + 2] * bflo(z.y), y3 = acc[pb][4 * rg + 3] * bfhi(z.y);
            acc[pb][4 * rg] = y0; acc[pb][4 * rg + 1] = y1; acc[pb][4 * rg + 2] = y2; acc[pb][4 * rg + 3] = y3;
            ss += (y0 * y0 + y1 * y1) + (y2 * y2 + y3 * y3); }
    ss = att::swap_sum(ss);
    if (hi == 0) tab[1024 + hh * 128 + l_loc] = ss;
    __syncthreads();
    const float rs = rsqrtf(((tab[1024 + l_loc] + tab[1024 + 128 + l_loc]) + (tab[1024 + 256 + l_loc] + tab[1024 + 384 + l_loc])) * (1.f / 256.f) + EPS);
    bf16* Og = (bf16*)(ws + WS_MIXED) + t * 2048 + 1024 + g * 256 + hh * 64;
#pragma unroll
    for (int pb = 0; pb < 2; ++pb)
#pragma unroll
        for (int rg = 0; rg < 4; ++rg) { const f32x4 wq = wv[pb][rg];
            v2u o; o.x = pk2(acc[pb][4 * rg] * rs * wq[0], acc[pb][4 * rg + 1] * rs * wq[1]); o.y = pk2(acc[pb][4 * rg + 2] * rs * wq[2], acc[pb][4 * rg + 3] * rs * wq[3]);
            *(GAS v2u*)(Og + 32 * pb + 8 * rg + 4 * hi) = o; }
    asm volatile("s_waitcnt lgkmcnt(0)\n\ts_barrier" ::: "memory");
    BSTAMP(4);
}
}
struct Sched2 {
    int G, c; const char *A, *B;
    __device__ __forceinline__ bool next(int i, pg8::Unit& u) const {
        const long L = (long)i * G + c; if (L >= 256) return false;
        int wgid = (int)L; { const int xcd = wgid % 8, off = wgid / 8; wgid = xcd * 32 + off; }
        u.pm = (wgid / 64) * 8 + ((wgid % 64) % 8); u.pn = (wgid % 64) / 8; u.kind = 0;
        u.a = A + (size_t)u.pm * TSTEP; u.b = B + (size_t)u.pn * TSTEP; return true;
    }
    __device__ __forceinline__ void a_ready(const pg8::Unit&) const {}
    __device__ __forceinline__ void done(const pg8::Unit&) const {}
};
struct EpiF32 {
    static constexpr bool PERM = false, AFTER_DRAIN = false;
    float* O; int ldc;
    __device__ __forceinline__ void operator()(const pg8::f32x4 (&acc)[2][2][4][2], const pg8::Unit& u, int wr, int wc, int fr, int fq) const {
        const int row0 = u.pm * 256 + wr * 64 + fr, col0 = u.pn * 256 + wc * 32 + 4 * fq;
#pragma unroll
        for (int ai = 0; ai < 2; ++ai)
#pragma unroll
            for (int m = 0; m < 4; ++m) { float* rowp = O + (size_t)(row0 + ai * 128 + m * 16) * ldc + col0;
#pragma unroll
                for (int bj = 0; bj < 2; ++bj)
#pragma unroll
                    for (int n = 0; n < 2; ++n) *(pg8::f32x4*)(rowp + bj * 128 + n * 16) = acc[ai][bj][m][n]; }
    }
};

struct EpiRmsRes {
    static constexpr bool PERM = false, AFTER_DRAIN = true;
    const float* x; const float* w; float* out; float* slots; unsigned* cnt;
    __device__ __forceinline__ void fused(pg8::f32x4 (&acc)[2][2][4][2], const pg8::Unit& u, int wr, int wc, int fr, int fq, PG8_LAS unsigned char* lds, int wid, int lane) const {
        PG8_LAS float* P = (PG8_LAS float*)lds;
        const int col0 = u.pn * 256 + wc * 32 + 4 * fq;
        pg8::f32x4 pre[4][2][2];
#pragma unroll
        for (int m = 0; m < 4; ++m) { const size_t off = (size_t)(u.pm * 256 + wr * 64 + m * 16 + fr) * DM + col0;
#pragma unroll
            for (int bj = 0; bj < 2; ++bj)
#pragma unroll
                for (int n = 0; n < 2; ++n) pre[m][bj][n] = *(const pg8::f32x4*)(x + off + bj * 128 + n * 16); }
        PG8_LAS float* S = (PG8_LAS float*)(lds + 4096);
#pragma unroll
        for (int ai = 0; ai < 2; ++ai)
#pragma unroll
            for (int m = 0; m < 4; ++m) { float s = 0.f;
#pragma unroll
                for (int bj = 0; bj < 2; ++bj)
#pragma unroll
                    for (int n = 0; n < 2; ++n) { const pg8::f32x4 v = acc[ai][bj][m][n]; s += (v[0] * v[0] + v[1] * v[1]) + (v[2] * v[2] + v[3] * v[3]); }
                s += __shfl_xor(s, 16); s += __shfl_xor(s, 32);
                if (fq == 0) P[(ai * 128 + wr * 64 + m * 16 + fr) * 4 + wc] = s; }
        asm volatile("s_waitcnt lgkmcnt(0)" ::: "memory"); __builtin_amdgcn_s_barrier(); asm volatile("" ::: "memory");
        const int row = wid * 32 + (lane & 31);
        if (lane < 32) { const float t = (P[row * 4] + P[row * 4 + 1]) + (P[row * 4 + 2] + P[row * 4 + 3]);
            __hip_atomic_store(slots + (size_t)(u.pm * 256 + row) * 8 + u.pn, t, __ATOMIC_RELAXED, __HIP_MEMORY_SCOPE_AGENT); }
        asm volatile("s_waitcnt vmcnt(0)" ::: "memory");
        if (lane == 0) __hip_atomic_fetch_add(cnt + 64 * u.pm, 1u, __ATOMIC_RELAXED, __HIP_MEMORY_SCOPE_AGENT);
        if (wid == 0) { unsigned sp = 0;
            while ((unsigned)__builtin_amdgcn_readfirstlane(__hip_atomic_load(cnt + 64 * u.pm, __ATOMIC_RELAXED, __HIP_MEMORY_SCOPE_AGENT)) < 64u) { __builtin_amdgcn_s_sleep(2); if (++sp > (1u << 22)) break; }
            __builtin_amdgcn_fence(__ATOMIC_ACQUIRE, "agent"); }
        asm volatile("s_waitcnt vmcnt(0) lgkmcnt(0)" ::: "memory"); __builtin_amdgcn_s_barrier(); asm volatile("" ::: "memory");
        if (lane < 32) { const float* sl = slots + (size_t)(u.pm * 256 + row) * 8; float t = 0.f;
#pragma unroll
            for (int k = 0; k < 8; ++k) t += __hip_atomic_load(sl + k, __ATOMIC_RELAXED, __HIP_MEMORY_SCOPE_AGENT);
            S[row] = rsqrtf(t * (1.f / DM) + EPS); }
        asm volatile("s_waitcnt lgkmcnt(0)" ::: "memory"); __builtin_amdgcn_s_barrier(); asm volatile("" ::: "memory");
        pg8::f32x4 wv[2][2];
#pragma unroll
        for (int bj = 0; bj < 2; ++bj)
#pragma unroll
            for (int n = 0; n < 2; ++n) wv[bj][n] = *(const pg8::f32x4*)(w + col0 + bj * 128 + n * 16);
#pragma unroll
        for (int ai = 0; ai < 2; ++ai)
#pragma unroll
            for (int m = 0; m < 4; ++m) { const int r = ai * 128 + wr * 64 + m * 16 + fr; const float rs = S[r]; const size_t off = (size_t)(u.pm * 256 + r) * DM + col0;
#pragma unroll
                for (int bj = 0; bj < 2; ++bj)
#pragma unroll
                    for (int n = 0; n < 2; ++n) { const pg8::f32x4 xv = ai == 0 ? pre[m][bj][n] : *(const pg8::f32x4*)(x + off + bj * 128 + n * 16);
                        *(pg8::f32x4*)(out + off + bj * 128 + n * 16) = xv + acc[ai][bj][m][n] * rs * wv[bj][n]; }
                if (m & 1) asm volatile("" ::: "memory"); }
    }
};
__device__ __forceinline__ void p5_final(Frame& F) {
    const int gw = F.vcu * NWAVES + F.wave, NGW = F.G * NWAVES;
    const float* o2 = (const float*)(F.ws + WS_O2); const GAS f32x4* wr = (const GAS f32x4*)F.in[19] + F.lane;
    for (int mrow = gw; mrow < M; mrow += NGW) {
        const GAS f32x4* orow = (const GAS f32x4*)(o2 + (size_t)mrow * DM) + F.lane; const GAS f32x4* xr = (const GAS f32x4*)(F.in[0] + (size_t)mrow * DM) + F.lane;
        GAS f32x4* outr = (GAS f32x4*)(F.out + (size_t)mrow * DM) + F.lane;
        f32x4 v[8]; float s = 0.f;
#pragma unroll
        for (int j = 0; j < 8; ++j) { v[j] = orow[64 * j]; s += (v[j].x * v[j].x + v[j].y * v[j].y) + (v[j].z * v[j].z + v[j].w * v[j].w); }
        const float rstd = rsqrtf(wave_sum(s) * (1.f / DM) + EPS);
#pragma unroll
        for (int j = 0; j < 8; ++j) outr[64 * j] = xr[64 * j] + v[j] * rstd * wr[64 * j];
    }
}
constexpr int LDS_BYTES = 147456;
struct Args { const float* in[20]; float* out; unsigned char* ws; int ph_lo, ph_hi; int rep[10]; };
__global__ void __launch_bounds__(NTHR, 2) mega(Args args) {
    extern __shared__ __attribute__((aligned(16))) unsigned char lds[];
    Frame F;
    F.lds = (LAS unsigned char*)lds;
    F.tid = threadIdx.x; F.lane = F.tid & 63; F.wave = __builtin_amdgcn_readfirstlane(F.tid >> 6);
    F.G = gridDim.x; { const int bx = blockIdx.x; F.vcu = (F.G % 8 == 0) ? (bx % 8) * (F.G / 8) + bx / 8 : bx; }
#pragma unroll
    for (int i = 0; i < 20; ++i) F.in[i] = args.in[i];
    F.out = args.out; F.ws = args.ws;
#pragma unroll
    for (int i = 0; i < 8; ++i) F.tacc[i] = 0;
    const int lo = args.ph_lo, hi = args.ph_hi;
#if PROF
    const unsigned long long tk0 = __builtin_amdgcn_s_memrealtime();
#endif
#define IN(k) (lo <= (k) && (k) < hi)
    volatile LAS unsigned* MISC = (volatile LAS unsigned*)(F.lds + LDS_BYTES - 64);
    if (F.tid < 16) MISC[F.tid] = 0u;
    __syncthreads();
    const XcdBarrier bar = xcd_barrier_post((unsigned*)(F.ws + WS_CTL) + 4096, MISC + 8);
#if PROF
#define SEAM(k) do { if (IN(k) && IN((k) + 1)) { const unsigned long long t0_ = __builtin_amdgcn_s_memtime(); xcd_barrier(bar); const unsigned long long d_ = __builtin_amdgcn_s_memtime() - t0_; \
    if (args.rep[9] == 30 + (k) || (args.rep[9] == 41 && (k) == 2 && blockIdx.x < 80) || (args.rep[9] == 42 && (k) == 2 && blockIdx.x >= 80)) { const unsigned long long t1_ = __builtin_amdgcn_s_memtime(); while (__builtin_amdgcn_s_memtime() - t1_ < d_) __builtin_amdgcn_s_sleep(4); } if (args.rep[9] == 30 + (k) || ((args.rep[9] == 41 || args.rep[9] == 42) && (k) == 2)) xcd_barrier(bar); } } while (0)
#else
#define SEAM(k) do { if (IN(k) && IN((k) + 1)) xcd_barrier(bar); } while (0)
#endif
#define REPS(k) (args.rep[k])
#define RETID() do { int t_ = threadIdx.x; asm volatile("" : "+v"(t_)); F.tid = t_; F.lane = t_ & 63; } while (0)
    for (int rp = 0; rp < REPS(0); ++rp) { if (rp) xcd_barrier(bar);
    if (IN(0)) { RETID(); p0_prologue(F); }
#if PROF
    if (args.rep[9] > 20) { const int sel = args.rep[9] - 20; unsigned long long acc = sel == 1 ? F.tacc[0] : sel == 2 ? F.tacc[1] : sel == 3 ? F.tacc[2] : sel == 4 ? F.tacc[3] : F.tacc[4];
        const unsigned long long t0 = __builtin_amdgcn_s_memtime(); while (__builtin_amdgcn_s_memtime() - t0 < acc) __builtin_amdgcn_s_sleep(4); }
#pragma unroll
    for (int i = 0; i < 8; ++i) F.tacc[i] = 0;
#endif
    }
    SEAM(0);
    for (int rp = 0; rp < REPS(1); ++rp) { if (rp) xcd_barrier(bar);
    if (IN(1)) {
        pg8::Gemm g{DM}; Sched1 S{F.G, (int)blockIdx.x, (const char*)(F.ws + WS_HN), (const char*)(F.ws + WS_W1T), (const char*)(F.ws + WS_MEMN), (const char*)(F.ws + WS_WKVT), (unsigned*)(F.ws + WS_CTL) + CW_P1DONE};
        EpiP1 E{F.ws};
        pg8::gemm_phase<EpiP1, Sched1, true, true>(F.lds, g, S, E);
    }
    }
    const bool overlap = (F.G == 256);
    if (!overlap) SEAM(1);
    for (int rp = 0; rp < REPS(2); ++rp) { if (rp) xcd_barrier(bar);
    if (IN(2)) {
        if (overlap) {
            if (F.tid == 0) { unsigned* p = (unsigned*)(F.ws + WS_CTL) + CW_P1DONE; unsigned sp = 0;
                while (__hip_atomic_load(p, __ATOMIC_RELAXED, __HIP_MEMORY_SCOPE_AGENT) < (unsigned)P1_EARLY_UNITS * (unsigned)args.rep[1]) { __builtin_amdgcn_s_sleep(4); if (++sp > (1u << 22)) break; }
                __builtin_amdgcn_fence(__ATOMIC_ACQUIRE, "agent"); asm volatile("s_waitcnt vmcnt(0)" ::: "memory"); }
            for (;;) {
                __syncthreads();
                if (F.tid == 0) MISC[4] = __hip_atomic_fetch_add((unsigned*)(F.ws + WS_CTL) + CW_P2AQ, 1u, __ATOMIC_RELAXED, __HIP_MEMORY_SCOPE_AGENT);
                __syncthreads();
                const int item = (int)MISC[4];
                if (item >= 256 + 128) break;
                if (item < 128) ssd::unitA(F, item >> 5, (item >> 1) & 15, item & 1);
                else if (item < 256) { const int u = item - 128; att::xattn_unit(F, u >> 5, (u >> 3) & 3, u & 7); }
                else { RETID(); p0_wot_chunk(F, item - 256); }
            }
#if PROF
            if (args.rep[9] > 50) { const int sel = args.rep[9] - 50; unsigned long long acc = sel == 1 ? F.tacc[0] : sel == 2 ? F.tacc[1] : sel == 3 ? F.tacc[2] : sel == 4 ? F.tacc[3] : F.tacc[4];
                const unsigned long long t0 = __builtin_amdgcn_s_memtime(); while (__builtin_amdgcn_s_memtime() - t0 < acc) __builtin_amdgcn_s_sleep(4); }
#pragma unroll
            for (int i = 0; i < 8; ++i) F.tacc[i] = 0;
#endif
        } else
        { for (int u = F.vcu; u < 256; u += F.G) { if (u < 128) att::xattn_unit(F, u >> 5, (u >> 3) & 3, u & 7); else { const int v = u - 128; ssd::unitA(F, v >> 5, (v >> 1) & 15, v & 1); } }
          __syncthreads(); RETID(); p0_wot(F, F.vcu * NWAVES + F.wave, F.G * NWAVES); __syncthreads(); }
    }
    }
    SEAM(2);
    for (int rp = 0; rp < REPS(3); ++rp) { if (rp) xcd_barrier(bar);
    if (IN(3)) {
        const float d1 = wave_sum(F.lane < 64 ? F.in[5][F.lane] * F.in[6][F.lane] : 0.f), d2 = wave_sum(F.in[7][F.lane] * F.in[8][F.lane]);
        const float lam = __expf(d1) - __expf(d2) + LAMBDA_INIT;
        for (int r6 = 0; r6 < args.rep[6]; ++r6)
        for (int v = F.vcu; v < 256; v += F.G) { ssd::scan_unit(F, v >> 6, (v >> 3) & 7, v & 7); ssd::scan_publish(F, v >> 6, (v >> 5) & 1); }
        for (int r7 = 0; r7 < args.rep[7]; ++r7)
        for (int v = F.vcu; v < 256; v += F.G) { const int x = v >> 5, j = v & 31, bh1 = 4 * x + (j >> 4), bh2 = bh1 + 2, s = j & 15;
            att::diff_unit(F, bh1 >> 3, bh1 & 7, s, lam); att::diff_unit(F, bh2 >> 3, bh2 & 7, 15 - s, lam); }
        for (int r8 = 0; r8 < args.rep[8]; ++r8)
        for (int v = F.vcu; v < 256; v += F.G) ssd::unitB(F, v >> 6, (v >> 2) & 15, (v >> 1) & 1, v & 1);
    }
    }
    SEAM(3);
    for (int rp = 0; rp < REPS(4); ++rp) { if (rp) xcd_barrier(bar);
    if (IN(4)) {
        pg8::Gemm g{DM}; Sched2 S{F.G, (int)blockIdx.x, (const char*)(F.ws + WS_MIXED), (const char*)(F.ws + WS_WOT)};
        if (F.G == 256) {
            EpiRmsRes E{F.in[0], F.in[19], F.out, (float*)(F.ws + WS_SLOTS), (unsigned*)(F.ws + WS_CTL) + 12288};
            pg8::gemm_phase<EpiRmsRes, Sched2, false, true>(F.lds, g, S, E);
        } else {
            EpiF32 E{(float*)(F.ws + WS_O2), DM};
            pg8::gemm_phase<EpiF32, Sched2, false, true>(F.lds, g, S, E);
        }
    }
    }
    if (F.G != 256) SEAM(4);
    for (int rp = 0; rp < REPS(5); ++rp) { if (rp) xcd_barrier(bar);
    if (IN(5) && F.G != 256) { RETID(); p5_final(F); }
    }
#if PROF
    if (args.rep[9] == 40) { const unsigned long long d_ = __builtin_amdgcn_s_memrealtime() - tk0, t1_ = __builtin_amdgcn_s_memrealtime(); while (__builtin_amdgcn_s_memrealtime() - t1_ < d_) __builtin_amdgcn_s_sleep(8); }
#endif
#undef SEAM
#undef IN
}
extern "C" void kernel_launch(void* const* d_in, const int* in_sizes, int n_in, void* d_out, int out_size, void* d_ws, size_t ws_size, hipStream_t stream) {
    static int grid = 0;
    if (grid == 0) {
        if (n_in != 20 || in_sizes[0] != M * DM || out_size != M * DM || ws_size < WS_END) { fprintf(stderr, "kernel_launch: unexpected shapes (n_in %d, ws %zu)\n", n_in, ws_size); grid = -1; return; }
        int dev = 0, cus = 0, per_cu = 0;
        (void)hipGetDevice(&dev); (void)hipDeviceGetAttribute(&cus, hipDeviceAttributeMultiprocessorCount, dev);
        (void)hipFuncSetAttribute((const void*)mega, hipFuncAttributeMaxDynamicSharedMemorySize, LDS_BYTES);
        (void)hipOccupancyMaxActiveBlocksPerMultiprocessor(&per_cu, (const void*)mega, NTHR, LDS_BYTES);
        if (per_cu < 1) { fprintf(stderr, "kernel_launch: occupancy query says %d\n", per_cu); per_cu = 1; }
        (void)hipGetLastError();
        grid = cus * (per_cu < 1 ? 1 : 1);
    }
    if (grid < 0) return;
    unsigned char* ws = (unsigned char*)d_ws;
    Args a{};
    for (int i = 0; i < 20; ++i) a.in[i] = (const float*)d_in[i];
    a.out = (float*)d_out; a.ws = ws;
    if (hipMemsetAsync(ws + WS_CTL, 0, 65536, stream) != hipSuccess) { fprintf(stderr, "kernel_launch: memset failed\n"); return; }
    a.ph_lo = 0; a.ph_hi = 6;
    for (int k = 0; k < 10; ++k) a.rep[k] = 1;
    void* kargs[] = {&a};
    hipError_t e = hipLaunchCooperativeKernel((const void*)mega, dim3(grid), dim3(NTHR), kargs, LDS_BYTES, stream);
    if (e != hipSuccess) fprintf(stderr, "kernel_launch: cooperative launch failed: %s (grid %d)\n", hipGetErrorString(e), grid);
}
```

```cpp
#include <hip/hip_runtime.h>
#include <hip/hip_cooperative_groups.h>
#include <cstdio>
#include <cstdint>
#include <cmath>
namespace pg8 {
#define PG8_LAS __attribute__((address_space(3)))
typedef unsigned short bf16_t;
typedef short bf16x8 __attribute__((ext_vector_type(8)));
typedef float f32x4 __attribute__((ext_vector_type(4)));
typedef unsigned u32x4 __attribute__((ext_vector_type(4)));
constexpr int BM = 256, BK = 64, HALF = 128, HTB = HALF * BK * 2  , STAGE_BYTES = 8 * HTB, NXCD = 8, WGM = 8;

__host__ __device__ __forceinline__ int lds_byte(int r, int c) { const int st = (r >> 4) * 2 + (c >> 5), rr = r & 15, cc = c & 31, ob = rr * 64 + cc * 2; return st * 1024 + (ob ^ (((ob >> 9) & 1) << 5)); }
__host__ __device__ __forceinline__ void stage_rc(int b, int& R, int& C) { const int st = b / 1024, sb = b % 1024, swz = sb ^ (((sb >> 9) & 1) << 5); R = (st >> 1) * 16 + swz / 64; C = (st & 1) * 32 + (swz % 64) / 2; }
__host__ __device__ __forceinline__ int perm32(int rho) { const int n = rho >> 4, i = rho & 15; return 8 * (i >> 2) + 4 * n + (i & 3); }

struct Unit { const char* a; const char* b; int pm, pn, kind; };
struct Gemm { int K; };

__device__ __forceinline__ unsigned cvt_pk_bf16(float lo, float hi) { unsigned r; asm volatile("v_cvt_pk_bf16_f32 %0, %1, %2" : "=v"(r) : "v"(lo), "v"(hi)); return r; }
template <class Epi, class Sched, bool ALIGN_EPI = false, bool SP2 = false>
__device__ __forceinline__ void gemm_phase(PG8_LAS unsigned char* lds, const Gemm g, const Sched& S, const Epi& E) {
    int tid_ = threadIdx.x; asm volatile("" : "+v"(tid_));
    const int tid = tid_, wid = __builtin_amdgcn_readfirstlane(tid >> 6), lane = tid & 63, wr = wid >> 2, wc = wid & 3, fr = lane & 15, fq = lane >> 4;
    const int K = g.K, nt = K / BK;
    unsigned voffA[2], voffB[2];
#pragma unroll
    for (int i = 0; i < 2; ++i) { int R, C; stage_rc(tid * 16 + i * 8192, R, C); const int Rb = Epi::PERM ? ((R & ~31) + perm32(R & 31)) : R;
        voffA[i] = (unsigned)(R * K + C) * 2u; voffB[i] = (unsigned)(Rb * K + C) * 2u; }
    const size_t kstep = (size_t)(BK * 2);
    const size_t hstep = (size_t)HALF * K * 2;
        const unsigned ldsw = (unsigned)wid * 1024u;
    const int aoff = lds_byte(wr * 64 + fr, fq * 8), boff = lds_byte(wc * 32 + fr, fq * 8);
#define PG8_SA(b, h) (((b) * 2 + (h)) * HTB)
#define PG8_SB(b, h) ((4 + (b) * 2 + (h)) * HTB)
#define PG8_STAGE(bufoff, gbase, voff) do { _Pragma("unroll") for (int _i = 0; _i < 2; ++_i) \
        __builtin_amdgcn_global_load_lds((const unsigned*)((const char*)(gbase) + (voff)[_i]), (PG8_LAS unsigned*)(lds + (bufoff) + ldsw + _i * 8192), 16, 0, 0); } while (0)
#define PG8_LDA(dst, b, h) do { _Pragma("unroll") for (int m = 0; m < 4; ++m) _Pragma("unroll") for (int k = 0; k < 2; ++k) dst[m][k] = *(const PG8_LAS bf16x8*)(lds + PG8_SA(b, h) + aoff + m * 2048 + k * 1024); } while (0)
#define PG8_LDB(dst, b, h) do { _Pragma("unroll") for (int n = 0; n < 2; ++n) _Pragma("unroll") for (int k = 0; k < 2; ++k) dst[n][k] = *(const PG8_LAS bf16x8*)(lds + PG8_SB(b, h) + boff + n * 2048 + k * 1024); } while (0)
#define PG8_MMA(ai, bj, At, Bt) do { __builtin_amdgcn_s_setprio(1); _Pragma("unroll") for (int m = 0; m < 4; ++m) _Pragma("unroll") for (int n = 0; n < 2; ++n) _Pragma("unroll") for (int k = 0; k < 2; ++k) \
        acc[ai][bj][m][n] = __builtin_amdgcn_mfma_f32_16x16x32_bf16(Bt[n][k], At[m][k], acc[ai][bj][m][n], 0, 0, 0); __builtin_amdgcn_s_setprio(0); } while (0)
#define PG8_WAIT_V(n) asm volatile("s_waitcnt vmcnt(" #n ")" ::: "memory")
#define PG8_WAIT_L(n) asm volatile("s_waitcnt lgkmcnt(" #n ")" ::: "memory")
#define PG8_BAR __builtin_amdgcn_s_barrier()
#define PG8_SCHED __builtin_amdgcn_sched_barrier(0)
    Unit cur, nxt; int ui = 0;
    if (!S.next(0, cur)) return;
    f32x4 acc[2][2][4][2];
#pragma unroll
    for (int a = 0; a < 2; ++a)
#pragma unroll
        for (int b = 0; b < 2; ++b)
#pragma unroll
            for (int m = 0; m < 4; ++m)
#pragma unroll
                for (int n = 0; n < 2; ++n) acc[a][b][m][n] = (f32x4){0.f, 0.f, 0.f, 0.f};
    bf16x8 At[4][2], B0[2][2], B1[2][2];
    const char* cA = cur.a; const char* cB = cur.b;
    S.a_ready(cur);
    if constexpr (SP2) {
        PG8_STAGE(PG8_SB(0, 0), cB, voffB); PG8_STAGE(PG8_SB(0, 1), cB + hstep, voffB); PG8_STAGE(PG8_SA(0, 0), cA, voffA); PG8_STAGE(PG8_SA(0, 1), cA + hstep, voffA);
        if (wr == 1) PG8_BAR;
        PG8_WAIT_V(2); PG8_BAR;
        PG8_STAGE(PG8_SB(1, 0), cB + kstep, voffB); PG8_STAGE(PG8_SA(1, 0), cA + kstep, voffA); PG8_STAGE(PG8_SB(1, 1), cB + hstep + kstep, voffB);
        PG8_WAIT_V(6); PG8_BAR;
    } else {
        PG8_STAGE(PG8_SB(0, 0), cB, voffB); PG8_STAGE(PG8_SA(0, 0), cA, voffA); PG8_STAGE(PG8_SB(0, 1), cB + hstep, voffB); PG8_STAGE(PG8_SA(0, 1), cA + hstep, voffA);
        if (wr == 1) PG8_BAR;
        PG8_WAIT_V(4); PG8_BAR;
        PG8_STAGE(PG8_SB(1, 0), cB + kstep, voffB); PG8_STAGE(PG8_SA(1, 0), cA + kstep, voffA); PG8_STAGE(PG8_SB(1, 1), cB + hstep + kstep, voffB);
        PG8_WAIT_V(6); PG8_BAR;
    }
    for (;;) {
        const bool has_next = S.next(ui + 1, nxt);
        const char* nA = has_next ? nxt.a : cA; const char* nB = has_next ? nxt.b : cB;
        for (int t = 0; t < nt; t += 2) {
            const bool last = (t == nt - 2);
            const char* a1 = cA + (size_t)(t + 1) * kstep;
            const char* a2 = last ? nA : cA + (size_t)(t + 2) * kstep; const char* b2 = last ? nB : cB + (size_t)(t + 2) * kstep;
            const char* a3 = a2 + kstep; const char* b3 = b2 + kstep;
            if (last && has_next) S.a_ready(nxt);
            if constexpr (SP2) {
            PG8_LDB(B0, 0, 0); PG8_LDB(B1, 0, 1); PG8_SCHED; PG8_LDA(At, 0, 0); PG8_STAGE(PG8_SA(1, 1), a1 + hstep, voffA);
            PG8_WAIT_V(8); PG8_WAIT_L(0); PG8_BAR; PG8_MMA(0, 0, At, B0); PG8_MMA(0, 1, At, B1); PG8_BAR; PG8_SCHED;
            PG8_LDA(At, 0, 1); PG8_STAGE(PG8_SB(0, 0), b2, voffB); PG8_STAGE(PG8_SB(0, 1), b2 + hstep, voffB); PG8_STAGE(PG8_SA(0, 0), a2, voffA);
            PG8_WAIT_V(8); PG8_WAIT_L(0); PG8_BAR; PG8_MMA(1, 0, At, B0); PG8_MMA(1, 1, At, B1); PG8_BAR; PG8_SCHED;
            PG8_LDB(B0, 1, 0); PG8_LDB(B1, 1, 1); PG8_SCHED; PG8_LDA(At, 1, 0); PG8_STAGE(PG8_SA(0, 1), a2 + hstep, voffA);
            PG8_WAIT_V(8); PG8_WAIT_L(0); PG8_BAR; PG8_MMA(0, 0, At, B0); PG8_MMA(0, 1, At, B1); PG8_BAR; PG8_SCHED;
            PG8_LDA(At, 1, 1); PG8_STAGE(PG8_SB(1, 0), b3, voffB); PG8_STAGE(PG8_SB(1, 1), b3 + hstep, voffB); PG8_STAGE(PG8_SA(1, 0), a3, voffA);
            PG8_WAIT_V(8); PG8_WAIT_L(0); PG8_BAR; PG8_MMA(1, 0, At, B0); PG8_MMA(1, 1, At, B1); PG8_BAR; PG8_SCHED;
            } else {
            PG8_LDB(B0, 0, 0); PG8_SCHED; PG8_LDA(At, 0, 0); PG8_STAGE(PG8_SA(1, 1), a1 + hstep, voffA);
            PG8_WAIT_L(8); PG8_BAR; PG8_WAIT_L(0); PG8_MMA(0, 0, At, B0); PG8_BAR; PG8_SCHED;
            PG8_LDB(B1, 0, 1); PG8_STAGE(PG8_SB(0, 0), b2, voffB);
            PG8_BAR; PG8_WAIT_L(0); PG8_MMA(0, 1, At, B1); PG8_BAR;
            PG8_LDA(At, 0, 1); PG8_STAGE(PG8_SA(0, 0), a2, voffA);
            PG8_BAR; PG8_WAIT_L(0); PG8_MMA(1, 0, At, B0); PG8_BAR; PG8_SCHED;
            PG8_STAGE(PG8_SB(0, 1), b2 + hstep, voffB);
            PG8_WAIT_V(6); PG8_BAR; PG8_MMA(1, 1, At, B1); PG8_BAR;
            PG8_LDB(B0, 1, 0); PG8_SCHED; PG8_LDA(At, 1, 0); PG8_STAGE(PG8_SA(0, 1), a2 + hstep, voffA);
            PG8_WAIT_L(8); PG8_BAR; PG8_WAIT_L(0); PG8_MMA(0, 0, At, B0); PG8_BAR; PG8_SCHED;
            PG8_LDB(B1, 1, 1); PG8_STAGE(PG8_SB(1, 0), b3, voffB);
            PG8_BAR; PG8_WAIT_L(0); PG8_MMA(0, 1, At, B1); PG8_BAR;
            PG8_LDA(At, 1, 1); PG8_STAGE(PG8_SA(1, 0), a3, voffA);
            PG8_BAR; PG8_WAIT_L(0); PG8_MMA(1, 0, At, B0); PG8_BAR; PG8_SCHED;
            PG8_STAGE(PG8_SB(1, 1), b3 + hstep, voffB);
            PG8_WAIT_V(6); PG8_BAR; PG8_MMA(1, 1, At, B1); PG8_BAR;
            }
        }
        if constexpr (ALIGN_EPI) { if (wr == 0) PG8_BAR; }
        if constexpr (!Epi::AFTER_DRAIN) { E(acc, cur, wr, wc, fr, fq); S.done(cur); }
        if (!has_next) break;
#pragma unroll
        for (int a = 0; a < 2; ++a)
#pragma unroll
            for (int b = 0; b < 2; ++b)
#pragma unroll
                for (int m = 0; m < 4; ++m)
#pragma unroll
                    for (int n = 0; n < 2; ++n) acc[a][b][m][n] = (f32x4){0.f, 0.f, 0.f, 0.f};
        cur = nxt; cA = nA; cB = nB; ++ui;
        if constexpr (ALIGN_EPI) { if (wr == 1) PG8_BAR; }
    }
    PG8_WAIT_V(0);
    if constexpr (!ALIGN_EPI) { if (wr == 0) PG8_BAR; }
    PG8_BAR;
    if constexpr (Epi::AFTER_DRAIN) { E.fused(acc, cur, wr, wc, fr, fq, lds, wid, lane); S.done(cur); }
#undef PG8_SA
#undef PG8_SB
#undef PG8_STAGE
#undef PG8_LDA
#undef PG8_LDB
#undef PG8_MMA
#undef PG8_WAIT_V
#undef PG8_WAIT_L
#undef PG8_BAR
#undef PG8_SCHED
}
}
constexpr int NWAVES = 8, NTHR = NWAVES * 64;
constexpr int BATCH = 4, SEQ = 2048, DM = 2048, M = BATCH * SEQ, DIN = 6664, MEMLEN = 256, MM = BATCH * MEMLEN;
constexpr int NW1 = 6656;
constexpr float EPS = 1e-6f, LOG2E = 1.4426950408889634f;
constexpr float C2Q = 0.125f * LOG2E;
constexpr float C2X = 0.08838834764831845f * LOG2E;
constexpr float LAMBDA_INIT = 0.2f;
constexpr size_t MiB = 1u << 20;
constexpr size_t WS_CTL = 0, CTL_ZERO_BYTES = 1 * MiB;
constexpr size_t WS_W1T = 1 * MiB, WS_WOT = 27 * MiB, WS_WKVT = 35 * MiB, WS_HN = 39 * MiB, WS_MEMN = 71 * MiB;
constexpr size_t WS_DT = 75 * MiB, WS_ACS = 75 * MiB + 256 * 1024, WS_ROPE = 76 * MiB;
constexpr size_t WS_Q = 78 * MiB, WS_K = 94 * MiB, WS_VT = 110 * MiB, WS_G = 126 * MiB, WS_Z = 142 * MiB, WS_XBC = 150 * MiB, WS_XQ = 166 * MiB, WS_XG = 174 * MiB;
constexpr size_t WS_MK = 182 * MiB, WS_MVT = 183 * MiB, WS_XT = 184 * MiB, WS_BC = 192 * MiB, WS_CS = 200 * MiB, WS_MIXED = 216 * MiB, WS_PREV = 248 * MiB, WS_END = 256 * MiB;
constexpr size_t WS_SLOTS = 75 * MiB + 512 * 1024;
constexpr size_t WS_O2 = 39 * MiB;
constexpr size_t TSTEP = (size_t)256 * DM * 2;

#define GAS __attribute__((address_space(1)))
#define LAS __attribute__((address_space(3)))
typedef unsigned short bf16;
typedef unsigned v4u __attribute__((ext_vector_type(4)));
typedef unsigned v2u __attribute__((ext_vector_type(2)));
typedef float f32x4 __attribute__((ext_vector_type(4)));
typedef float f32x16 __attribute__((ext_vector_type(16)));
typedef short bf16x8 __attribute__((ext_vector_type(8)));
#define LDS_WAIT() asm volatile("s_waitcnt lgkmcnt(0)" ::: "memory")
#define VM_WAIT() asm volatile("s_waitcnt vmcnt(0)" ::: "memory")
__device__ __forceinline__ unsigned f2bf(float f) { unsigned u = __builtin_bit_cast(unsigned, f); return (u + 0x7fffu + ((u >> 16) & 1u)) >> 16; }
__device__ __forceinline__ unsigned pk2(float lo, float hi) { return f2bf(lo) | (f2bf(hi) << 16); }
__device__ __forceinline__ float bf2f(bf16 v) { return __builtin_bit_cast(float, (unsigned)v << 16); }
__device__ __forceinline__ float bflo(unsigned w) { return __builtin_bit_cast(float, w << 16); }
__device__ __forceinline__ float bfhi(unsigned w) { return __builtin_bit_cast(float, w & 0xffff0000u); }
__device__ __forceinline__ float silu_f(float v) { return v / (1.f + __expf(-v)); }
__device__ __forceinline__ float wave_sum(float v) {
#pragma unroll
    for (int o = 1; o < 64; o <<= 1) v += __shfl_xor(v, o);
    return v;
}

struct Frame {
    LAS unsigned char* lds;
    int tid, lane, wave, vcu, G;
    const float* in[20]; float* out; unsigned char* ws;
    unsigned long long tacc[8];
};

__device__ __forceinline__ int w1_src_col(int r) {
    if (r < 2048) { const int p = r & 63, i = p >> 2, j = p & 3; return (r & ~63) + 2 * i + (j & 1) + 32 * (j >> 1); }
    if (r < 3072) return 3072 + (r - 2048);
    if (r < 3584) return 4096 + (r - 3072);
    if (r < 4608) return 4608 + (r - 3584);
    if (r < 5120) return 5640 + (r - 4608);
    if (r < 5632) return 6152 + (r - 5120);
    return 2048 + (r - 5632);
}
struct TItem { const float* src; bf16* dst; int N; };
__device__ __forceinline__ TItem p0_item(const Frame& F, int it, int lane) {
    constexpr int I_1 = (NW1 / 32) * (DM / 64), I_KV = (1024 / 32) * (DM / 64);
    const float* W; bf16* WT; int N, r = it; bool map = false;
    int nblk;
    if (r < I_1) { W = F.in[4]; N = DIN; WT = (bf16*)(F.ws + WS_W1T); map = true; nblk = NW1 / 32; }
    else if (r < I_1 + I_KV) { r -= I_1; W = F.in[17]; N = 1024; WT = (bf16*)(F.ws + WS_WKVT); nblk = 32; }
    else { r -= I_1 + I_KV; W = F.in[18]; N = DM; WT = (bf16*)(F.ws + WS_WOT); nblk = 64; }
    const int kb = r / nblk, nb = r - kb * nblk, k0 = 64 * kb, n0 = 32 * nb;
    const int sc = map ? w1_src_col(n0 + (lane & 31)) : n0 + (lane & 31);
    TItem t; t.src = W + (size_t)(k0 + (lane >> 5)) * N + sc; t.dst = WT + (size_t)n0 * DM + k0; t.N = N; return t;
}
__device__ __forceinline__ void p0_item_load(float (&tv)[32], const TItem& t) {
#pragma unroll
    for (int i = 0; i < 32; ++i) tv[i] = t.src[(size_t)(2 * i) * t.N];
}
__device__ __forceinline__ void p0_item_store(const float (&tv)[32], const TItem& t, LAS float* scr, int lane) {
#pragma unroll
    for (int i = 0; i < 32; ++i) scr[(2 * i + (lane >> 5)) * 33 + (lane & 31)] = tv[i];
    LDS_WAIT(); asm volatile("" ::: "memory");
    const int c = lane & 7;
#pragma unroll
    for (int j = 0; j < 4; ++j) { const int n = (lane >> 3) + 8 * j; const LAS float* s = scr + (8 * c) * 33 + n;
        v4u o; o.x = pk2(s[0 * 33], s[1 * 33]); o.y = pk2(s[2 * 33], s[3 * 33]); o.z = pk2(s[4 * 33], s[5 * 33]); o.w = pk2(s[6 * 33], s[7 * 33]);
        *(GAS v4u*)(t.dst + (size_t)n * DM + 8 * c) = o; }
    LDS_WAIT(); asm volatile("" ::: "memory");
}
__device__ __forceinline__ void p0_row_load(f32x4 (&v)[8], const Frame& F, int m, int lane) {
    const GAS f32x4* xr = (const GAS f32x4*)((m < M) ? F.in[0] + (size_t)m * DM : F.in[1] + (size_t)(m - M) * DM) + lane;
#pragma unroll
    for (int j = 0; j < 8; ++j) v[j] = xr[64 * j];
}
__device__ __forceinline__ void p0_row_finish(f32x4 (&v)[8], const Frame& F, int m, const LAS float* wdt, int lane) {
    const bool isx = m < M;
    const GAS f32x4* wr = (const GAS f32x4*)(isx ? F.in[3] : F.in[16]) + lane;
    bf16* orow = isx ? (bf16*)(F.ws + WS_HN) + (size_t)m * DM : (bf16*)(F.ws + WS_MEMN) + (size_t)(m - M) * DM;
    float s = 0.f;
#pragma unroll
    for (int j = 0; j < 8; ++j) s += (v[j].x * v[j].x + v[j].y * v[j].y) + (v[j].z * v[j].z + v[j].w * v[j].w);
    const float rstd = rsqrtf(wave_sum(s) * (1.f / DM) + EPS);
    GAS v2u* o8 = (GAS v2u*)orow + lane;
#pragma unroll
    for (int j = 0; j < 8; ++j) { v[j] = v[j] * rstd * wr[64 * j]; v2u o; o.x = pk2(v[j].x, v[j].y); o.y = pk2(v[j].z, v[j].w); o8[64 * j] = o; }
    if (isx) {
        float d[8];
#pragma unroll
        for (int h = 0; h < 8; ++h) { float a = 0.f;
#pragma unroll
            for (int j = 0; j < 8; ++j) { const f32x4 ww = *(const LAS f32x4*)(wdt + h * DM + 4 * (lane + 64 * j)); a += (v[j].x * ww.x + v[j].y * ww.y) + (v[j].z * ww.z + v[j].w * ww.w); }
            d[h] = wave_sum(a); }
        float mine = 0.f;
#pragma unroll
        for (int h = 0; h < 8; ++h) mine = (lane == h) ? d[h] : mine;
        if (lane < 8) { const float r = mine + F.in[12][lane]; ((float*)(F.ws + WS_DT))[(size_t)m * 8 + lane] = (r > 20.f) ? r : log1pf(__expf(r)); }
    }
}
constexpr int P0_NT = (NW1 / 32) * (DM / 64) + (1024 / 32) * (DM / 64), P0_NT_ALL = P0_NT + (DM / 32) * (DM / 64);
__device__ __forceinline__ void p0_wot(Frame& F, int wi, int nw_total) {
    LAS float* scr = (LAS float*)(F.lds + F.wave * 8448); float ta[32]; const int lane = F.lane;
    for (int it = P0_NT + wi; it < P0_NT_ALL; it += nw_total) { const TItem ia = p0_item(F, it, lane); p0_item_load(ta, ia); p0_item_store(ta, ia, scr, lane); }
}
__device__ __forceinline__ void p0_wot_chunk(Frame& F, int ci) {
    LAS float* scr = (LAS float*)(F.lds + F.wave * 8448); float ta[32]; const int lane = F.lane;
#pragma unroll 1
    for (int k = 0; k < 2; ++k) { const TItem ia = p0_item(F, P0_NT + ci * 16 + F.wave * 2 + k, lane); p0_item_load(ta, ia); p0_item_store(ta, ia, scr, lane); }
}
__device__ __forceinline__ void p0_prologue(Frame& F) {
#if PROF
    unsigned long long tlast; asm volatile("s_memtime %0\n\ts_waitcnt lgkmcnt(0)" : "=s"(tlast) :: "memory");
#define PSTAMP(k) do { unsigned long long t_; asm volatile("s_memtime %0\n\ts_waitcnt lgkmcnt(0)" : "=s"(t_) :: "memory"); F.tacc[k] += t_ - tlast; tlast = t_; } while (0)
#else
#define PSTAMP(k) do { } while (0)
#endif
    const int lane = F.lane;
    LAS float* scr = (LAS float*)(F.lds + F.wave * 8448);
    LAS float* wdt = (LAS float*)(F.lds + 69632);
    const int gw = F.vcu * NWAVES + F.wave, NGW = F.G * NWAVES;
    for (int idx = F.tid; idx < DM * 8; idx += NTHR) { const int k = idx >> 3, h = idx & 7; wdt[h * DM + k] = F.in[4][(size_t)k * DIN + 5632 + h]; }
    __syncthreads();
    PSTAMP(0);
    constexpr int NT = P0_NT;
    { float ta[32], tb[32]; TItem ia, ib; int it = gw;
      if (it < NT) { ia = p0_item(F, it, lane); p0_item_load(ta, ia); }
      for (; it < NT; it += 2 * NGW) {
          const int n1 = it + NGW, n2 = n1 + NGW;
          if (n1 < NT) { ib = p0_item(F, n1, lane); p0_item_load(tb, ib); }
          p0_item_store(ta, ia, scr, lane);
          if (n2 < NT) { ia = p0_item(F, n2, lane); p0_item_load(ta, ia); }
          if (n1 < NT) p0_item_store(tb, ib, scr, lane);
      } }
    PSTAMP(1);
    { f32x4 va[8], vb[8]; int m = gw; constexpr int NR = M + MM;
      if (m < NR) p0_row_load(va, F, m, lane);
      for (; m < NR; m += 2 * NGW) {
          const int m1 = m + NGW, m2 = m1 + NGW;
          if (m1 < NR) p0_row_load(vb, F, m1, lane);
          p0_row_finish(va, F, m, wdt, lane);
          if (m2 < NR) p0_row_load(va, F, m2, lane);
          if (m1 < NR) p0_row_finish(vb, F, m1, wdt, lane);
      } }
    PSTAMP(2);
    { const int* pos = (const int*)F.in[2]; float* rope = (float*)(F.ws + WS_ROPE);
      for (int idx = (F.vcu * NTHR + F.tid); idx < M * 32; idx += F.G * NTHR) { const int t = idx >> 5, f = idx & 31;
          const float inv = 1.0f / powf(10000.f, (float)(2 * f) / 64.f); const float ang = (float)pos[t] * inv;
          rope[2 * idx] = cosf(ang); rope[2 * idx + 1] = sinf(ang); } }
    PSTAMP(3);
    __syncthreads();
    PSTAMP(4);
}

constexpr int CW_P1DONE = 10240, CW_P2AQ = 10304, CW_P2BQ = 10368  , P1_EARLY_UNITS = 272;
struct Sched1 {
    int G, c; const char *HN, *W1T, *MEMN, *WKVT; unsigned* cnt;
    __device__ __forceinline__ bool next(int i, pg8::Unit& u) const {
        const long L = (long)i * G + c; if (L >= 848) return false;
        if (L < 256) {
            int wgid = (int)L; { const int xcd = wgid % 8, off = wgid / 8; wgid = xcd * 32 + off; }
            const int pm = (wgid / 64) * 8 + ((wgid % 64) % 8), pn = 14 + (wgid % 64) / 8;
            u.kind = 0; u.pm = pm; u.pn = pn; u.a = HN + (size_t)pm * TSTEP; u.b = W1T + (size_t)pn * TSTEP;
        } else if (L < 264) { const int r = (int)L - 256;
            u.kind = 2; u.pm = r & 3; u.pn = r >> 2; u.a = MEMN + (size_t)u.pm * TSTEP; u.b = WKVT + (size_t)u.pn * TSTEP;
        } else if (L < 272) { const int r = (int)L - 264;
            u.kind = 3; u.pm = r & 1; u.pn = r >> 1; u.a = WKVT + (size_t)(2 + u.pm) * TSTEP; u.b = MEMN + (size_t)u.pn * TSTEP;
        } else if (L < 720) {
            int wgid = (int)L - 272; { const int xcd = wgid % 8, off = wgid / 8; wgid = xcd * 56 + off; }
            const int pm = (wgid / 112) * 8 + ((wgid % 112) % 8), pn = (wgid % 112) / 8;
            u.kind = 0; u.pm = pm; u.pn = pn; u.a = HN + (size_t)pm * TSTEP; u.b = W1T + (size_t)pn * TSTEP;
        } else { const int r = (int)L - 720;
            u.kind = 1; u.pm = r & 3; u.pn = r >> 2; u.a = W1T + (size_t)(22 + u.pm) * TSTEP; u.b = HN + (size_t)u.pn * TSTEP; }
        return true;
    }
    __device__ __forceinline__ void a_ready(const pg8::Unit&) const {}
    __device__ __forceinline__ void done(const pg8::Unit& u) const {
        if (u.kind == 2 || u.kind == 3 || (u.kind == 0 && u.pn >= 14)) {
            asm volatile("s_waitcnt vmcnt(0)\n\ts_barrier" ::: "memory");
            if (threadIdx.x == 0) __hip_atomic_fetch_add(cnt, 1u, __ATOMIC_RELAXED, __HIP_MEMORY_SCOPE_AGENT);
        }
    }
};
struct EpiP1 {
    static constexpr bool PERM = true, AFTER_DRAIN = false;
    unsigned char* ws;
    __device__ __forceinline__ void operator()(const pg8::f32x4 (&acc)[2][2][4][2], const pg8::Unit& u, int wr, int wc, int fr, int fq) const {
        bf16* base; int ldc, op = 0, colt; float sc = 1.f;
        if (u.kind == 0) { const int pn = u.pn;
            if (pn < 4) { base = (bf16*)(ws + WS_Q); ldc = 1024; colt = pn * 256; op = 2; sc = C2Q; }
            else if (pn < 8) { base = (bf16*)(ws + WS_K); ldc = 1024; colt = (pn - 4) * 256; op = 2; }
            else if (pn < 12) { base = (bf16*)(ws + WS_G); ldc = 1024; colt = (pn - 8) * 256; op = 1; }
            else if (pn < 14) { base = (bf16*)(ws + WS_Z); ldc = 512; colt = (pn - 12) * 256; op = 1; }
            else if (pn < 18) { base = (bf16*)(ws + WS_XBC); ldc = 1024; colt = (pn - 14) * 256; }
            else if (pn < 20) { base = (bf16*)(ws + WS_XQ); ldc = 512; colt = (pn - 18) * 256; sc = C2X; }
            else { base = (bf16*)(ws + WS_XG); ldc = 512; colt = (pn - 20) * 256; op = 1; }
        } else if (u.kind == 1) { base = (bf16*)(ws + WS_VT); ldc = M; colt = u.pn * 256; }
        else if (u.kind == 2) { base = (bf16*)(ws + WS_MK); ldc = 512; colt = u.pn * 256; }
        else { base = (bf16*)(ws + WS_MVT); ldc = MM; colt = u.pn * 256; }
        const int row0 = u.pm * 256 + wr * 64 + fr, col0 = colt + wc * 32 + 8 * fq;
        const bool early = (u.kind == 2 || u.kind == 3 || (u.kind == 0 && u.pn >= 14));
        const __amdgpu_buffer_rsrc_t rsrc = __builtin_amdgcn_make_buffer_rsrc(base, 0, 0x7fffffff, 0x00020000);
        const float* rope = (const float*)(ws + WS_ROPE); const int i0 = 8 * (wc & 1) + 2 * fq;
#pragma unroll
        for (int ai = 0; ai < 2; ++ai)
#pragma unroll
            for (int m = 0; m < 4; ++m) { const int row = row0 + ai * 128 + m * 16; bf16* rowp = base + (size_t)row * ldc + col0;
                f32x4 cs0 = {1.f, 0.f, 1.f, 0.f}, cs1 = {1.f, 0.f, 1.f, 0.f};
                if (op == 2) { cs0 = *(const f32x4*)(rope + ((size_t)row * 32 + 2 * i0) * 2); cs1 = *(const f32x4*)(rope + ((size_t)row * 32 + 2 * i0 + 2) * 2); }
#pragma unroll
                for (int bj = 0; bj < 2; ++bj) { f32x4 v0 = acc[ai][bj][m][0], v1 = acc[ai][bj][m][1];
                    if (op == 1) { v0 = (f32x4){silu_f(v0[0]), silu_f(v0[1]), silu_f(v0[2]), silu_f(v0[3])}; v1 = (f32x4){silu_f(v1[0]), silu_f(v1[1]), silu_f(v1[2]), silu_f(v1[3])}; }
                    if (op == 2) {
                        v0 = (f32x4){v0[0] * cs0[0] - v0[2] * cs0[1], v0[1] * cs0[2] - v0[3] * cs0[3], v0[2] * cs0[0] + v0[0] * cs0[1], v0[3] * cs0[2] + v0[1] * cs0[3]};
                        v1 = (f32x4){v1[0] * cs1[0] - v1[2] * cs1[1], v1[1] * cs1[2] - v1[3] * cs1[3], v1[2] * cs1[0] + v1[0] * cs1[1], v1[3] * cs1[2] + v1[1] * cs1[3]}; }
                    v0 = v0 * sc; v1 = v1 * sc;
                    v4u w; w.x = pg8::cvt_pk_bf16(v0[0], v0[1]); w.y = pg8::cvt_pk_bf16(v0[2], v0[3]); w.z = pg8::cvt_pk_bf16(v1[0], v1[1]); w.w = pg8::cvt_pk_bf16(v1[2], v1[3]);
                    if (early) __builtin_amdgcn_raw_buffer_store_b128(w, rsrc, (unsigned)(((size_t)row * ldc + col0 + bj * 128) * 2), 0, 16  );
                    else *(v4u*)(rowp + bj * 128) = w; } }
    }
};
#define XB_TMO      128
#define XB_XCNT(j)  (256  + 64 * (j))
#define XB_XSUB(j)  (1280 + 64 * (j))
#define XB_XGEN(j)  (2304 + 64 * (j))
#define XB_TOP      3328
#define XB_TOPGEN   3392
#define XCD_BAR_WORDS 3456
#define XB_SPIN_CAP (1u << 18)

__device__ __forceinline__ unsigned xb_ld(unsigned* p)              { return __hip_atomic_load(p, __ATOMIC_RELAXED, __HIP_MEMORY_SCOPE_AGENT); }
__device__ __forceinline__ unsigned xb_add(unsigned* p, unsigned v) { return __hip_atomic_fetch_add(p, v, __ATOMIC_RELAXED, __HIP_MEMORY_SCOPE_AGENT); }
__device__ __forceinline__ unsigned xb_xcc_id() { return (unsigned)__builtin_amdgcn_s_getreg((3 << 11) | 20) & 0xFu; }
#define XB_SPIN(cond, bar) do { unsigned _sp = 0; while (cond) { __builtin_amdgcn_s_sleep(1); \
    if ((++_sp & 255u) == 0u) { if (xb_ld(&(bar)[XB_TMO])) break; if (_sp > XB_SPIN_CAP) { atomicAdd(&(bar)[XB_TMO], 1u); break; } } } } while (0)

struct XcdBarrier {
    unsigned* bar; unsigned x;
    volatile LAS unsigned* st;
};

__device__ __forceinline__ XcdBarrier xcd_barrier_post(unsigned* bar, volatile LAS unsigned* st) {
    XcdBarrier b; b.bar = bar; b.x = xb_xcc_id(); b.st = st;
    if (threadIdx.x == 0) (void)xb_add(&bar[XB_XCNT(b.x)], 1u);
    return b;
}
__device__ __forceinline__ void xcd_barrier_complete(unsigned* bar, unsigned x, unsigned& nloc, unsigned& nx) {
    const unsigned G = gridDim.x * gridDim.y * gridDim.z;
    unsigned sum, cnt, mine, sp = 0u;
    for (;;) {
        sum = 0u; cnt = 0u; mine = 0u;
#pragma unroll
        for (unsigned j = 0; j < 16; ++j) { const unsigned c = xb_ld(&bar[XB_XCNT(j)]); sum += c; cnt += (c > 0u) ? 1u : 0u; mine = (j == x) ? c : mine; }
        if (sum == G) break;
        __builtin_amdgcn_s_sleep(1);
        if ((++sp & 255u) == 0u) { if (xb_ld(&bar[XB_TMO])) break; if (sp > XB_SPIN_CAP) { atomicAdd(&bar[XB_TMO], 1u); break; } }
    }
    nloc = mine > 0u ? mine : 1u; nx = cnt > 0u ? cnt : 1u;
}

__device__ __forceinline__ void xcd_barrier(const XcdBarrier& b) {
    asm volatile("s_waitcnt vmcnt(0)" ::: "memory");
    __syncthreads();
    if (threadIdx.x == 0) {
        unsigned* bar = b.bar;
        __builtin_amdgcn_s_waitcnt(0);
        unsigned nloc = b.st[0], nx = b.st[1];
        if (nloc == 0u) { xcd_barrier_complete(bar, b.x, nloc, nx); b.st[0] = nloc; b.st[1] = nx; }
        const unsigned old = xb_add(&bar[XB_XSUB(b.x)], 1u);
        const unsigned gen = old / nloc;
        if (old + 1u == (gen + 1u) * nloc) {
            __builtin_amdgcn_fence(__ATOMIC_RELEASE, "agent");
            asm volatile("s_waitcnt vmcnt(0)" ::: "memory");
            const unsigned og = xb_add(&bar[XB_TOP], 1u);
            const unsigned tg = og / nx;
            if (og + 1u == (tg + 1u) * nx) xb_add(&bar[XB_TOPGEN], 1u);
            else XB_SPIN(xb_ld(&bar[XB_TOPGEN]) == tg, bar);
            __builtin_amdgcn_fence(__ATOMIC_ACQUIRE, "agent");
            xb_add(&bar[XB_XGEN(b.x)], 1u);
            asm volatile("s_waitcnt vmcnt(0)" ::: "memory");
        } else {
            XB_SPIN(xb_ld(&bar[XB_XGEN(b.x)]) == gen, bar);
            __builtin_amdgcn_fence(__ATOMIC_ACQUIRE, "agent");
            asm volatile("s_waitcnt vmcnt(0)" ::: "memory");
        }
    }
    __syncthreads();
}
namespace att {
#ifndef PROF
#define PROF 0
#endif
#if PROF
#define STAMP(k) do { unsigned long long t_; asm volatile("s_memtime %0\n\ts_waitcnt lgkmcnt(0)" : "=s"(t_) :: "memory"); F_tacc[k] += t_ - tlast; tlast = t_; } while (0)
#else
#define STAMP(k) do { } while (0)
#endif
constexpr int STAGE = 32768;
__device__ __forceinline__ int k_off(int row, int ch) { return row * 256 + ((ch ^ (row & 15)) << 4); }
__device__ __forceinline__ int v_off(int row, int ch) { return 16384 + (row >> 1) * 256 + ((((row & 1) << 3) | (ch ^ ((row >> 1) & 7))) << 4); }
__device__ __forceinline__ int pi32(int i) { return (i & 0x13) | ((i & 4) << 1) | ((i & 8) >> 1); }
__device__ __forceinline__ float other_half(float v) {
    return __shfl_xor(v, 32);
}
__device__ __forceinline__ unsigned cvtpk(float lo, float hi) { typedef float f2 __attribute__((ext_vector_type(2))); typedef __bf16 b2 __attribute__((ext_vector_type(2))); f2 v = {lo, hi}; b2 b = __builtin_convertvector(v, b2); return __builtin_bit_cast(unsigned, b); }
constexpr int NST = 4;
struct Stager {
    const bf16* ks[2]; const bf16* vs[2]; size_t kstep; unsigned kd[2], vd[2];
    __device__ __forceinline__ void init(const bf16* Kp, int ldk, const bf16* VTp, int ldv, int wave, int lane) {
#pragma unroll
        for (int i = 0; i < 2; ++i) { const int pc = wave * 2 + i;
            const int row = 4 * pc + (lane >> 4), ch = (lane & 15) ^ (row & 15);
            ks[i] = Kp + (size_t)row * ldk + ch * 8; kd[i] = pc * 1024;
            const int line = 4 * pc + (lane >> 4), slot = lane & 15, vrow = 2 * line + (slot >> 3), vch = (slot & 7) ^ (line & 7);
            vs[i] = VTp + (size_t)vrow * ldv + vch * 8; vd[i] = 16384 + pc * 1024; }
        kstep = (size_t)64 * ldk;
    }
    __device__ __forceinline__ void issue(LAS unsigned char* lds, int t) const {
        LAS unsigned char* buf = lds + (t & (NST - 1)) * STAGE;
#pragma unroll
        for (int i = 0; i < 2; ++i) {
            __builtin_amdgcn_global_load_lds((const unsigned*)(ks[i] + (size_t)t * kstep), (LAS unsigned*)(buf + kd[i]), 16, 0, 0);
            __builtin_amdgcn_global_load_lds((const unsigned*)(vs[i] + (size_t)t * 64), (LAS unsigned*)(buf + vd[i]), 16, 0, 0); }
    }
};
__device__ __forceinline__ void wait_bar(int ahead) {
    if (ahead >= 2) asm volatile("s_waitcnt vmcnt(8)\n\ts_barrier" ::: "memory");
    else if (ahead == 1) asm volatile("s_waitcnt vmcnt(4)\n\ts_barrier" ::: "memory");
    else asm volatile("s_waitcnt vmcnt(0)\n\ts_barrier" ::: "memory");
}
__device__ __forceinline__ float swap_max(float v) { auto r = __builtin_amdgcn_permlane32_swap(__float_as_uint(v), __float_as_uint(v), false, false); return fmaxf(__uint_as_float(r[0]), __uint_as_float(r[1])); }
__device__ __forceinline__ float swap_sum(float v) { auto r = __builtin_amdgcn_permlane32_swap(__float_as_uint(v), __float_as_uint(v), false, false); return __uint_as_float(r[0]) + __uint_as_float(r[1]); }
template <int KSTEPS, bool CAUSAL>
__device__ __forceinline__ void attn_core(LAS unsigned char* lds, const bf16* Qw, int ldq, const bf16* Kp, int ldk, const bf16* VTp, int ldv, int ntiles, int q0rel, int coff,
                                          f32x16 (&o)[4], float& l_out, int wave, int lane, unsigned long long* F_tacc) {
    const int r32 = lane & 31, hi = lane >> 5; const bool trail = wave >= 4;
#if PROF
    unsigned long long tlast; asm volatile("s_memtime %0\n\ts_waitcnt lgkmcnt(0)" : "=s"(tlast) :: "memory");
#endif
    bf16x8 qf[KSTEPS];
#pragma unroll
    for (int ks = 0; ks < KSTEPS; ++ks) qf[ks] = *(const GAS bf16x8*)(Qw + (size_t)r32 * ldq + ks * 16 + hi * 8);
    Stager sg; sg.init(Kp, ldk, VTp, ldv, wave, lane);
    asm volatile("s_waitcnt vmcnt(0)" ::: "memory");
#pragma unroll
    for (int t = 0; t < NST - 1; ++t) if (t < ntiles) sg.issue(lds, t);
#pragma unroll
    for (int d = 0; d < 4; ++d)
#pragma unroll
        for (int r = 0; r < 16; ++r) o[d][r] = 0.f;
    float mref = 0.f, l = 0.f;
    f32x16 negm;
#pragma unroll
    for (int r = 0; r < 16; ++r) negm[r] = 0.f;
    const int krow = pi32(r32), kch0 = (coff >> 3) + hi;
    STAMP(0);
    if (trail) wait_bar(ntiles - 1);
    for (int t = 0; t < ntiles; ++t) {
        if (!trail) wait_bar(ntiles - 1 - t); else asm volatile("s_barrier" ::: "memory");
        STAMP(1);
        if (trail && t + NST - 1 < ntiles) sg.issue(lds, t + NST - 1);
        LAS unsigned char* buf = lds + (t & (NST - 1)) * STAGE;
        const int kv0 = t * 64;
        const bool active = !CAUSAL || (kv0 <= q0rel + 31);
        v4u pw[4]; f32x16 pa, pb;
        if (active) {
            f32x16 p0 = negm, p1 = negm;
#pragma unroll
            for (int kb = 0; kb < KSTEPS; kb += 4) {
                bf16x8 kf[8];
#pragma unroll
                for (int ks = 0; ks < 4; ++ks) { kf[2 * ks] = *(const LAS bf16x8*)(buf + k_off(krow, kch0 + 2 * (kb + ks))); kf[2 * ks + 1] = *(const LAS bf16x8*)(buf + k_off(32 + krow, kch0 + 2 * (kb + ks))); }
                __builtin_amdgcn_sched_barrier(0);
#pragma unroll
                for (int ks = 0; ks < 4; ++ks) {
                    p0 = __builtin_amdgcn_mfma_f32_32x32x16_bf16(kf[2 * ks], qf[kb + ks], p0, 0, 0, 0);
                    p1 = __builtin_amdgcn_mfma_f32_32x32x16_bf16(kf[2 * ks + 1], qf[kb + ks], p1, 0, 0, 0);
                }
            }
            if (CAUSAL && (kv0 + 63 > q0rel)) {
                const int qg = q0rel + r32;
#pragma unroll
                for (int r = 0; r < 16; ++r) { const int kv = kv0 + 16 * (r >> 3) + 8 * hi + (r & 7); if (kv > qg) p0[r] = -INFINITY; if (kv + 32 > qg) p1[r] = -INFINITY; }
            }
            float ra = fmaxf(fmaxf(p0[0], p0[1]), p1[0]), rb = fmaxf(fmaxf(p0[2], p0[3]), p1[1]);
            ra = fmaxf(fmaxf(ra, p1[2]), p1[3]);
#pragma unroll
            for (int r = 4; r < 16; r += 4) { ra = fmaxf(fmaxf(ra, p0[r]), p0[r + 1]); rb = fmaxf(fmaxf(rb, p0[r + 2]), p0[r + 3]); ra = fmaxf(fmaxf(ra, p1[r]), p1[r + 1]); rb = fmaxf(fmaxf(rb, p1[r + 2]), p1[r + 3]); }
            const float rm = swap_max(fmaxf(ra, rb));
            if (t == 0) {
                mref = rm;
#pragma unroll
                for (int r = 0; r < 16; ++r) { p0[r] -= rm; p1[r] -= rm; negm[r] = -rm; }
            } else if (__any(rm > 8.f)) {
                const float dl = fmaxf(rm, 0.f), al = __builtin_amdgcn_exp2f(-dl);
                mref += dl; l *= al;
#pragma unroll
                for (int r = 0; r < 16; ++r) { p0[r] -= dl; p1[r] -= dl; negm[r] = -mref; }
#pragma unroll
                for (int d = 0; d < 4; ++d)
#pragma unroll
                    for (int r = 0; r < 16; ++r) o[d][r] *= al;
            }
#pragma unroll
            for (int r = 0; r < 16; ++r) p0[r] = __builtin_amdgcn_exp2f(p0[r]);
#pragma unroll
            for (int s = 0; s < 2; ++s)
                pw[s] = (v4u){cvtpk(p0[8 * s], p0[8 * s + 1]), cvtpk(p0[8 * s + 2], p0[8 * s + 3]), cvtpk(p0[8 * s + 4], p0[8 * s + 5]), cvtpk(p0[8 * s + 6], p0[8 * s + 7])};
            pa = p0; pb = p1;
        }
        STAMP(2);
        if (!trail) asm volatile("s_barrier" ::: "memory"); else if (t + 1 < ntiles) wait_bar(ntiles - 2 - t); else asm volatile("s_barrier" ::: "memory");
        STAMP(3);
        if (!trail && t + NST - 1 < ntiles) sg.issue(lds, t + NST - 1);
        if (active) {
            bf16x8 vf[8];
#pragma unroll
            for (int ks = 0; ks < 2; ++ks)
#pragma unroll
                for (int d = 0; d < 4; ++d) vf[4 * ks + d] = *(const LAS bf16x8*)(buf + v_off(32 * d + r32, 2 * ks + hi));
            float ls = 0.f;
#pragma unroll
            for (int r = 0; r < 16; ++r) { pb[r] = __builtin_amdgcn_exp2f(pb[r]); ls += pa[r]; }
#pragma unroll
            for (int ks = 0; ks < 2; ++ks)
#pragma unroll
                for (int d = 0; d < 4; ++d) o[d] = __builtin_amdgcn_mfma_f32_32x32x16_bf16(vf[4 * ks + d], __builtin_bit_cast(bf16x8, pw[ks]), o[d], 0, 0, 0);
#pragma unroll
            for (int ks = 2; ks < 4; ++ks)
#pragma unroll
                for (int d = 0; d < 4; ++d) vf[4 * (ks - 2) + d] = *(const LAS bf16x8*)(buf + v_off(32 * d + r32, 2 * ks + hi));
#pragma unroll
            for (int s = 0; s < 2; ++s)
                pw[2 + s] = (v4u){cvtpk(pb[8 * s], pb[8 * s + 1]), cvtpk(pb[8 * s + 2], pb[8 * s + 3]), cvtpk(pb[8 * s + 4], pb[8 * s + 5]), cvtpk(pb[8 * s + 6], pb[8 * s + 7])};
#pragma unroll
            for (int r = 0; r < 16; ++r) ls += pb[r];
            l += ls;
#pragma unroll
            for (int ks = 2; ks < 4; ++ks)
#pragma unroll
                for (int d = 0; d < 4; ++d) o[d] = __builtin_amdgcn_mfma_f32_32x32x16_bf16(vf[4 * (ks - 2) + d], __builtin_bit_cast(bf16x8, pw[ks]), o[d], 0, 0, 0);
        }
        STAMP(4);
    }
    if (!trail) asm volatile("s_barrier" ::: "memory");
    asm volatile("s_waitcnt lgkmcnt(0)\n\ts_barrier" ::: "memory");
    l_out = swap_sum(l);
    STAMP(5);
}
__device__ __forceinline__ int crow(int r, int hi) { return (r & 3) + 8 * (r >> 2) + 4 * hi; }

__device__ __forceinline__ void diff_unit(Frame& F, int b, int h, int qb, float lam) {
    unsigned char* ws = F.ws; int tid_ = F.tid; asm volatile("" : "+v"(tid_)); const int w = F.wave, c = w >> 2, sb = w & 3, lane = tid_ & 63, r32 = lane & 31, hi = lane >> 5;
    const int q0 = qb * 128, q0w = q0 + 32 * sb; const size_t trow0 = (size_t)b * SEQ;
    const bf16* Qw = (const bf16*)(ws + WS_Q) + (trow0 + q0w) * 1024 + h * 128 + c * 64;
    const bf16* Kp = (const bf16*)(ws + WS_K) + trow0 * 1024 + h * 128;
    const bf16* VTp = (const bf16*)(ws + WS_VT) + (size_t)(h * 128) * M + trow0;
    f32x16 o[4]; float l;
#if PROF
    { unsigned long long t_; asm volatile("s_memtime %0\n\ts_waitcnt lgkmcnt(0)" : "=s"(t_) :: "memory"); F.tacc[7] = t_; }
#endif
    attn_core<4, true>(F.lds, Qw, 1024, Kp, 1024, VTp, M, (q0 + 128) / 64, q0w, c * 64, o, l, w, lane, F.tacc);
    const float inv = 1.f / l;
    LAS float* xch = (LAS float*)F.lds + sb * 4096 + lane;
    if (c == 1) {
        const float f = lam * inv;
#pragma unroll
        for (int d = 0; d < 4; ++d)
#pragma unroll
            for (int r = 0; r < 16; ++r) xch[(d * 16 + r) * 64] = o[d][r] * f;
    }
    __syncthreads();
    if (c == 0) {
        float ss = 0.f;
#pragma unroll
        for (int d = 0; d < 4; ++d)
#pragma unroll
            for (int r = 0; r < 16; ++r) { const float v = o[d][r] * inv - xch[(d * 16 + r) * 64]; o[d][r] = v; ss += v * v; }
        ss = swap_sum(ss);
        const float rs = rsqrtf(ss * (1.f / 128.f) + EPS) * (1.f - LAMBDA_INIT);
        const size_t t = trow0 + q0w + r32;
        const bf16* Gp = (const bf16*)(ws + WS_G) + t * 1024 + h * 128; bf16* Op = (bf16*)(ws + WS_MIXED) + t * 2048 + h * 128;
        const float* sw = F.in[9];
#pragma unroll
        for (int d = 0; d < 4; ++d)
#pragma unroll
            for (int rg = 0; rg < 4; ++rg) { const int dv = 32 * d + 8 * rg + 4 * hi;
                const v2u g = *(const GAS v2u*)(Gp + dv); const f32x4 wv = *(const GAS f32x4*)(sw + dv);
                v2u ov; ov.x = pk2(o[d][4 * rg] * rs * wv[0] * bflo(g.x), o[d][4 * rg + 1] * rs * wv[1] * bfhi(g.x));
                ov.y = pk2(o[d][4 * rg + 2] * rs * wv[2] * bflo(g.y), o[d][4 * rg + 3] * rs * wv[3] * bfhi(g.y));
                *(GAS v2u*)(Op + dv) = ov; }
    }
    __syncthreads();
#if PROF
    { unsigned long long t_; asm volatile("s_memtime %0\n\ts_waitcnt lgkmcnt(0)" : "=s"(t_) :: "memory"); F.tacc[6] += t_ - F.tacc[7]; }
#endif
}
__device__ __forceinline__ void xattn_unit(Frame& F, int b, int h, int qb) {
    unsigned char* ws = F.ws; int tid_ = F.tid; asm volatile("" : "+v"(tid_)); const int w = F.wave, lane = tid_ & 63, r32 = lane & 31, hi = lane >> 5;
    const int q0w = qb * 256 + 32 * w; const size_t trow0 = (size_t)b * SEQ;
    const bf16* Qw = (const bf16*)(ws + WS_XQ) + (trow0 + q0w) * 512 + h * 128;
    const bf16* Kp = (const bf16*)(ws + WS_MK) + (size_t)(b * MEMLEN) * 512 + h * 128;
    const bf16* VTp = (const bf16*)(ws + WS_MVT) + (size_t)(h * 128) * MM + b * MEMLEN;
    f32x16 o[4]; float l;
    attn_core<8, false>(F.lds, Qw, 512, Kp, 512, VTp, MM, MEMLEN / 64, 0, 0, o, l, w, lane, F.tacc);
    const float inv = 1.f / l; const size_t t = trow0 + q0w + r32;
    const bf16* Gp = (const bf16*)(ws + WS_XG) + t * 512 + h * 128; bf16* Op = (bf16*)(ws + WS_MIXED) + t * 2048 + 1536 + h * 128;
#pragma unroll
    for (int d = 0; d < 4; ++d)
#pragma unroll
        for (int rg = 0; rg < 4; ++rg) { const int dv = 32 * d + 8 * rg + 4 * hi;
            const v2u g = *(const GAS v2u*)(Gp + dv);
            v2u ov; ov.x = pk2(o[d][4 * rg] * inv * bflo(g.x), o[d][4 * rg + 1] * inv * bfhi(g.x));
            ov.y = pk2(o[d][4 * rg + 2] * inv * bflo(g.y), o[d][4 * rg + 3] * inv * bfhi(g.y));
            *(GAS v2u*)(Op + dv) = ov; }
}
}
namespace ssd {
#if PROF
#define BSTAMP(k) do { unsigned long long t_; asm volatile("s_memtime %0\n\ts_waitcnt lgkmcnt(0)" : "=s"(t_) :: "memory"); F.tacc[k] += t_ - tlast; tlast = t_; } while (0)
#else
#define BSTAMP(k) do { } while (0)
#endif
using att::k_off; using att::pi32; using att::crow; using att::other_half;
__device__ __forceinline__ v4u pack8(const float (&s)[8]) { return (v4u){att::cvtpk(s[0], s[1]), att::cvtpk(s[2], s[3]), att::cvtpk(s[4], s[5]), att::cvtpk(s[6], s[7])}; }
__device__ __forceinline__ void unitA(Frame& F, int b, int c, int g) {
    unsigned char* ws = F.ws; int tid_ = F.tid; asm volatile("" : "+v"(tid_)); const int tid = tid_, lane = tid & 63, w = F.wave, r32 = lane & 31, hi = lane >> 5;
    const size_t t0 = (size_t)b * SEQ + c * 128;
#if PROF
    unsigned long long tlast; asm volatile("s_memtime %0\n\ts_waitcnt lgkmcnt(0)" : "=s"(tlast) :: "memory");
#endif
    LAS unsigned char* tile = F.lds;
    LAS float* tab = (LAS float*)(F.lds + 98304);
    const float* DTg = (const float*)(ws + WS_DT); float* ACSg = (float*)(ws + WS_ACS);
    { const int hh = tid >> 7, l = tid & 127, h = g * 4 + hh;
      const float dt = DTg[(t0 + l) * 8 + h]; float v = dt * (-__expf(F.in[13][h]));
#pragma unroll
      for (int o = 1; o < 64; o <<= 1) { const float t = __shfl_up(v, o); if (lane >= o) v += t; }
      if ((w & 1) == 0 && lane == 63) tab[1536 + hh] = v;
      __syncthreads();
      if (w & 1) v += tab[1536 + hh];
      tab[hh * 128 + l] = dt; tab[512 + hh * 128 + l] = v; ACSg[(t0 + l) * 8 + h] = v;
      __syncthreads();
      tab[1024 + hh * 128 + l] = dt * __expf(tab[512 + hh * 128 + 127] - v);
      __syncthreads(); }
    BSTAMP(0);
    { const int ch = tid; const int col = (ch < 256) ? g * 256 + ch : (ch < 384) ? 512 + g * 128 + (ch - 256) : 768 + g * 128 + (ch - 384);
      const float* cw = F.in[10]; const float w0 = cw[col], w1 = cw[1024 + col], w2 = cw[2048 + col], w3 = cw[3072 + col], bias = F.in[11][col];
      const bf16* src = (const bf16*)(ws + WS_XBC) + t0 * 1024 + col;
      float xx[11]; xx[0] = xx[1] = xx[2] = 0.f;
      if (c > 0) { xx[0] = bf2f(src[-3 * 1024]); xx[1] = bf2f(src[-2 * 1024]); xx[2] = bf2f(src[-1 * 1024]); }
      bf16* XTg = (bf16*)(ws + WS_XT) + ((size_t)(b * 16 + c) * 512 + g * 256 + ch) * 128;
      bf16* BCg = (bf16*)(ws + WS_BC) + t0 * 512 + ((ch < 384) ? g * 128 + (ch - 256) : 256 + g * 128 + (ch - 384));
      const int hh = (ch >> 6) & 3;
#pragma unroll 1
      for (int half = 0; half < 4; ++half) {
          bf16 raw[32];
#pragma unroll
          for (int j = 0; j < 32; ++j) raw[j] = src[(size_t)(half * 32 + j) * 1024];
#pragma unroll
          for (int lq = 0; lq < 4; ++lq) { const int lg = half * 4 + lq;
#pragma unroll
              for (int j = 0; j < 8; ++j) xx[3 + j] = bf2f(raw[lq * 8 + j]);
              float s[8];
#pragma unroll
              for (int j = 0; j < 8; ++j) { const float y = bias + w0 * xx[j] + w1 * xx[j + 1] + w2 * xx[j + 2] + w3 * xx[j + 3]; s[j] = y / (1.f + __expf(-y)); }
              xx[0] = xx[8]; xx[1] = xx[9]; xx[2] = xx[10];
              if (ch < 256) {
                  *(GAS v4u*)(XTg + lg * 8) = pack8(s);
                  const f32x4 wa = *(const LAS f32x4*)(tab + 1024 + hh * 128 + lg * 8), wb = *(const LAS f32x4*)(tab + 1024 + hh * 128 + lg * 8 + 4);
                  float sw[8] = {s[0] * wa[0], s[1] * wa[1], s[2] * wa[2], s[3] * wa[3], s[4] * wb[0], s[5] * wb[1], s[6] * wb[2], s[7] * wb[3]};
                  *(LAS v4u*)(tile + k_off(ch, lg)) = pack8(sw);
              } else {
#pragma unroll
                  for (int j = 0; j < 8; ++j) BCg[(size_t)(lg * 8 + j) * 512] = (bf16)f2bf(s[j]);
                  if (ch < 384) *(LAS v4u*)(tile + k_off(ch, lg)) = pack8(s);
              }
          }
      } }
    BSTAMP(1);
    __syncthreads();
    BSTAMP(2);
    { const int hh = w >> 1, nh = w & 1;
      f32x16 acc[2][2];
#pragma unroll
      for (int i = 0; i < 2; ++i)
#pragma unroll
          for (int j = 0; j < 2; ++j)
#pragma unroll
              for (int r = 0; r < 16; ++r) acc[i][j][r] = 0.f;
#pragma unroll
      for (int ks = 0; ks < 8; ++ks) {
          const bf16x8 a0 = *(const LAS bf16x8*)(tile + k_off(hh * 64 + r32, 2 * ks + hi)), a1 = *(const LAS bf16x8*)(tile + k_off(hh * 64 + 32 + r32, 2 * ks + hi));
          const bf16x8 b0 = *(const LAS bf16x8*)(tile + k_off(256 + nh * 64 + r32, 2 * ks + hi)), b1 = *(const LAS bf16x8*)(tile + k_off(256 + nh * 64 + 32 + r32, 2 * ks + hi));
          acc[0][0] = __builtin_amdgcn_mfma_f32_32x32x16_bf16(a0, b0, acc[0][0], 0, 0, 0); acc[0][1] = __builtin_amdgcn_mfma_f32_32x32x16_bf16(a0, b1, acc[0][1], 0, 0, 0);
          acc[1][0] = __builtin_amdgcn_mfma_f32_32x32x16_bf16(a1, b0, acc[1][0], 0, 0, 0); acc[1][1] = __builtin_amdgcn_mfma_f32_32x32x16_bf16(a1, b1, acc[1][1], 0, 0, 0);
      }
      float* cs = (float*)(ws + WS_CS) + (size_t)((b * 16 + c) * 8 + g * 4 + hh) * 8192;
#pragma unroll
      for (int pb = 0; pb < 2; ++pb)
#pragma unroll
          for (int nb = 0; nb < 2; ++nb)
#pragma unroll
              for (int r = 0; r < 16; ++r) cs[(32 * pb + crow(r, hi)) * 128 + nh * 64 + 32 * nb + r32] = acc[pb][nb][r]; }
    BSTAMP(3);
    __syncthreads();
    BSTAMP(4);
}

__device__ __forceinline__ void scan_unit(Frame& F, int b, int h, int sl) {
    unsigned char* ws = F.ws; int tid_ = F.tid; asm volatile("" : "+v"(tid_)); const int e = sl * 1024 + 2 * tid_;
    typedef float f32x2 __attribute__((ext_vector_type(2)));
    const float* CSg = (const float*)(ws + WS_CS) + (size_t)(b * 16 * 8 + h) * 8192 + e; const float* ACSg = (const float*)(ws + WS_ACS);
    unsigned* PVg = (unsigned*)((bf16*)(ws + WS_PREV) + (size_t)(b * 16 * 8 + h) * 8192 + e);
    f32x2 v[15]; float dec[15];
#pragma unroll
    for (int c = 0; c < 15; ++c) { v[c] = *(const GAS f32x2*)(CSg + (size_t)c * 8 * 8192); dec[c] = __expf(ACSg[((size_t)b * SEQ + c * 128 + 127) * 8 + h]); }
    f32x2 s = {0.f, 0.f};
#pragma unroll
    for (int c = 0; c < 16; ++c) { PVg[(size_t)c * 8 * 4096] = att::cvtpk(s[0], s[1]); if (c < 15) s = s * dec[c] + v[c]; }
}
__device__ __forceinline__ void scan_publish(Frame& F, int b, int g) {
    asm volatile("s_waitcnt vmcnt(0)" ::: "memory");
    __syncthreads();
    if (F.tid == 0) { __builtin_amdgcn_fence(__ATOMIC_RELEASE, "agent"); asm volatile("s_waitcnt vmcnt(0)" ::: "memory");
        __hip_atomic_fetch_add((unsigned*)(F.ws + WS_CTL) + 8192 + (b * 2 + g) * 64, 1u, __ATOMIC_RELAXED, __HIP_MEMORY_SCOPE_AGENT); }
}
__device__ __forceinline__ void scan_wait(Frame& F, int b, int g) {
    if (F.tid == 0) { unsigned* p = (unsigned*)(F.ws + WS_CTL) + 8192 + (b * 2 + g) * 64; unsigned sp = 0;
        while (__hip_atomic_load(p, __ATOMIC_RELAXED, __HIP_MEMORY_SCOPE_AGENT) < 32u) { __builtin_amdgcn_s_sleep(2); if (++sp > (1u << 22)) break; }
        __builtin_amdgcn_fence(__ATOMIC_ACQUIRE, "agent"); asm volatile("s_waitcnt vmcnt(0)" ::: "memory"); }
    __syncthreads();
}

__device__ __forceinline__ void unitB(Frame& F, int b, int c, int g, int half) {
    unsigned char* ws = F.ws; int tid_ = F.tid; asm volatile("" : "+v"(tid_)); const int tid = tid_, lane = tid & 63, w = F.wave, r32 = lane & 31, hi = lane >> 5;
    const size_t t0 = (size_t)b * SEQ + c * 128;
#if PROF
    unsigned long long tlast; asm volatile("s_memtime %0\n\ts_waitcnt lgkmcnt(0)" : "=s"(tlast) :: "memory");
#endif
    LAS unsigned char* btile = F.lds;
    LAS unsigned char* xtile = F.lds + 32768;
    LAS float* tab = (LAS float*)(F.lds + 98304);
    const float* DTg = (const float*)(ws + WS_DT); const float* ACSg = (const float*)(ws + WS_ACS);
    const bf16* BCg = (const bf16*)(ws + WS_BC) + t0 * 512;
    const bf16* XTg = (const bf16*)(ws + WS_XT) + ((size_t)(b * 16 + c) * 512 + g * 256) * 128;
    if (c > 0) scan_wait(F, b, g);
#pragma unroll
    for (int i = 0; i < 12; ++i) { const int pc = w * 12 + i;
        const int row = 4 * (pc < 32 ? pc : pc - 32) + (lane >> 4), ch = (lane & 15) ^ (row & 15);
        const bf16* src = (pc < 32) ? BCg + (size_t)row * 512 + g * 128 + ch * 8 : XTg + (size_t)row * 128 + ch * 8;
        __builtin_amdgcn_global_load_lds((const unsigned*)src, (LAS unsigned*)(F.lds + pc * 1024), 16, 0, 0); }
    { const int hq = tid >> 7, l = tid & 127; tab[hq * 128 + l] = DTg[(t0 + l) * 8 + g * 4 + hq]; tab[512 + hq * 128 + l] = ACSg[(t0 + l) * 8 + g * 4 + hq]; }
    BSTAMP(0);
    const int lbi = w >> 2, hh = w & 3, lb = half ? (lbi ? 2 : 1) : (lbi ? 3 : 0), l_loc = 32 * lb + r32;
    const bf16* PVg = (const bf16*)(ws + WS_PREV) + (size_t)((b * 16 + c) * 8 + g * 4 + hh) * 8192;
    bf16x8 cf[8];
#pragma unroll
    for (int ks = 0; ks < 8; ++ks) cf[ks] = *(const GAS bf16x8*)(BCg + (size_t)l_loc * 512 + 256 + g * 128 + 16 * ks + 8 * hi);
    const size_t t = t0 + l_loc; const bf16* Zg = (const bf16*)(ws + WS_Z) + t * 512 + g * 256 + hh * 64;
    v2u zq[2][4];
#pragma unroll
    for (int pb = 0; pb < 2; ++pb)
#pragma unroll
        for (int rg = 0; rg < 4; ++rg) zq[pb][rg] = *(const GAS v2u*)(Zg + 32 * pb + 8 * rg + 4 * hi);
    f32x16 acc[2];
    { bf16x8 pf[2][8];
      if (c > 0) {
#pragma unroll
          for (int pb = 0; pb < 2; ++pb)
#pragma unroll
              for (int ks = 0; ks < 8; ++ks) pf[pb][ks] = *(const GAS bf16x8*)(PVg + (32 * pb + r32) * 128 + 16 * ks + 8 * hi);
      }
#pragma unroll
      for (int pb = 0; pb < 2; ++pb) {
#pragma unroll
          for (int r = 0; r < 16; ++r) acc[pb][r] = 0.f;
          if (c > 0) {
#pragma unroll
              for (int ks = 0; ks < 8; ++ks) acc[pb] = __builtin_amdgcn_mfma_f32_32x32x16_bf16(pf[pb][ks], cf[ks], acc[pb], 0, 0, 0);
              const float e = __expf(ACSg[(t0 + l_loc) * 8 + g * 4 + hh]);
#pragma unroll
              for (int r = 0; r < 16; ++r) acc[pb][r] *= e;
          }
      } }
    BSTAMP(1);
    asm volatile("s_waitcnt vmcnt(0)" ::: "memory"); __syncthreads();
    BSTAMP(2);
    const float acs_l = tab[512 + hh * 128 + l_loc], Dh = F.in[14][g * 4 + hh];
#pragma unroll 1
    for (int sb = 0; sb <= lb; ++sb) {
        f32x16 gt;
#pragma unroll
        for (int r = 0; r < 16; ++r) gt[r] = 0.f;
#pragma unroll
        for (int ks = 0; ks < 8; ++ks) { const bf16x8 bfr = *(const LAS bf16x8*)(btile + k_off(32 * sb + pi32(r32), 2 * ks + hi)); gt = __builtin_amdgcn_mfma_f32_32x32x16_bf16(bfr, cf[ks], gt, 0, 0, 0); }
        float sc[16];
#pragma unroll
        for (int q4 = 0; q4 < 4; ++q4) { const int sbase = 32 * sb + 16 * (q4 >> 1) + 8 * hi + 4 * (q4 & 1);
            const f32x4 as = *(const LAS f32x4*)(tab + 512 + hh * 128 + sbase), ds = *(const LAS f32x4*)(tab + hh * 128 + sbase);
#pragma unroll
            for (int e = 0; e < 4; ++e) { const int r = 4 * q4 + e; float v = gt[r] * __builtin_amdgcn_exp2f(fminf(acs_l - as[e], 0.f) * LOG2E) * ds[e];
                if (sb == lb) { const int sl = 16 * (r >> 3) + 8 * hi + (r & 7); if (sl > r32) v = 0.f; if (sl == r32) v += Dh; }
                sc[r] = v; } }
        v4u scb[2];
        scb[0] = (v4u){att::cvtpk(sc[0], sc[1]), att::cvtpk(sc[2], sc[3]), att::cvtpk(sc[4], sc[5]), att::cvtpk(sc[6], sc[7])};
        scb[1] = (v4u){att::cvtpk(sc[8], sc[9]), att::cvtpk(sc[10], sc[11]), att::cvtpk(sc[12], sc[13]), att::cvtpk(sc[14], sc[15])};
#pragma unroll
        for (int pb = 0; pb < 2; ++pb)
#pragma unroll
            for (int k2 = 0; k2 < 2; ++k2) { const bf16x8 xf = *(const LAS bf16x8*)(xtile + k_off(hh * 64 + 32 * pb + r32, 4 * sb + 2 * k2 + hi));
                acc[pb] = __builtin_amdgcn_mfma_f32_32x32x16_bf16(xf, __builtin_bit_cast(bf16x8, scb[k2]), acc[pb], 0, 0, 0); }
    }
    BSTAMP(3);
    const float* nw = F.in[15] + g * 256 + hh * 64;
    f32x4 wv[2][4];
#pragma unroll
    for (int pb = 0; pb < 2; ++pb)
#pragma unroll
        for (int rg = 0; rg < 4; ++rg) wv[pb][rg] = *(const GAS f32x4*)(nw + 32 * pb + 8 * rg + 4 * hi);
    float ss = 0.f;
#pragma unroll
    for (int pb = 0; pb < 2; ++pb)
#pragma unroll
        for (int rg = 0; rg < 4; ++rg) { const v2u z = zq[pb][rg];
            const float y0 = acc[pb][4 * rg] * bflo(z.x), y1 = acc[pb][4 * rg + 1] * bfhi(z.x), y2 = acc[pb][4 * rg + 2] * bflo(z.y), y3 = acc[pb][4 * rg + 3] * bfhi(z.y);
            acc[pb][4 * rg] = y0; acc[pb][4 * rg + 1] = y1; acc[pb][4 * rg + 2] = y2; acc[pb][4 * rg + 3] = y3;
            ss += (y0 * y0 + y1 * y1) + (y2 * y2 + y3 * y3); }
    ss = att::swap_sum(ss);
    if (hi == 0) tab[1024 + hh * 128 + l_loc] = ss;
    __syncthreads();
    const float rs = rsqrtf(((tab[1024 + l_loc] + tab[1024 + 128 + l_loc]) + (tab[1024 + 256 + l_loc] + tab[1024 + 384 + l_loc])) * (1.f / 256.f) + EPS);
    bf16* Og = (bf16*)(ws + WS_MIXED) + t * 2048 + 1024 + g * 256 + hh * 64;
#pragma unroll
    for (int pb = 0; pb < 2; ++pb)
#pragma unroll
        for (int rg = 0; rg < 4; ++rg) { const f32x4 wq = wv[pb][rg];
            v2u o; o.x = pk2(acc[pb][4 * rg] * rs * wq[0], acc[pb][4 * rg + 1] * rs * wq[1]); o.y = pk2(acc[pb][4 * rg + 2] * rs * wq[2], acc[pb][4 * rg + 3] * rs * wq[3]);
            *(GAS v2u*)(Og + 32 * pb + 8 * rg + 4 * hi) = o; }
    asm volatile("s_waitcnt lgkmcnt(0)\n\ts_barrier" ::: "memory");
    BSTAMP(4);
}
}
struct Sched2 {
    int G, c; const char *A, *B;
    __device__ __forceinline__ bool next(int i, pg8::Unit& u) const {
        const long L = (long)i * G + c; if (L >= 256) return false;
        int wgid = (int)L; { const int xcd = wgid % 8, off = wgid / 8; wgid = xcd * 32 + off; }
        u.pm = (wgid / 64) * 8 + ((wgid % 64) % 8); u.pn = (wgid % 64) / 8; u.kind = 0;
        u.a = A + (size_t)u.pm * TSTEP; u.b = B + (size_t)u.pn * TSTEP; return true;
    }
    __device__ __forceinline__ void a_ready(const pg8::Unit&) const {}
    __device__ __forceinline__ void done(const pg8::Unit&) const {}
};
struct EpiF32 {
    static constexpr bool PERM = false, AFTER_DRAIN = false;
    float* O; int ldc;
    __device__ __forceinline__ void operator()(const pg8::f32x4 (&acc)[2][2][4][2], const pg8::Unit& u, int wr, int wc, int fr, int fq) const {
        const int row0 = u.pm * 256 + wr * 64 + fr, col0 = u.pn * 256 + wc * 32 + 4 * fq;
#pragma unroll
        for (int ai = 0; ai < 2; ++ai)
#pragma unroll
            for (int m = 0; m < 4; ++m) { float* rowp = O + (size_t)(row0 + ai * 128 + m * 16) * ldc + col0;
#pragma unroll
                for (int bj = 0; bj < 2; ++bj)
#pragma unroll
                    for (int n = 0; n < 2; ++n) *(pg8::f32x4*)(rowp + bj * 128 + n * 16) = acc[ai][bj][m][n]; }
    }
};

struct EpiRmsRes {
    static constexpr bool PERM = false, AFTER_DRAIN = true;
    const float* x; const float* w; float* out; float* slots; unsigned* cnt;
    __device__ __forceinline__ void fused(pg8::f32x4 (&acc)[2][2][4][2], const pg8::Unit& u, int wr, int wc, int fr, int fq, PG8_LAS unsigned char* lds, int wid, int lane) const {
        PG8_LAS float* P = (PG8_LAS float*)lds;
        const int col0 = u.pn * 256 + wc * 32 + 4 * fq;
        pg8::f32x4 pre[4][2][2];
#pragma unroll
        for (int m = 0; m < 4; ++m) { const size_t off = (size_t)(u.pm * 256 + wr * 64 + m * 16 + fr) * DM + col0;
#pragma unroll
            for (int bj = 0; bj < 2; ++bj)
#pragma unroll
                for (int n = 0; n < 2; ++n) pre[m][bj][n] = *(const pg8::f32x4*)(x + off + bj * 128 + n * 16); }
        PG8_LAS float* S = (PG8_LAS float*)(lds + 4096);
#pragma unroll
        for (int ai = 0; ai < 2; ++ai)
#pragma unroll
            for (int m = 0; m < 4; ++m) { float s = 0.f;
#pragma unroll
                for (int bj = 0; bj < 2; ++bj)
#pragma unroll
                    for (int n = 0; n < 2; ++n) { const pg8::f32x4 v = acc[ai][bj][m][n]; s += (v[0] * v[0] + v[1] * v[1]) + (v[2] * v[2] + v[3] * v[3]); }
                s += __shfl_xor(s, 16); s += __shfl_xor(s, 32);
                if (fq == 0) P[(ai * 128 + wr * 64 + m * 16 + fr) * 4 + wc] = s; }
        asm volatile("s_waitcnt lgkmcnt(0)" ::: "memory"); __builtin_amdgcn_s_barrier(); asm volatile("" ::: "memory");
        const int row = wid * 32 + (lane & 31);
        if (lane < 32) { const float t = (P[row * 4] + P[row * 4 + 1]) + (P[row * 4 + 2] + P[row * 4 + 3]);
            __hip_atomic_store(slots + (size_t)(u.pm * 256 + row) * 8 + u.pn, t, __ATOMIC_RELAXED, __HIP_MEMORY_SCOPE_AGENT); }
        asm volatile("s_waitcnt vmcnt(0)" ::: "memory");
        if (lane == 0) __hip_atomic_fetch_add(cnt + 64 * u.pm, 1u, __ATOMIC_RELAXED, __HIP_MEMORY_SCOPE_AGENT);
        if (wid == 0) { unsigned sp = 0;
            while ((unsigned)__builtin_amdgcn_readfirstlane(__hip_atomic_load(cnt + 64 * u.pm, __ATOMIC_RELAXED, __HIP_MEMORY_SCOPE_AGENT)) < 64u) { __builtin_amdgcn_s_sleep(2); if (++sp > (1u << 22)) break; }
            __builtin_amdgcn_fence(__ATOMIC_ACQUIRE, "agent"); }
        asm volatile("s_waitcnt vmcnt(0) lgkmcnt(0)" ::: "memory"); __builtin_amdgcn_s_barrier(); asm volatile("" ::: "memory");
        if (lane < 32) { const float* sl = slots + (size_t)(u.pm * 256 + row) * 8; float t = 0.f;
#pragma unroll
            for (int k = 0; k < 8; ++k) t += __hip_atomic_load(sl + k, __ATOMIC_RELAXED, __HIP_MEMORY_SCOPE_AGENT);
            S[row] = rsqrtf(t * (1.f / DM) + EPS); }
        asm volatile("s_waitcnt lgkmcnt(0)" ::: "memory"); __builtin_amdgcn_s_barrier(); asm volatile("" ::: "memory");
        pg8::f32x4 wv[2][2];
#pragma unroll
        for (int bj = 0; bj < 2; ++bj)
#pragma unroll
            for (int n = 0; n < 2; ++n) wv[bj][n] = *(const pg8::f32x4*)(w + col0 + bj * 128 + n * 16);
#pragma unroll
        for (int ai = 0; ai < 2; ++ai)
#pragma unroll
            for (int m = 0; m < 4; ++m) { const int r = ai * 128 + wr * 64 + m * 16 + fr; const float rs = S[r]; const size_t off = (size_t)(u.pm * 256 + r) * DM + col0;
#pragma unroll
                for (int bj = 0; bj < 2; ++bj)
#pragma unroll
                    for (int n = 0; n < 2; ++n) { const pg8::f32x4 xv = ai == 0 ? pre[m][bj][n] : *(const pg8::f32x4*)(x + off + bj * 128 + n * 16);
                        *(pg8::f32x4*)(out + off + bj * 128 + n * 16) = xv + acc[ai][bj][m][n] * rs * wv[bj][n]; }
                if (m & 1) asm volatile("" ::: "memory"); }
    }
};
__device__ __forceinline__ void p5_final(Frame& F) {
    const int gw = F.vcu * NWAVES + F.wave, NGW = F.G * NWAVES;
    const float* o2 = (const float*)(F.ws + WS_O2); const GAS f32x4* wr = (const GAS f32x4*)F.in[19] + F.lane;
    for (int mrow = gw; mrow < M; mrow += NGW) {
        const GAS f32x4* orow = (const GAS f32x4*)(o2 + (size_t)mrow * DM) + F.lane; const GAS f32x4* xr = (const GAS f32x4*)(F.in[0] + (size_t)mrow * DM) + F.lane;
        GAS f32x4* outr = (GAS f32x4*)(F.out + (size_t)mrow * DM) + F.lane;
        f32x4 v[8]; float s = 0.f;
#pragma unroll
        for (int j = 0; j < 8; ++j) { v[j] = orow[64 * j]; s += (v[j].x * v[j].x + v[j].y * v[j].y) + (v[j].z * v[j].z + v[j].w * v[j].w); }
        const float rstd = rsqrtf(wave_sum(s) * (1.f / DM) + EPS);
#pragma unroll
        for (int j = 0; j < 8; ++j) outr[64 * j] = xr[64 * j] + v[j] * rstd * wr[64 * j];
    }
}
constexpr int LDS_BYTES = 147456;
struct Args { const float* in[20]; float* out; unsigned char* ws; int ph_lo, ph_hi; int rep[10]; };
__global__ void __launch_bounds__(NTHR, 2) mega(Args args) {
    extern __shared__ __attribute__((aligned(16))) unsigned char lds[];
    Frame F;
    F.lds = (LAS unsigned char*)lds;
    F.tid = threadIdx.x; F.lane = F.tid & 63; F.wave = __builtin_amdgcn_readfirstlane(F.tid >> 6);
    F.G = gridDim.x; { const int bx = blockIdx.x; F.vcu = (F.G % 8 == 0) ? (bx % 8) * (F.G / 8) + bx / 8 : bx; }
#pragma unroll
    for (int i = 0; i < 20; ++i) F.in[i] = args.in[i];
    F.out = args.out; F.ws = args.ws;
#pragma unroll
    for (int i = 0; i < 8; ++i) F.tacc[i] = 0;
    const int lo = args.ph_lo, hi = args.ph_hi;
#if PROF
    const unsigned long long tk0 = __builtin_amdgcn_s_memrealtime();
#endif
#define IN(k) (lo <= (k) && (k) < hi)
    volatile LAS unsigned* MISC = (volatile LAS unsigned*)(F.lds + LDS_BYTES - 64);
    if (F.tid < 16) MISC[F.tid] = 0u;
    __syncthreads();
    const XcdBarrier bar = xcd_barrier_post((unsigned*)(F.ws + WS_CTL) + 4096, MISC + 8);
#if PROF
#define SEAM(k) do { if (IN(k) && IN((k) + 1)) { const unsigned long long t0_ = __builtin_amdgcn_s_memtime(); xcd_barrier(bar); const unsigned long long d_ = __builtin_amdgcn_s_memtime() - t0_; \
    if (args.rep[9] == 30 + (k) || (args.rep[9] == 41 && (k) == 2 && blockIdx.x < 80) || (args.rep[9] == 42 && (k) == 2 && blockIdx.x >= 80)) { const unsigned long long t1_ = __builtin_amdgcn_s_memtime(); while (__builtin_amdgcn_s_memtime() - t1_ < d_) __builtin_amdgcn_s_sleep(4); } if (args.rep[9] == 30 + (k) || ((args.rep[9] == 41 || args.rep[9] == 42) && (k) == 2)) xcd_barrier(bar); } } while (0)
#else
#define SEAM(k) do { if (IN(k) && IN((k) + 1)) xcd_barrier(bar); } while (0)
#endif
#define REPS(k) (args.rep[k])
#define RETID() do { int t_ = threadIdx.x; asm volatile("" : "+v"(t_)); F.tid = t_; F.lane = t_ & 63; } while (0)
    for (int rp = 0; rp < REPS(0); ++rp) { if (rp) xcd_barrier(bar);
    if (IN(0)) { RETID(); p0_prologue(F); }
#if PROF
    if (args.rep[9] > 20) { const int sel = args.rep[9] - 20; unsigned long long acc = sel == 1 ? F.tacc[0] : sel == 2 ? F.tacc[1] : sel == 3 ? F.tacc[2] : sel == 4 ? F.tacc[3] : F.tacc[4];
        const unsigned long long t0 = __builtin_amdgcn_s_memtime(); while (__builtin_amdgcn_s_memtime() - t0 < acc) __builtin_amdgcn_s_sleep(4); }
#pragma unroll
    for (int i = 0; i < 8; ++i) F.tacc[i] = 0;
#endif
    }
    SEAM(0);
    for (int rp = 0; rp < REPS(1); ++rp) { if (rp) xcd_barrier(bar);
    if (IN(1)) {
        pg8::Gemm g{DM}; Sched1 S{F.G, (int)blockIdx.x, (const char*)(F.ws + WS_HN), (const char*)(F.ws + WS_W1T), (const char*)(F.ws + WS_MEMN), (const char*)(F.ws + WS_WKVT), (unsigned*)(F.ws + WS_CTL) + CW_P1DONE};
        EpiP1 E{F.ws};
        pg8::gemm_phase<EpiP1, Sched1, true, true>(F.lds, g, S, E);
    }
    }
    const bool overlap = (F.G == 256);
    if (!overlap) SEAM(1);
    for (int rp = 0; rp < REPS(2); ++rp) { if (rp) xcd_barrier(bar);
    if (IN(2)) {
        if (overlap) {
            if (F.tid == 0) { unsigned* p = (unsigned*)(F.ws + WS_CTL) + CW_P1DONE; unsigned sp = 0;
                while (__hip_atomic_load(p, __ATOMIC_RELAXED, __HIP_MEMORY_SCOPE_AGENT) < (unsigned)P1_EARLY_UNITS * (unsigned)args.rep[1]) { __builtin_amdgcn_s_sleep(4); if (++sp > (1u << 22)) break; }
                __builtin_amdgcn_fence(__ATOMIC_ACQUIRE, "agent"); asm volatile("s_waitcnt vmcnt(0)" ::: "memory"); }
            for (;;) {
                __syncthreads();
                if (F.tid == 0) MISC[4] = __hip_atomic_fetch_add((unsigned*)(F.ws + WS_CTL) + CW_P2AQ, 1u, __ATOMIC_RELAXED, __HIP_MEMORY_SCOPE_AGENT);
                __syncthreads();
                const int item = (int)MISC[4];
                if (item >= 256 + 128) break;
                if (item < 128) ssd::unitA(F, item >> 5, (item >> 1) & 15, item & 1);
                else if (item < 256) { const int u = item - 128; att::xattn_unit(F, u >> 5, (u >> 3) & 3, u & 7); }
                else { RETID(); p0_wot_chunk(F, item - 256); }
            }
#if PROF
            if (args.rep[9] > 50) { const int sel = args.rep[9] - 50; unsigned long long acc = sel == 1 ? F.tacc[0] : sel == 2 ? F.tacc[1] : sel == 3 ? F.tacc[2] : sel == 4 ? F.tacc[3] : F.tacc[4];
                const unsigned long long t0 = __builtin_amdgcn_s_memtime(); while (__builtin_amdgcn_s_memtime() - t0 < acc) __builtin_amdgcn_s_sleep(4); }
#pragma unroll
            for (int i = 0; i < 8; ++i) F.tacc[i] = 0;
#endif
        } else
        { for (int u = F.vcu; u < 256; u += F.G) { if (u < 128) att::xattn_unit(F, u >> 5, (u >> 3) & 3, u & 7); else { const int v = u - 128; ssd::unitA(F, v >> 5, (v >> 1) & 15, v & 1); } }
          __syncthreads(); RETID(); p0_wot(F, F.vcu * NWAVES + F.wave, F.G * NWAVES); __syncthreads(); }
    }
    }
    SEAM(2);
    for (int rp = 0; rp < REPS(3); ++rp) { if (rp) xcd_barrier(bar);
    if (IN(3)) {
        const float d1 = wave_sum(F.lane < 64 ? F.in[5][F.lane] * F.in[6][F.lane] : 0.f), d2 = wave_sum(F.in[7][F.lane] * F.in[8][F.lane]);
        const float lam = __expf(d1) - __expf(d2) + LAMBDA_INIT;
        for (int r6 = 0; r6 < args.rep[6]; ++r6)
        for (int v = F.vcu; v < 256; v += F.G) { ssd::scan_unit(F, v >> 6, (v >> 3) & 7, v & 7); ssd::scan_publish(F, v >> 6, (v >> 5) & 1); }
        for (int r7 = 0; r7 < args.rep[7]; ++r7)
        for (int v = F.vcu; v < 256; v += F.G) { const int x = v >> 5, j = v & 31, bh1 = 4 * x + (j >> 4), bh2 = bh1 + 2, s = j & 15;
            att::diff_unit(F, bh1 >> 3, bh1 & 7, s, lam); att::diff_unit(F, bh2 >> 3, bh2 & 7, 15 - s, lam); }
        for (int r8 = 0; r8 < args.rep[8]; ++r8)
        for (int v = F.vcu; v < 256; v += F.G) ssd::unitB(F, v >> 6, (v >> 2) & 15, (v >> 1) & 1, v & 1);
    }
    }
    SEAM(3);
    for (int rp = 0; rp < REPS(4); ++rp) { if (rp) xcd_barrier(bar);
    if (IN(4)) {
        pg8::Gemm g{DM}; Sched2 S{F.G, (int)blockIdx.x, (const char*)(F.ws + WS_MIXED), (const char*)(F.ws + WS_WOT)};
        if (F.G == 256) {
            EpiRmsRes E{F.in[0], F.in[19], F.out, (float*)(F.ws + WS_SLOTS), (unsigned*)(F.ws + WS_CTL) + 12288};
            pg8::gemm_phase<EpiRmsRes, Sched2, false, true>(F.lds, g, S, E);
        } else {
            EpiF32 E{(float*)(F.ws + WS_O2), DM};
            pg8::gemm_phase<EpiF32, Sched2, false, true>(F.lds, g, S, E);
        }
    }
    }
    if (F.G != 256) SEAM(4);
    for (int rp = 0; rp < REPS(5); ++rp) { if (rp) xcd_barrier(bar);
    if (IN(5) && F.G != 256) { RETID(); p5_final(F); }
    }
#if PROF
    if (args.rep[9] == 40) { const unsigned long long d_ = __builtin_amdgcn_s_memrealtime() - tk0, t1_ = __builtin_amdgcn_s_memrealtime(); while (__builtin_amdgcn_s_memrealtime() - t1_ < d_) __builtin_amdgcn_s_sleep(8); }
#endif
#undef SEAM
#undef IN
}
extern "C" void kernel_launch(void* const* d_in, const int* in_sizes, int n_in, void* d_out, int out_size, void* d_ws, size_t ws_size, hipStream_t stream) {
    static int grid = 0;
    if (grid == 0) {
        if (n_in != 20 || in_sizes[0] != M * DM || out_size != M * DM || ws_size < WS_END) { fprintf(stderr, "kernel_launch: unexpected shapes (n_in %d, ws %zu)\n", n_in, ws_size); grid = -1; return; }
        int dev = 0, cus = 0, per_cu = 0;
        (void)hipGetDevice(&dev); (void)hipDeviceGetAttribute(&cus, hipDeviceAttributeMultiprocessorCount, dev);
        (void)hipFuncSetAttribute((const void*)mega, hipFuncAttributeMaxDynamicSharedMemorySize, LDS_BYTES);
        (void)hipOccupancyMaxActiveBlocksPerMultiprocessor(&per_cu, (const void*)mega, NTHR, LDS_BYTES);
        if (per_cu < 1) { fprintf(stderr, "kernel_launch: occupancy query says %d\n", per_cu); per_cu = 1; }
        (void)hipGetLastError();
        grid = cus * (per_cu < 1 ? 1 : 1);
    }
    if (grid < 0) return;
    unsigned char* ws = (unsigned char*)d_ws;
    Args a{};
    for (int i = 0; i < 20; ++i) a.in[i] = (const float*)d_in[i];
    a.out = (float*)d_out; a.ws = ws;
    if (hipMemsetAsync(ws + WS_CTL, 0, 65536, stream) != hipSuccess) { fprintf(stderr, "kernel_launch: memset failed\n"); return; }
    a.ph_lo = 0; a.ph_hi = 6;
    for (int k = 0; k < 10; ++k) a.rep[k] = 1;
    void* kargs[] = {&a};
    hipError_t e = hipLaunchCooperativeKernel((const void*)mega, dim3(grid), dim3(NTHR), kargs, LDS_BYTES, stream);
    if (e != hipSuccess) fprintf(stderr, "kernel_launch: cooperative launch failed: %s (grid %d)\n", hipGetErrorString(e), grid);
}
```
